# Optimizing an MI355X kernel written in HIP

```python
import math
import jax, jax.numpy as jnp
from jax import lax
import numpy as np


D_MODEL = 1024
BATCH = 8
SEQ = 4096
DEPTH = 2

GRID_W = 64
CTX_LEN = 256
N_MIXERS = 4
GROUP_WIDTH = D_MODEL // N_MIXERS
MIX_WIDTH = N_MIXERS * GROUP_WIDTH
Q_BLOCK = 128
CHUNK = 128
ROPE_THETA = 10000.0
NORM_EPS = 1e-6
FFN_RES = 0.5
D_FF = ((8 * D_MODEL // 3 + 127) // 128) * 128
N_MOD = 9

A_HEADS = 4
A_V_DIM = GROUP_WIDTH // A_HEADS
A_QK_DIM = A_V_DIM // 2
B_HEADS = 4
B_KV_HEADS = 2
B_HEAD_DIM = GROUP_WIDTH // B_HEADS
C_GROUPS = 4
C_GROUP_DIM = GROUP_WIDTH // C_GROUPS
D_HEADS = 4
D_V_DIM = GROUP_WIDTH // D_HEADS
D_NOPE_DIM = D_V_DIM
D_ROPE_DIM = D_V_DIM // 2
D_Q_RANK = D_MODEL // 4
D_KV_RANK = D_MODEL // 8

IN_SIZES = (A_HEADS * 2 * A_QK_DIM, A_HEADS * 2 * A_QK_DIM, A_HEADS * A_V_DIM,
            B_HEADS * B_HEAD_DIM, B_KV_HEADS * B_HEAD_DIM, B_KV_HEADS * B_HEAD_DIM,
            GROUP_WIDTH, GROUP_WIDTH,
            D_Q_RANK, D_KV_RANK, D_ROPE_DIM)
IN_WIDTH = (2 * A_HEADS * 2 * A_QK_DIM + A_HEADS * A_V_DIM + B_HEADS * B_HEAD_DIM
            + 2 * B_KV_HEADS * B_HEAD_DIM + 2 * GROUP_WIDTH + D_Q_RANK + D_KV_RANK + D_ROPE_DIM)

kernel_name = 'hybrid_parallel_group_dit_trunk'


def rms_norm(x, g):
    xf = x.astype(jnp.float32)
    y = xf * lax.rsqrt(jnp.mean(xf * xf, axis=-1, keepdims=True) + NORM_EPS)
    return (y * g.astype(jnp.float32)).astype(x.dtype)


def layer_norm(x, g, b):
    xf = x.astype(jnp.float32)
    mu = jnp.mean(xf, axis=-1, keepdims=True)
    xc = xf - mu
    y = xc * lax.rsqrt(jnp.mean(xc * xc, axis=-1, keepdims=True) + NORM_EPS)
    return (y * g.astype(jnp.float32) + b.astype(jnp.float32)).astype(x.dtype)


def split_cols(p, sizes):
    idx = [int(i) for i in np.cumsum(sizes)[:-1]]
    return jnp.split(p, idx, axis=-1)


def swiglu(h, w1, w2):
    g, u = jnp.split(h @ w1, 2, axis=-1)
    return (jax.nn.silu(g) * u) @ w2


def lambda_init(layer_idx):
    return 0.8 - 0.6 * math.exp(-0.3 * layer_idx)


def axial_rope_tables(n_rows, rot_dim):
    rows = jnp.repeat(jnp.arange(n_rows, dtype=jnp.float32), GRID_W)
    cols = jnp.tile(jnp.arange(GRID_W, dtype=jnp.float32), n_rows)
    axis_dim = rot_dim // 2
    inv_freq = ROPE_THETA ** (-jnp.arange(0, axis_dim, 2, dtype=jnp.float32) / axis_dim)
    ang_r = rows[:, None] * inv_freq[None, :]
    ang_c = cols[:, None] * inv_freq[None, :]
    return (jnp.cos(ang_r), jnp.sin(ang_r), jnp.cos(ang_c), jnp.sin(ang_c))


def apply_rope_axis(x, cos, sin):
    half = x.shape[-1] // 2
    shp = (1, x.shape[1]) + (1,) * (x.ndim - 3) + (half,)
    cos = cos.reshape(shp)
    sin = sin.reshape(shp)
    xf = x.astype(jnp.float32)
    x1, x2 = xf[..., :half], xf[..., half:]
    return jnp.concatenate([x1 * cos - x2 * sin, x2 * cos + x1 * sin], axis=-1).astype(x.dtype)


def apply_rope_2d(x, tabs):
    cr, sr, cc, sc = tabs
    a = x.shape[-1] // 2
    return jnp.concatenate([apply_rope_axis(x[..., :a], cr, sr),
                            apply_rope_axis(x[..., a:], cc, sc)], axis=-1)


def sweep_query_blocks(fn, q):
    b, s = q.shape[:2]
    nb = s // Q_BLOCK
    qb = jnp.moveaxis(q.reshape((b, nb, Q_BLOCK) + q.shape[2:]), 1, 0)
    out = jnp.moveaxis(lax.map(fn, qb), 0, 1)
    return out.reshape((b, s) + out.shape[3:])


def diff_core(q, k, v, lam, scale):
    s = jnp.einsum('bqhmd,bkhmd->bhmqk', q, k).astype(jnp.float32) * scale
    p = jax.nn.softmax(s, axis=-1)
    w = p[:, :, 0] - lam * p[:, :, 1]
    return jnp.einsum('bhqk,bkhd->bqhd', w.astype(v.dtype), v)


def gqa_core(q, k, v, scale):
    s = jnp.einsum('bqhgd,bkhd->bhgqk', q, k).astype(jnp.float32) * scale
    p = jax.nn.softmax(s, axis=-1).astype(v.dtype)
    return jnp.einsum('bhgqk,bkhd->bqhgd', p, v)


def diff_attention_group(pc, pl, lam_vecs, g_subln, lam_init, rope, need_ctx):
    def heads(q, k, v):
        b, s = q.shape[:2]
        return (q.reshape(b, s, A_HEADS, 2, A_QK_DIM), k.reshape(b, s, A_HEADS, 2, A_QK_DIM),
                v.reshape(b, s, A_HEADS, A_V_DIM))
    qc, kc, vc = heads(*pc)
    ql, kl, vl = heads(*pl)
    ql = apply_rope_2d(ql, rope)
    kl = apply_rope_2d(kl, rope)
    lv = lam_vecs.astype(jnp.float32)
    lam = jnp.exp(jnp.sum(lv[0] * lv[1])) - jnp.exp(jnp.sum(lv[2] * lv[3])) + lam_init
    scale = A_QK_DIM ** -0.5
    k_all = jnp.concatenate([kc, kl], axis=1)
    v_all = jnp.concatenate([vc, vl], axis=1)
    o_lat = sweep_query_blocks(lambda qb: diff_core(qb, k_all, v_all, lam, scale), ql)

    def finish(o):
        b, s = o.shape[:2]
        return (rms_norm(o, g_subln) * (1.0 - lam_init)).reshape(b, s, A_HEADS * A_V_DIM)
    o_ctx = finish(diff_core(qc, kc, vc, lam, scale)) if need_ctx else None
    return o_ctx, finish(o_lat)


def gqa_group(pc, pl, g_qn, g_kn, rope, need_ctx):
    def heads(q, k, v):
        b, s = q.shape[:2]
        q = rms_norm(q.reshape(b, s, B_HEADS, B_HEAD_DIM), g_qn)
        k = rms_norm(k.reshape(b, s, B_KV_HEADS, B_HEAD_DIM), g_kn)
        return q, k, v.reshape(b, s, B_KV_HEADS, B_HEAD_DIM)
    qc, kc, vc = heads(*pc)
    ql, kl, vl = heads(*pl)
    ql = apply_rope_2d(ql, rope)
    kl = apply_rope_2d(kl, rope)
    n_rep = B_HEADS // B_KV_HEADS

    def group(q):
        return q.reshape(q.shape[:2] + (B_KV_HEADS, n_rep, B_HEAD_DIM))

    def flat(o):
        return o.reshape(o.shape[:2] + (B_HEADS * B_HEAD_DIM,))
    scale = B_HEAD_DIM ** -0.5
    k_all = jnp.concatenate([kc, kl], axis=1)
    v_all = jnp.concatenate([vc, vl], axis=1)
    o_lat = sweep_query_blocks(lambda qb: gqa_core(qb, k_all, v_all, scale), group(ql))
    o_ctx = flat(gqa_core(group(qc), kc, vc, scale)) if need_ctx else None
    return o_ctx, flat(o_lat)


def chunk_gmlp(u, v, w_sp, b_sp, ln_g, ln_b):
    u = jax.nn.gelu(u)
    v = layer_norm(jax.nn.gelu(v), ln_g, ln_b)
    b, s, _ = v.shape
    vr = v.reshape(b, s // CHUNK, CHUNK, C_GROUPS, C_GROUP_DIM)
    mixed = jnp.einsum('gpq,bnqgc->bnpgc', w_sp, vr) + b_sp.T[None, None, :, :, None]
    return u * mixed.reshape(b, s, C_GROUPS * C_GROUP_DIM)


def mla_group(pc, pl, g_qa, w_uq, g_kva, w_ukv, rope, need_ctx):
    def expand(cq, ckv, kr):
        b, s = cq.shape[:2]
        q = (rms_norm(cq, g_qa) @ w_uq).reshape(b, s, D_HEADS, D_NOPE_DIM + D_ROPE_DIM)
        kv = (rms_norm(ckv, g_kva) @ w_ukv).reshape(b, s, D_HEADS, D_NOPE_DIM + D_V_DIM)
        return (q[..., :D_NOPE_DIM], q[..., D_NOPE_DIM:], kv[..., :D_NOPE_DIM],
                kv[..., D_NOPE_DIM:], kr[:, :, None, :])

    def assemble(qn, qr, kn, kr):
        q = jnp.concatenate([qn, qr], axis=-1)[:, :, :, None, :]
        k = jnp.concatenate([kn, jnp.broadcast_to(kr, kn.shape[:3] + (D_ROPE_DIM,))], axis=-1)
        return q, k
    qn_c, qr_c, kn_c, v_c, kr_c = expand(*pc)
    qn_l, qr_l, kn_l, v_l, kr_l = expand(*pl)
    qr_l = apply_rope_2d(qr_l, rope)
    kr_l = apply_rope_2d(kr_l, rope)
    q_c, k_c = assemble(qn_c, qr_c, kn_c, kr_c)
    q_l, k_l = assemble(qn_l, qr_l, kn_l, kr_l)
    scale = (D_NOPE_DIM + D_ROPE_DIM) ** -0.5

    def flat(o):
        return o.reshape(o.shape[:2] + (D_HEADS * D_V_DIM,))
    k_all = jnp.concatenate([k_c, k_l], axis=1)
    v_all = jnp.concatenate([v_c, v_l], axis=1)
    o_lat = sweep_query_blocks(lambda qb: gqa_core(qb, k_all, v_all, scale), q_l)
    o_ctx = flat(gqa_core(q_c, k_c, v_c, scale)) if need_ctx else None
    return o_ctx, flat(o_lat)


def trunk_layer(x_ctx, x_lat, mod_ctx, mod_lat, params, ropes, lam_init, need_ctx):
    (g_pre, g_post, w_ffn1_in, w_ffn1_out, w_ffn2_in, w_ffn2_out, w_in, w_out,
     lam_vecs, g_subln, g_qnorm, g_knorm, w_spatial, b_spatial, ln_g, ln_b,
     g_q_a, w_uq, g_kv_a, w_ukv) = params
    rope_a, rope_b, rope_d = ropes

    def mod(m, i):
        return m[:, i, None, :]

    def pre(xs, m, j):
        return rms_norm(xs, g_pre[j]) * (1.0 + mod(m, 3 * j + 1)) + mod(m, 3 * j)

    def post(xs, y, m, j, w):
        return xs + w * mod(m, 3 * j + 2) * rms_norm(y, g_post[j])

    x_ctx = post(x_ctx, swiglu(pre(x_ctx, mod_ctx, 0), w_ffn1_in, w_ffn1_out), mod_ctx, 0, FFN_RES)
    x_lat = post(x_lat, swiglu(pre(x_lat, mod_lat, 0), w_ffn1_in, w_ffn1_out), mod_lat, 0, FFN_RES)

    pc = split_cols(pre(x_ctx, mod_ctx, 1) @ w_in, IN_SIZES)
    pl = split_cols(pre(x_lat, mod_lat, 1) @ w_in, IN_SIZES)
    a_c, a_l = diff_attention_group(pc[0:3], pl[0:3], lam_vecs, g_subln, lam_init, rope_a, need_ctx)
    b_c, b_l = gqa_group(pc[3:6], pl[3:6], g_qnorm, g_knorm, rope_b, need_ctx)
    c_l = chunk_gmlp(pl[6], pl[7], w_spatial, b_spatial, ln_g, ln_b)
    d_c, d_l = mla_group(pc[8:11], pl[8:11], g_q_a, w_uq, g_kv_a, w_ukv, rope_d, need_ctx)
    y_lat = jnp.concatenate([a_l, b_l, c_l, d_l], axis=-1) @ w_out
    x_lat = post(x_lat, y_lat, mod_lat, 1, 1.0)

    x_lat = post(x_lat, swiglu(pre(x_lat, mod_lat, 2), w_ffn2_in, w_ffn2_out), mod_lat, 2, FFN_RES)

    if need_ctx:
        c_c = chunk_gmlp(pc[6], pc[7], w_spatial, b_spatial, ln_g, ln_b)
        y_ctx = jnp.concatenate([a_c, b_c, c_c, d_c], axis=-1) @ w_out
        x_ctx = post(x_ctx, y_ctx, mod_ctx, 1, 1.0)
        x_ctx = post(x_ctx, swiglu(pre(x_ctx, mod_ctx, 2), w_ffn2_in, w_ffn2_out), mod_ctx, 2, FFN_RES)
    return x_ctx, x_lat


def setup_inputs(seed: int = 0) -> dict:
    key = jax.random.key(seed)
    ks = jax.random.split(key, 26)
    f32 = jnp.float32
    L = DEPTH

    def nrm(k, shape, s):
        return jax.random.normal(k, shape, f32) * s

    def gain(k, shape):
        return 1.0 + 0.05 * jax.random.normal(k, shape, f32)
    return {
        'x': nrm(ks[0], (BATCH, SEQ, D_MODEL), 1.0),
        'c': nrm(ks[1], (BATCH, D_MODEL), 1.0),
        'ctx': nrm(ks[2], (BATCH, CTX_LEN, D_MODEL), 1.0),
        'c_ctx': nrm(ks[3], (D_MODEL,), 1.0),
        'w_ada': nrm(ks[4], (L, D_MODEL, N_MOD * D_MODEL), D_MODEL ** -0.5),
        'b_ada': nrm(ks[5], (L, N_MOD * D_MODEL), 0.02),
        'g_pre': gain(ks[6], (L, 3, D_MODEL)),
        'g_post': gain(ks[7], (L, 3, D_MODEL)),
        'w_ffn1_in': nrm(ks[8], (L, D_MODEL, 2 * D_FF), D_MODEL ** -0.5),
        'w_ffn1_out': nrm(ks[9], (L, D_FF, D_MODEL), D_FF ** -0.5),
        'w_ffn2_in': nrm(ks[10], (L, D_MODEL, 2 * D_FF), D_MODEL ** -0.5),
        'w_ffn2_out': nrm(ks[11], (L, D_FF, D_MODEL), D_FF ** -0.5),
        'w_in': nrm(ks[12], (L, D_MODEL, IN_WIDTH), D_MODEL ** -0.5),
        'w_out': nrm(ks[13], (L, MIX_WIDTH, D_MODEL), MIX_WIDTH ** -0.5),
        'lam_vecs': nrm(ks[14], (L, 4, A_QK_DIM), 0.1),
        'g_subln': gain(ks[15], (L, A_V_DIM)),
        'g_qnorm': gain(ks[16], (L, B_HEAD_DIM)),
        'g_knorm': gain(ks[17], (L, B_HEAD_DIM)),
        'w_spatial': nrm(ks[18], (L, C_GROUPS, CHUNK, CHUNK), CHUNK ** -0.5),
        'b_spatial': gain(ks[19], (L, C_GROUPS, CHUNK)),
        'ln_g': gain(ks[20], (L, GROUP_WIDTH)),
        'ln_b': nrm(ks[21], (L, GROUP_WIDTH), 0.02),
        'g_q_a': gain(ks[22], (L, D_Q_RANK)),
        'w_uq': nrm(ks[23], (L, D_Q_RANK, D_HEADS * (D_NOPE_DIM + D_ROPE_DIM)), D_Q_RANK ** -0.5),
        'g_kv_a': gain(ks[24], (L, D_KV_RANK)),
        'w_ukv': nrm(ks[25], (L, D_KV_RANK, D_HEADS * (D_NOPE_DIM + D_V_DIM)), D_KV_RANK ** -0.5),
    }


def reference(x, c, ctx, c_ctx, w_ada, b_ada, g_pre, g_post, w_ffn1_in, w_ffn1_out,
              w_ffn2_in, w_ffn2_out, w_in, w_out, lam_vecs, g_subln, g_qnorm, g_knorm,
              w_spatial, b_spatial, ln_g, ln_b, g_q_a, w_uq, g_kv_a, w_ukv):
    n_rows = x.shape[1] // GRID_W
    ropes = (axial_rope_tables(n_rows, A_QK_DIM),
             axial_rope_tables(n_rows, B_HEAD_DIM),
             axial_rope_tables(n_rows, D_ROPE_DIM))
    x_ctx, x_lat = ctx, x
    for l in range(DEPTH):
        mod_lat = (jax.nn.silu(c) @ w_ada[l] + b_ada[l]).reshape(c.shape[0], N_MOD, D_MODEL)
        mod_ctx = (jax.nn.silu(c_ctx)[None, :] @ w_ada[l] + b_ada[l]).reshape(1, N_MOD, D_MODEL)
        params = (g_pre[l], g_post[l], w_ffn1_in[l], w_ffn1_out[l], w_ffn2_in[l], w_ffn2_out[l],
                  w_in[l], w_out[l], lam_vecs[l], g_subln[l], g_qnorm[l], g_knorm[l],
                  w_spatial[l], b_spatial[l], ln_g[l], ln_b[l],
                  g_q_a[l], w_uq[l], g_kv_a[l], w_ukv[l])
        x_ctx, x_lat = trunk_layer(x_ctx, x_lat, mod_ctx, mod_lat, params, ropes,
                                   lambda_init(l), l < DEPTH - 1)
    return x_lat
```

```cpp
#include <hip/hip_runtime.h>
#include <hip/hip_cooperative_groups.h>
#include <stdint.h>
#include <cstdio>
namespace cg = cooperative_groups;

#ifndef MULTI_LAUNCH
#define MULTI_LAUNCH 0
#endif

typedef unsigned short bf16_t;
using bf16x8 = __attribute__((ext_vector_type(8))) short;
using f32x16 = __attribute__((ext_vector_type(16))) float;
using u32x4 = __attribute__((ext_vector_type(4))) unsigned;
using u32x2 = __attribute__((ext_vector_type(2))) unsigned;

#define DI __device__ __forceinline__
#define MFMA32(a, b, c) __builtin_amdgcn_mfma_f32_32x32x16_bf16((a), (b), (c), 0, 0, 0)

constexpr int NT = 4352;
constexpr int NB = 8;
constexpr int MROWS = NB * NT;
constexpr int DM = 1024;
constexpr int DFF = 2816;
constexpr int NIN = 2304;
constexpr int NTHREADS = 512;
constexpr float EPS = 1e-6f;
constexpr float LOG2E = 1.4426950408889634f;

constexpr size_t OFF_W1 = 0;
constexpr size_t OFF_W2 = 5767168;
constexpr size_t OFF_W3 = 8650752;
constexpr size_t OFF_W4 = 14417920;
constexpr size_t OFF_WIN = 17301504;
constexpr size_t OFF_WOUT = 19660800;
constexpr size_t OFF_WUQ = 20709376;
constexpr size_t OFF_WUKV = 20840448;
constexpr size_t OFF_WSP = 20905984;
constexpr size_t LAYER_W = 20971520;

constexpr size_t QA_OFF = 0;
constexpr size_t KA_OFF = 8912896;
constexpr size_t VAT_OFF = 17825792;
constexpr size_t QB_OFF = 26738688;
constexpr size_t KB_OFF = 35651584;
constexpr size_t VBT_OFF = 40108032;
constexpr size_t QD_OFF = 44564480;
constexpr size_t KD_OFF = 57933824;
constexpr size_t VDT_OFF = 71303168;

struct Params {
  const float *x, *c, *ctx, *c_ctx, *w_ada, *b_ada, *g_pre, *g_post, *w_ffn1_in, *w_ffn1_out, *w_ffn2_in,
      *w_ffn2_out, *w_in, *w_out, *lam_vecs, *g_subln, *g_qnorm, *g_knorm, *w_spatial, *b_spatial, *ln_g, *ln_b,
      *g_q_a, *w_uq, *g_kv_a, *w_ukv;
  float* out;
  bf16_t* wts;
  float* mods;
  float* rope;
  float* xctx;
  bf16_t* h;
  bf16_t* r1;
  bf16_t* r2;
  int phase_lo, phase_hi;
};

DI int otid() { int t = threadIdx.x; asm volatile("" : "+v"(t)); return t; }
DI float bf2f(bf16_t v) { return __uint_as_float(((unsigned)v) << 16); }
DI bf16_t f2bf(float f) { __bf16 b = (__bf16)f; return __builtin_bit_cast(unsigned short, b); }
DI unsigned pack2(float a, float b) { return (unsigned)f2bf(a) | ((unsigned)f2bf(b) << 16); }
DI int crow(int e, int hh) { return (e & 3) + 8 * (e >> 2) + 4 * hh; }
DI float wave_sum(float v) {
#pragma unroll
  for (int o = 32; o >= 1; o >>= 1) v += __shfl_xor(v, o);
  return v;
}
DI float gelu_tanh(float x) {
  float u = 0.7978845608028654f * (x + 0.044715f * x * x * x);
  return 0.5f * x * (1.f + tanhf(u));
}
DI float silu(float x) { return x / (1.f + __expf(-x)); }

DI void convert_tile(const float* __restrict__ src, int K, int N, int mode, bf16_t* __restrict__ dst, int kt, int nt,
                     float* tile) {
  const int tid = otid();
  {
    const int kl = tid >> 4, n4 = (tid & 15) * 4;
    const int np = nt * 64 + n4;
    int sc = np;
    if (mode == 1) {
      int j = (np >> 5) & 1, tl = np >> 8, w = (np >> 6) & 3, r = np & 31;
      sc = j * DFF + tl * 128 + w * 32 + r;
    }
    const bool valid = (mode == 1) || (np < N);
#pragma unroll
    for (int half = 0; half < 2; ++half) {
      int k = kl + 32 * half;
      float4 v = make_float4(0.f, 0.f, 0.f, 0.f);
      if (valid) v = *(const float4*)(src + (size_t)(kt * 64 + k) * N + sc);
      float* tp = tile + k * 65 + n4;
      tp[0] = v.x; tp[1] = v.y; tp[2] = v.z; tp[3] = v.w;
    }
  }
  __syncthreads();
  {
    const int nl = tid >> 3, kc = (tid & 7) * 8;
    u32x4 o;
#pragma unroll
    for (int j = 0; j < 4; ++j) o[j] = pack2(tile[(kc + 2 * j) * 65 + nl], tile[(kc + 2 * j + 1) * 65 + nl]);
    *(u32x4*)(dst + (size_t)(nt * 64 + nl) * K + kt * 64 + kc) = o;
  }
  __syncthreads();
}

DI void phase_setup(const Params& p, char* smem, int bid, int nblk) {
  const int tid = otid();
  constexpr int PER_LAYER = 5120;
  constexpr int N_CONV = 2 * PER_LAYER;
  constexpr int N_MOD = 288;
  const int total = N_CONV + N_MOD + 1;
  for (int it = bid; it < total; it += nblk) {
    if (it < N_CONV) {
      const int l = it / PER_LAYER;
      int i = it - l * PER_LAYER;
      bf16_t* wl = p.wts + (size_t)l * LAYER_W;
      float* tile = (float*)smem;
      if (i < 1408) { convert_tile(p.w_ffn1_in + (size_t)l * DM * 2 * DFF, DM, 2 * DFF, 1, wl + OFF_W1, i / 88, i % 88, tile); continue; }
      i -= 1408;
      if (i < 704) { convert_tile(p.w_ffn1_out + (size_t)l * DFF * DM, DFF, DM, 0, wl + OFF_W2, i / 16, i % 16, tile); continue; }
      i -= 704;
      if (i < 1408) { convert_tile(p.w_ffn2_in + (size_t)l * DM * 2 * DFF, DM, 2 * DFF, 1, wl + OFF_W3, i / 88, i % 88, tile); continue; }
      i -= 1408;
      if (i < 704) { convert_tile(p.w_ffn2_out + (size_t)l * DFF * DM, DFF, DM, 0, wl + OFF_W4, i / 16, i % 16, tile); continue; }
      i -= 704;
      if (i < 576) { convert_tile(p.w_in + (size_t)l * DM * 2208, DM, 2208, 0, wl + OFF_WIN, i / 36, i % 36, tile); continue; }
      i -= 576;
      if (i < 256) { convert_tile(p.w_out + (size_t)l * DM * DM, DM, DM, 0, wl + OFF_WOUT, i / 16, i % 16, tile); continue; }
      i -= 256;
      if (i < 32) { convert_tile(p.w_uq + (size_t)l * 256 * 384, 256, 384, 0, wl + OFF_WUQ, i / 8, i % 8, tile); continue; }
      i -= 32;
      if (i < 16) { convert_tile(p.w_ukv + (size_t)l * 128 * 512, 128, 512, 0, wl + OFF_WUKV, i / 8, i % 8, tile); continue; }
      i -= 16;
      {
        const float* s = p.w_spatial + (size_t)l * 65536 + (size_t)i * 4096;
        bf16_t* d = wl + OFF_WSP + (size_t)i * 4096;
        for (int e = tid; e < 4096; e += NTHREADS) d[e] = f2bf(s[e]);
      }
    } else if (it < N_CONV + N_MOD) {
      const int m = it - N_CONV;
      const int l = m / 144, cg64 = m % 144;
      float* s = (float*)smem;
      float* red = (float*)(smem + 36864);
      for (int e = tid; e < 9 * 1024; e += NTHREADS) {
        int b = e >> 10, k = e & 1023;
        float v = (b < 8) ? p.c[b * 1024 + k] : p.c_ctx[k];
        s[e] = silu(v);
      }
      __syncthreads();
      const int w = tid >> 6, lane = tid & 63;
      const int col = cg64 * 64 + lane;
      float acc[9];
#pragma unroll
      for (int b = 0; b < 9; ++b) acc[b] = 0.f;
      const float* wp = p.w_ada + (size_t)l * 1024 * 9216 + col;
      for (int k = w * 128; k < w * 128 + 128; ++k) {
        float wv = wp[(size_t)k * 9216];
#pragma unroll
        for (int b = 0; b < 9; ++b) acc[b] += s[b * 1024 + k] * wv;
      }
#pragma unroll
      for (int b = 0; b < 9; ++b) red[(w * 9 + b) * 64 + lane] = acc[b];
      __syncthreads();
      for (int e = tid; e < 9 * 64; e += NTHREADS) {
        int b = e >> 6, ln = e & 63;
        float t = 0.f;
#pragma unroll
        for (int ww = 0; ww < 8; ++ww) t += red[(ww * 9 + b) * 64 + ln];
        int cc = cg64 * 64 + ln;
        p.mods[((size_t)l * 9 + b) * 9216 + cc] = t + p.b_ada[(size_t)l * 9216 + cc];
      }
      __syncthreads();
    } else {
      for (int e = tid; e < 64 * 8; e += NTHREADS) {
        int pos = e >> 3, j = e & 7;
        float inv = powf(10000.f, -(float)(2 * j) / 16.f);
        float ang = (float)pos * inv;
        p.rope[e] = cosf(ang);
        p.rope[512 + e] = sinf(ang);
      }
      for (int e = tid; e < 64 * 16; e += NTHREADS) {
        int pos = e >> 4, j = e & 15;
        float inv = powf(10000.f, -(float)(2 * j) / 32.f);
        float ang = (float)pos * inv;
        p.rope[1024 + e] = cosf(ang);
        p.rope[2048 + e] = sinf(ang);
      }
    }
  }
}

DI void phase_rowpass(const Params& p, int bid, int nblk, int l_post, int j_post, float wres, int l_pre,
                              int j_pre, bool src_inputs, bool lat_only) {
  const int tid = otid(); const int lane = tid & 63, w = tid >> 6;
  const int gw = bid * 8 + w, nw = nblk * 8;
  const int nrows = lat_only ? NB * 4096 : MROWS;
  const bf16_t* y = p.r2;
  for (int ri = gw; ri < nrows; ri += nw) {
    int R = lat_only ? ((ri >> 12) * NT + 256 + (ri & 4095)) : ri;
    const int b = R / NT, t = R - b * NT;
    const bool isctx = t < 256;
    const int mrow = isctx ? 8 : b;
    const float* src;
    float* dst;
    if (isctx) {
      size_t o = ((size_t)b * 256 + t) * DM;
      src = src_inputs ? p.ctx + o : p.xctx + o;
      dst = p.xctx + o;
    } else {
      size_t o = ((size_t)b * 4096 + (t - 256)) * DM;
      src = src_inputs ? p.x + o : p.out + o;
      dst = p.out + o;
    }
    float xv[16];
#pragma unroll
    for (int c = 0; c < 4; ++c) {
      float4 v = *(const float4*)(src + c * 256 + lane * 4);
      xv[c * 4 + 0] = v.x; xv[c * 4 + 1] = v.y; xv[c * 4 + 2] = v.z; xv[c * 4 + 3] = v.w;
    }
    if (j_post >= 0) {
      float yv[16];
      float ss = 0.f;
#pragma unroll
      for (int c = 0; c < 4; ++c) {
        u32x2 u = *(const u32x2*)(y + (size_t)R * DM + c * 256 + lane * 4);
        yv[c * 4 + 0] = __uint_as_float(u[0] << 16);
        yv[c * 4 + 1] = __uint_as_float(u[0] & 0xffff0000u);
        yv[c * 4 + 2] = __uint_as_float(u[1] << 16);
        yv[c * 4 + 3] = __uint_as_float(u[1] & 0xffff0000u);
#pragma unroll
        for (int q = 0; q < 4; ++q) ss += yv[c * 4 + q] * yv[c * 4 + q];
      }
      ss = wave_sum(ss);
      const float rstd = rsqrtf(ss * (1.f / DM) + EPS) * wres;
      const float* gate = p.mods + ((size_t)l_post * 9 + mrow) * 9216 + (3 * j_post + 2) * DM;
      const float* gp = p.g_post + ((size_t)l_post * 3 + j_post) * DM;
#pragma unroll
      for (int c = 0; c < 4; ++c) {
        float4 g = *(const float4*)(gate + c * 256 + lane * 4);
        float4 gg = *(const float4*)(gp + c * 256 + lane * 4);
        xv[c * 4 + 0] += g.x * yv[c * 4 + 0] * rstd * gg.x;
        xv[c * 4 + 1] += g.y * yv[c * 4 + 1] * rstd * gg.y;
        xv[c * 4 + 2] += g.z * yv[c * 4 + 2] * rstd * gg.z;
        xv[c * 4 + 3] += g.w * yv[c * 4 + 3] * rstd * gg.w;
        *(float4*)(dst + c * 256 + lane * 4) = make_float4(xv[c * 4 + 0], xv[c * 4 + 1], xv[c * 4 + 2], xv[c * 4 + 3]);
      }
    }
    if (j_pre >= 0) {
      float ss = 0.f;
#pragma unroll
      for (int q = 0; q < 16; ++q) ss += xv[q] * xv[q];
      ss = wave_sum(ss);
      const float rstd = rsqrtf(ss * (1.f / DM) + EPS);
      const float* mb = p.mods + ((size_t)l_pre * 9 + mrow) * 9216;
      const float* shift = mb + (3 * j_pre) * DM;
      const float* scale = mb + (3 * j_pre + 1) * DM;
      const float* gp = p.g_pre + ((size_t)l_pre * 3 + j_pre) * DM;
#pragma unroll
      for (int c = 0; c < 4; ++c) {
        float4 sh = *(const float4*)(shift + c * 256 + lane * 4);
        float4 sc = *(const float4*)(scale + c * 256 + lane * 4);
        float4 gg = *(const float4*)(gp + c * 256 + lane * 4);
        float h0 = xv[c * 4 + 0] * rstd * gg.x * (1.f + sc.x) + sh.x;
        float h1 = xv[c * 4 + 1] * rstd * gg.y * (1.f + sc.y) + sh.y;
        float h2 = xv[c * 4 + 2] * rstd * gg.z * (1.f + sc.z) + sh.z;
        float h3 = xv[c * 4 + 3] * rstd * gg.w * (1.f + sc.w) + sh.w;
        u32x2 o;
        o[0] = pack2(h0, h1);
        o[1] = pack2(h2, h3);
        *(u32x2*)(p.h + (size_t)R * DM + c * 256 + lane * 4) = o;
      }
    }
  }
}

enum { EPI_SWIGLU = 0, EPI_Y = 1, EPI_WIN = 2, EPI_UQ = 3, EPI_UKV = 4 };

DI void gemm_mainloop(const bf16_t* __restrict__ A, int lda, const bf16_t* __restrict__ Bt, int ldb, int K, char* smem,
                      f32x16 (&acc)[4][2]) {
  const int tid = otid(), lane = tid & 63, w = tid >> 6, wm = w >> 2, wn = w & 3, r = lane & 31, hh = lane >> 5;
  const int lc = tid & 7, lr = tid >> 3;
  const bf16_t* ap = A + (size_t)lr * lda + lc * 8;
  const bf16_t* bp = Bt + (size_t)lr * ldb + lc * 8;
  const int st_off = lr * 128 + ((lc ^ ((lr >> 1) & 7)) << 4);
  u32x4 ra[4], rb[4];
#pragma unroll
  for (int i = 0; i < 4; ++i)
#pragma unroll
    for (int j = 0; j < 2; ++j)
#pragma unroll
      for (int e = 0; e < 16; ++e) acc[i][j][e] = 0.f;
  const int nk = K >> 6;
#pragma unroll
  for (int i = 0; i < 4; ++i) {
    ra[i] = *(const u32x4*)(ap + (size_t)i * 64 * lda);
    rb[i] = *(const u32x4*)(bp + (size_t)i * 64 * ldb);
  }
#pragma unroll
  for (int i = 0; i < 4; ++i) {
    *(u32x4*)(smem + st_off + i * 8192) = ra[i];
    *(u32x4*)(smem + 32768 + st_off + i * 8192) = rb[i];
  }
  __syncthreads();
  const int sw = (r >> 1) & 7;
#pragma unroll 1
  for (int kt = 0; kt < nk; ++kt) {
    char* cur = smem + (kt & 1) * 65536;
    const bool more = (kt + 1 < nk);
    if (more) {
      ap += 64;
      bp += 64;
#pragma unroll
      for (int i = 0; i < 4; ++i) {
        ra[i] = *(const u32x4*)(ap + (size_t)i * 64 * lda);
        rb[i] = *(const u32x4*)(bp + (size_t)i * 64 * ldb);
      }
    }
    const char* abase = cur + (wm * 128 + r) * 128;
    const char* bbase = cur + 32768 + (wn * 64 + r) * 128;
#pragma unroll
    for (int ks = 0; ks < 4; ++ks) {
      const int off = (((2 * ks + hh) ^ sw) << 4);
      bf16x8 af[4], bfr[2];
#pragma unroll
      for (int i = 0; i < 4; ++i) af[i] = *(const bf16x8*)(abase + i * 4096 + off);
#pragma unroll
      for (int j = 0; j < 2; ++j) bfr[j] = *(const bf16x8*)(bbase + j * 4096 + off);
#pragma unroll
      for (int i = 0; i < 4; ++i)
#pragma unroll
        for (int j = 0; j < 2; ++j) acc[i][j] = MFMA32(af[i], bfr[j], acc[i][j]);
    }
    if (more) {
      char* nxt = smem + ((kt + 1) & 1) * 65536;
#pragma unroll
      for (int i = 0; i < 4; ++i) {
        *(u32x4*)(nxt + st_off + i * 8192) = ra[i];
        *(u32x4*)(nxt + 32768 + st_off + i * 8192) = rb[i];
      }
    }
    __syncthreads();
  }
}

DI int lat_tile(int i) { return (i >> 4) * 17 + 1 + (i & 15); }

DI void gemm_tile(const Params& p, char* smem, int mode, int layer, const bf16_t* A, int lda, const bf16_t* Bt,
                          int K, int rt, int ct) {
  f32x16 acc[4][2];
  const int row0 = rt * 256, col0 = ct * 256;
  gemm_mainloop(A + (size_t)row0 * lda, lda, Bt + (size_t)col0 * K, K, K, smem, acc);
  const int tid = otid(), lane = tid & 63, w = tid >> 6, wm = w >> 2, wn = w & 3, r = lane & 31, hh = lane >> 5;
  const int rb = row0 + wm * 128, cb = col0 + wn * 64;
  const int b = row0 / NT;
  const int tb = rb - b * NT;
  if (mode == EPI_SWIGLU) {
    bf16_t* act = p.r1;
    const int oc = ct * 128 + wn * 32 + r;
#pragma unroll
    for (int i = 0; i < 4; ++i)
#pragma unroll
      for (int e = 0; e < 16; ++e) {
        float g = acc[i][0][e], u = acc[i][1][e];
        act[(size_t)(rb + i * 32 + crow(e, hh)) * DFF + oc] = f2bf(silu(g) * u);
      }
  } else if (mode == EPI_Y) {
    bf16_t* y = p.r2;
#pragma unroll
    for (int i = 0; i < 4; ++i)
#pragma unroll
      for (int j = 0; j < 2; ++j)
#pragma unroll
        for (int e = 0; e < 16; ++e)
          y[(size_t)(rb + i * 32 + crow(e, hh)) * DM + cb + j * 32 + r] = f2bf(acc[i][j][e]);
  } else if (mode == EPI_WIN) {
    const bool isAv = (cb >= 512 && cb < 768);
    const bool isBv = (cb >= 1152 && cb < 1280);
    if (isAv || isBv) {
      bf16_t* vt;
      if (isAv) vt = p.r2 + VAT_OFF + (size_t)((b * 4 + (cb - 512) / 64) * 64) * NT;
      else vt = p.r2 + VBT_OFF + (size_t)((b * 2 + (cb - 1152) / 64) * 64) * NT;
#pragma unroll
      for (int i = 0; i < 4; ++i)
#pragma unroll
        for (int j = 0; j < 2; ++j)
#pragma unroll
          for (int e4 = 0; e4 < 4; ++e4) {
            u32x2 o;
            o[0] = pack2(acc[i][j][e4 * 4 + 0], acc[i][j][e4 * 4 + 1]);
            o[1] = pack2(acc[i][j][e4 * 4 + 2], acc[i][j][e4 * 4 + 3]);
            int t = tb + i * 32 + 8 * e4 + 4 * hh;
            *(u32x2*)(vt + (size_t)(j * 32 + r) * NT + t) = o;
          }
    } else {
      bf16_t* pp = p.r1;
#pragma unroll
      for (int i = 0; i < 4; ++i)
#pragma unroll
        for (int j = 0; j < 2; ++j)
#pragma unroll
          for (int e = 0; e < 16; ++e)
            pp[(size_t)(rb + i * 32 + crow(e, hh)) * NIN + cb + j * 32 + r] = f2bf(acc[i][j][e]);
    }
  } else if (mode == EPI_UQ) {
    const float scale = 0.10206207261596577f * LOG2E;
    const bool isctx = tb < 256;
#pragma unroll
    for (int j = 0; j < 2; ++j) {
      const int n0 = cb + j * 32;
      if (n0 >= 384) continue;
      const int head = n0 / 96, seg = (n0 % 96) / 32;
      bf16_t* qd = p.r2 + QD_OFF + (size_t)(b * 4 + head) * NT * 96 + seg * 32 + r;
#pragma unroll
      for (int i = 0; i < 4; ++i)
#pragma unroll
        for (int e = 0; e < 16; ++e) {
          float v = acc[i][j][e];
          const int t = tb + i * 32 + crow(e, hh);
          if (seg == 2) {
            float pr = __shfl_xor(v, 8);
            if (!isctx) {
              const int pos = t - 256;
              const int pa = (r & 16) ? (pos & 63) : (pos >> 6);
              const float cs = p.rope[pa * 8 + (r & 7)], sn = p.rope[512 + pa * 8 + (r & 7)];
              v = v * cs + ((r & 8) ? pr : -pr) * sn;
            }
          }
          qd[(size_t)t * 96] = f2bf(v * scale);
        }
    }
  } else {
#pragma unroll
    for (int j = 0; j < 2; ++j) {
      const int n0 = cb + j * 32;
      const int head = n0 >> 7, wseg = n0 & 127;
      if (wseg < 64) {
        bf16_t* kd = p.r2 + KD_OFF + (size_t)(b * 4 + head) * NT * 96 + wseg + r;
#pragma unroll
        for (int i = 0; i < 4; ++i)
#pragma unroll
          for (int e = 0; e < 16; ++e) kd[(size_t)(tb + i * 32 + crow(e, hh)) * 96] = f2bf(acc[i][j][e]);
      } else {
        bf16_t* vt = p.r2 + VDT_OFF + (size_t)((b * 4 + head) * 64 + (wseg - 64) + r) * NT;
#pragma unroll
        for (int i = 0; i < 4; ++i)
#pragma unroll
          for (int e4 = 0; e4 < 4; ++e4) {
            u32x2 o;
            o[0] = pack2(acc[i][j][e4 * 4 + 0], acc[i][j][e4 * 4 + 1]);
            o[1] = pack2(acc[i][j][e4 * 4 + 2], acc[i][j][e4 * 4 + 3]);
            *(u32x2*)(vt + tb + i * 32 + 8 * e4 + 4 * hh) = o;
          }
      }
    }
  }
}

DI int xcd_vb(int bid, int nblk) {
  if (nblk & 7) return bid;
  return (bid & 7) * (nblk >> 3) + (bid >> 3);
}

DI void phase_gemm(const Params& p, char* smem, int bid, int nblk, int mode, int layer, const bf16_t* A, int lda,
                           const bf16_t* Bt, int K, int nct, bool lat_only) {
  const int nrt = lat_only ? 128 : 136;
  const int total = nrt * nct;
  for (int t = xcd_vb(bid, nblk); t < total; t += nblk) {
    int rti = t / nct, ct = t - rti * nct;
    int rt = lat_only ? lat_tile(rti) : rti;
    gemm_tile(p, smem, mode, layer, A, lda, Bt, K, rt, ct);
  }
}

DI void phase_rowprep(const Params& p, int bid, int nblk, int l) {
  const int tid = otid(); const int lane = tid & 63, w = tid >> 6;
  const int gw = bid * 8 + w, nw = nblk * 8;
  const float* ropeAc = p.rope;
  const float* ropeAs = p.rope + 512;
  const float* ropeBc = p.rope + 1024;
  const float* ropeBs = p.rope + 2048;
  const float gqn = p.g_qnorm[l * 64 + lane], gkn = p.g_knorm[l * 64 + lane];
  const float scaleA = 0.17677669529663687f * LOG2E;
  const float scaleB = 0.125f * LOG2E;
  for (int R = gw; R < MROWS; R += nw) {
    const int b = R / NT, t = R - b * NT;
    const bool isctx = t < 256;
    const int pos = t - 256;
    const int prow = pos >> 6, pcol = pos & 63;
    bf16_t* P = p.r1 + (size_t)R * NIN;
    {
      const int d = lane & 31;
      const int pa = (d & 16) ? pcol : prow;
      float cs = 1.f, sn = 0.f;
      if (!isctx) { cs = ropeAc[pa * 8 + (d & 7)]; sn = ropeAs[pa * 8 + (d & 7)]; }
      const float sg = (d & 8) ? 1.f : -1.f;
#pragma unroll
      for (int i = 0; i < 4; ++i) {
        const int e = i * 64 + lane;
        const int hm = e >> 5;
        float vq = bf2f(P[e]), vk = bf2f(P[256 + e]);
        float pq = __shfl_xor(vq, 8), pk = __shfl_xor(vk, 8);
        vq = vq * cs + sg * pq * sn;
        vk = vk * cs + sg * pk * sn;
        size_t o = ((size_t)(b * 8 + hm) * NT + t) * 32 + d;
        p.r2[QA_OFF + o] = f2bf(vq * scaleA);
        p.r2[KA_OFF + o] = f2bf(vk);
      }
    }
    {
      const int d = lane;
      const int pa = (d & 32) ? pcol : prow;
      float cs = 1.f, sn = 0.f;
      if (!isctx) { cs = ropeBc[pa * 16 + (d & 15)]; sn = ropeBs[pa * 16 + (d & 15)]; }
      const float sg = (d & 16) ? 1.f : -1.f;
#pragma unroll
      for (int i = 0; i < 6; ++i) {
        float v = bf2f(P[768 + i * 64 + lane]);
        float ss = wave_sum(v * v);
        v = v * rsqrtf(ss * (1.f / 64.f) + EPS) * (i < 4 ? gqn : gkn);
        float pr = __shfl_xor(v, 16);
        v = v * cs + sg * pr * sn;
        if (i < 4) p.r2[QB_OFF + ((size_t)(b * 4 + i) * NT + t) * 64 + d] = f2bf(v * scaleB);
        else p.r2[KB_OFF + ((size_t)(b * 2 + (i - 4)) * NT + t) * 64 + d] = f2bf(v);
      }
    }
    {
      float vv[4];
      float s1 = 0.f;
#pragma unroll
      for (int i = 0; i < 4; ++i) {
        const int e = i * 64 + lane;
        P[1280 + e] = f2bf(gelu_tanh(bf2f(P[1280 + e])));
        vv[i] = gelu_tanh(bf2f(P[1536 + e]));
        s1 += vv[i];
      }
      const float mu = wave_sum(s1) * (1.f / 256.f);
      float s2 = 0.f;
#pragma unroll
      for (int i = 0; i < 4; ++i) { vv[i] -= mu; s2 += vv[i] * vv[i]; }
      const float rstd = rsqrtf(wave_sum(s2) * (1.f / 256.f) + EPS);
#pragma unroll
      for (int i = 0; i < 4; ++i) {
        const int e = i * 64 + lane;
        P[1536 + e] = f2bf(vv[i] * rstd * p.ln_g[l * 256 + e] + p.ln_b[l * 256 + e]);
      }
    }
    {
      float v[4];
      float ss = 0.f;
#pragma unroll
      for (int i = 0; i < 4; ++i) { v[i] = bf2f(P[1792 + i * 64 + lane]); ss += v[i] * v[i]; }
      float rstd = rsqrtf(wave_sum(ss) * (1.f / 256.f) + EPS);
#pragma unroll
      for (int i = 0; i < 4; ++i) P[1792 + i * 64 + lane] = f2bf(v[i] * rstd * p.g_q_a[l * 256 + i * 64 + lane]);
      ss = 0.f;
#pragma unroll
      for (int i = 0; i < 2; ++i) { v[i] = bf2f(P[2048 + i * 64 + lane]); ss += v[i] * v[i]; }
      rstd = rsqrtf(wave_sum(ss) * (1.f / 128.f) + EPS);
#pragma unroll
      for (int i = 0; i < 2; ++i) P[2048 + i * 64 + lane] = f2bf(v[i] * rstd * p.g_kv_a[l * 128 + i * 64 + lane]);
      const int d = lane & 31;
      float kr = bf2f(P[2176 + d]);
      float pr = __shfl_xor(kr, 8);
      if (!isctx) {
        const int pa = (d & 16) ? pcol : prow;
        kr = kr * ropeAc[pa * 8 + (d & 7)] + ((d & 8) ? pr : -pr) * ropeAs[pa * 8 + (d & 7)];
      }
      if (lane < 32) {
        const bf16_t kb = f2bf(kr);
#pragma unroll
        for (int hd = 0; hd < 4; ++hd) p.r2[KD_OFF + ((size_t)(b * 4 + hd) * NT + t) * 96 + 64 + d] = kb;
      }
    }
  }
}

DI void gmlp_item(const Params& p, char* smem, int l, int ch, int g) {
  const int tid = otid(), lane = tid & 63, w = tid >> 6, r = lane & 31, hh = lane >> 5;
  const int R0 = ch * 128;
  bf16_t* vT = (bf16_t*)smem;
#pragma unroll
  for (int u = 0; u < 2; ++u) {
    const int cid = tid + u * NTHREADS;
    const int q = cid >> 3, cc = cid & 7;
    u32x4 v = *(const u32x4*)(p.r1 + (size_t)(R0 + q) * NIN + 1536 + g * 64 + cc * 8);
#pragma unroll
    for (int j = 0; j < 4; ++j) {
      vT[(cc * 8 + 2 * j) * 136 + q] = (bf16_t)(v[j] & 0xffffu);
      vT[(cc * 8 + 2 * j + 1) * 136 + q] = (bf16_t)(v[j] >> 16);
    }
  }
  __syncthreads();
  const int wp = w >> 1, wc = w & 1;
  const bf16_t* wsp = p.wts + (size_t)l * LAYER_W + OFF_WSP + (size_t)g * 16384;
  f32x16 acc;
#pragma unroll
  for (int e = 0; e < 16; ++e) acc[e] = 0.f;
#pragma unroll
  for (int ks = 0; ks < 8; ++ks) {
    bf16x8 a = *(const bf16x8*)(wsp + (wp * 32 + r) * 128 + ks * 16 + hh * 8);
    bf16x8 bb = *(const bf16x8*)(vT + (wc * 32 + r) * 136 + ks * 16 + hh * 8);
    acc = MFMA32(a, bb, acc);
  }
  const int c = g * 64 + wc * 32 + r;
#pragma unroll
  for (int e = 0; e < 16; ++e) {
    const int pp = wp * 32 + crow(e, hh);
    const float u = bf2f(p.r1[(size_t)(R0 + pp) * NIN + 1280 + c]);
    const float mixed = acc[e] + p.b_spatial[(size_t)l * 512 + g * 128 + pp];
    p.h[(size_t)(R0 + pp) * DM + 512 + c] = f2bf(u * mixed);
  }
  __syncthreads();
}

DI void phase_dexp_gmlp(const Params& p, char* smem, int bid, int nblk, int l) {
  const bool lat_only = (l == 1);
  const bf16_t* wl = p.wts + (size_t)l * LAYER_W;
  const int nch = lat_only ? 256 : 272;
  const int total = 272 + 272 + nch * 4;
  for (int t = xcd_vb(bid, nblk); t < total; t += nblk) {
    if (t < 272) {
      gemm_tile(p, smem, EPI_UQ, l, p.r1 + 1792, NIN, wl + OFF_WUQ, 256, t >> 1, t & 1);
    } else if (t < 544) {
      int u = t - 272;
      gemm_tile(p, smem, EPI_UKV, l, p.r1 + 2048, NIN, wl + OFF_WUKV, 128, u >> 1, u & 1);
    } else {
      int u = t - 544;
      int ci = u >> 2, g = u & 3;
      int ch = lat_only ? ((ci >> 5) * 34 + 2 + (ci & 31)) : ci;
      gmlp_item(p, smem, l, ch, g);
    }
  }
}

template <int DQK, int NMAP>
DI void attn_item(const bf16_t* __restrict__ Qb, const bf16_t* __restrict__ Kb, const bf16_t* __restrict__ Vt,
                          int q0, int nkeys, bf16_t* __restrict__ outp, char* smem, float lam, float post_scale,
                          const float* __restrict__ g_subln) {
  constexpr int KSTR = DQK * 2 + 16;
  constexpr int KBYTES = NMAP * 64 * KSTR;
  constexpr int VSTR = 136;
  constexpr int STAGE = KBYTES + 64 * VSTR;
  constexpr int CPR = DQK / 8;
  constexpr int NKCH = NMAP * 64 * CPR;
  constexpr int NKL = (NKCH + NTHREADS - 1) / NTHREADS;
  constexpr int KK = DQK / 16;
  const int tid = otid(), lane = tid & 63, w = tid >> 6, r = lane & 31, hh = lane >> 5;

  bf16x8 qf[NMAP][KK];
  {
    const int qrow = q0 + w * 32 + r;
#pragma unroll
    for (int m = 0; m < NMAP; ++m)
#pragma unroll
      for (int kk = 0; kk < KK; ++kk)
        qf[m][kk] = *(const bf16x8*)(Qb + (size_t)m * NT * DQK + (size_t)qrow * DQK + kk * 16 + hh * 8);
  }
  const bf16_t* ksrc[NKL];
  int kdst[NKL];
  bool kval[NKL];
#pragma unroll
  for (int u = 0; u < NKL; ++u) {
    const int cid = tid + u * NTHREADS;
    kval[u] = cid < NKCH;
    const int c = cid % CPR, key = (cid / CPR) & 63, m = cid / (CPR * 64);
    ksrc[u] = Kb + (size_t)m * NT * DQK + (size_t)key * DQK + c * 8;
    kdst[u] = m * 64 * KSTR + key * KSTR + c * 16;
  }
  const bf16_t* vsrc = Vt + (size_t)(tid >> 3) * NT + (tid & 7) * 8;
  const int vdst = KBYTES + (tid >> 3) * VSTR + (tid & 7) * 16;

  f32x16 O[NMAP][2];
  float mrun[NMAP], lrun[NMAP];
#pragma unroll
  for (int m = 0; m < NMAP; ++m) {
    mrun[m] = -INFINITY;
    lrun[m] = 0.f;
#pragma unroll
    for (int d = 0; d < 2; ++d)
#pragma unroll
      for (int e = 0; e < 16; ++e) O[m][d][e] = 0.f;
  }
  u32x4 kreg[NKL], vreg;
#pragma unroll
  for (int u = 0; u < NKL; ++u)
    if (kval[u]) kreg[u] = *(const u32x4*)(ksrc[u]);
  vreg = *(const u32x4*)(vsrc);
#pragma unroll
  for (int u = 0; u < NKL; ++u)
    if (kval[u]) *(u32x4*)(smem + kdst[u]) = kreg[u];
  {
    u32x2 lo, hi;
    lo[0] = vreg[0]; lo[1] = vreg[1]; hi[0] = vreg[2]; hi[1] = vreg[3];
    *(u32x2*)(smem + vdst) = lo;
    *(u32x2*)(smem + vdst + 8) = hi;
  }
  __syncthreads();
  const int nt = nkeys >> 6;
#pragma unroll 1
  for (int it = 0; it < nt; ++it) {
    const char* cur = smem + (it & 1) * STAGE;
    const bool more = it + 1 < nt;
    if (more) {
      const int k0 = (it + 1) * 64;
#pragma unroll
      for (int u = 0; u < NKL; ++u)
        if (kval[u]) kreg[u] = *(const u32x4*)(ksrc[u] + (size_t)k0 * DQK);
      vreg = *(const u32x4*)(vsrc + k0);
    }
    bf16x8 pb[NMAP][2][2];
#pragma unroll
    for (int m = 0; m < NMAP; ++m) {
      f32x16 S[2];
#pragma unroll
      for (int t2 = 0; t2 < 2; ++t2) {
#pragma unroll
        for (int e = 0; e < 16; ++e) S[t2][e] = 0.f;
#pragma unroll
        for (int kk = 0; kk < KK; ++kk) {
          bf16x8 a = *(const bf16x8*)(cur + m * 64 * KSTR + (t2 * 32 + r) * KSTR + kk * 32 + hh * 16);
          S[t2] = MFMA32(a, qf[m][kk], S[t2]);
        }
      }
      float mx = S[0][0];
#pragma unroll
      for (int t2 = 0; t2 < 2; ++t2)
#pragma unroll
        for (int e = 0; e < 16; ++e) mx = fmaxf(mx, S[t2][e]);
      mx = fmaxf(mx, __shfl_xor(mx, 32));
      const float mnew = fmaxf(mrun[m], mx);
      const float alpha = __builtin_amdgcn_exp2f(mrun[m] - mnew);
      mrun[m] = mnew;
      float sum = 0.f;
#pragma unroll
      for (int t2 = 0; t2 < 2; ++t2)
#pragma unroll
        for (int e = 0; e < 16; ++e) {
          float pv = __builtin_amdgcn_exp2f(S[t2][e] - mnew);
          S[t2][e] = pv;
          sum += pv;
        }
      sum += __shfl_xor(sum, 32);
      lrun[m] = lrun[m] * alpha + sum;
#pragma unroll
      for (int d = 0; d < 2; ++d)
#pragma unroll
        for (int e = 0; e < 16; ++e) O[m][d][e] *= alpha;
#pragma unroll
      for (int t2 = 0; t2 < 2; ++t2)
#pragma unroll
        for (int s = 0; s < 2; ++s) {
          u32x4 pk;
#pragma unroll
          for (int j = 0; j < 4; ++j) pk[j] = pack2(S[t2][8 * s + 2 * j], S[t2][8 * s + 2 * j + 1]);
          pb[m][t2][s] = __builtin_bit_cast(bf16x8, pk);
        }
    }
    const char* vs = cur + KBYTES;
#pragma unroll
    for (int d = 0; d < 2; ++d)
#pragma unroll
      for (int t2 = 0; t2 < 2; ++t2)
#pragma unroll
        for (int s = 0; s < 2; ++s) {
          const char* vp = vs + (d * 32 + r) * VSTR + (t2 * 32 + 16 * s + 4 * hh) * 2;
          u32x2 lo = *(const u32x2*)(vp);
          u32x2 hi = *(const u32x2*)(vp + 16);
          u32x4 vv;
          vv[0] = lo[0]; vv[1] = lo[1]; vv[2] = hi[0]; vv[3] = hi[1];
          bf16x8 vf = __builtin_bit_cast(bf16x8, vv);
#pragma unroll
          for (int m = 0; m < NMAP; ++m) O[m][d] = MFMA32(vf, pb[m][t2][s], O[m][d]);
        }
    if (more) {
      char* nxt = smem + ((it + 1) & 1) * STAGE;
#pragma unroll
      for (int u = 0; u < NKL; ++u)
        if (kval[u]) *(u32x4*)(nxt + kdst[u]) = kreg[u];
      u32x2 lo, hi;
      lo[0] = vreg[0]; lo[1] = vreg[1]; hi[0] = vreg[2]; hi[1] = vreg[3];
      *(u32x2*)(nxt + vdst) = lo;
      *(u32x2*)(nxt + vdst + 8) = hi;
    }
    __syncthreads();
  }
  bf16_t* orow = outp + (size_t)(w * 32 + r) * DM;
  if (NMAP == 1) {
    const float inv = 1.f / lrun[0];
#pragma unroll
    for (int d = 0; d < 2; ++d)
#pragma unroll
      for (int e4 = 0; e4 < 4; ++e4) {
        u32x2 o;
        o[0] = pack2(O[0][d][e4 * 4 + 0] * inv, O[0][d][e4 * 4 + 1] * inv);
        o[1] = pack2(O[0][d][e4 * 4 + 2] * inv, O[0][d][e4 * 4 + 3] * inv);
        *(u32x2*)(orow + d * 32 + 8 * e4 + 4 * hh) = o;
      }
  } else {
    const float i1 = 1.f / lrun[0], i2 = lam / lrun[NMAP - 1];
    float ss = 0.f;
#pragma unroll
    for (int d = 0; d < 2; ++d)
#pragma unroll
      for (int e = 0; e < 16; ++e) {
        float o = O[0][d][e] * i1 - O[NMAP - 1][d][e] * i2;
        O[0][d][e] = o;
        ss += o * o;
      }
    ss += __shfl_xor(ss, 32);
    const float rstd = rsqrtf(ss * (1.f / 64.f) + EPS) * post_scale;
#pragma unroll
    for (int d = 0; d < 2; ++d)
#pragma unroll
      for (int e4 = 0; e4 < 4; ++e4) {
        const int dv = d * 32 + 8 * e4 + 4 * hh;
        u32x2 o;
        o[0] = pack2(O[0][d][e4 * 4 + 0] * rstd * g_subln[dv + 0], O[0][d][e4 * 4 + 1] * rstd * g_subln[dv + 1]);
        o[1] = pack2(O[0][d][e4 * 4 + 2] * rstd * g_subln[dv + 2], O[0][d][e4 * 4 + 3] * rstd * g_subln[dv + 3]);
        *(u32x2*)(orow + dv) = o;
      }
  }
}

DI void phase_attn(const Params& p, char* smem, int bid, int nblk, int l) {
  const bool lat_only = (l == 1);
  const int nq = lat_only ? 16 : 17;
  const int per = NB * 4 * nq;
  const int total = 3 * per;
  const float lam_init = (l == 0) ? 0.2f : 0.35550906759096927f;
  float lam;
  {
    const float* lv = p.lam_vecs + l * 128;
    float s1 = 0.f, s2 = 0.f;
    for (int i = 0; i < 32; ++i) { s1 += lv[i] * lv[32 + i]; s2 += lv[64 + i] * lv[96 + i]; }
    lam = expf(s1) - expf(s2) + lam_init;
  }
  for (int t = xcd_vb(bid, nblk); t < total; t += nblk) {
    const int mixer = t / per;
    int u = t - mixer * per;
    const int bh = u / nq;
    int qb = u - bh * nq;
    if (lat_only) qb += 1;
    const int b = bh >> 2, hd = bh & 3;
    const int q0 = qb * 256;
    const int nkeys = (qb == 0) ? 256 : NT;
    bf16_t* mixrow = p.h + ((size_t)b * NT + q0) * DM;
    if (mixer == 0) {
      attn_item<32, 2>(p.r2 + QA_OFF + (size_t)(b * 4 + hd) * 2 * NT * 32, p.r2 + KA_OFF + (size_t)(b * 4 + hd) * 2 * NT * 32,
                       p.r2 + VAT_OFF + (size_t)(b * 4 + hd) * 64 * NT, q0, nkeys, mixrow + hd * 64, smem, lam,
                       1.f - lam_init, p.g_subln + l * 64);
    } else if (mixer == 1) {
      attn_item<96, 1>(p.r2 + QD_OFF + (size_t)(b * 4 + hd) * NT * 96, p.r2 + KD_OFF + (size_t)(b * 4 + hd) * NT * 96,
                       p.r2 + VDT_OFF + (size_t)(b * 4 + hd) * 64 * NT, q0, nkeys, mixrow + 768 + hd * 64, smem, 0.f, 0.f,
                       nullptr);
    } else {
      attn_item<64, 1>(p.r2 + QB_OFF + (size_t)(b * 4 + hd) * NT * 64, p.r2 + KB_OFF + (size_t)(b * 2 + (hd >> 1)) * NT * 64,
                       p.r2 + VBT_OFF + (size_t)(b * 2 + (hd >> 1)) * 64 * NT, q0, nkeys, mixrow + 256 + hd * 64, smem, 0.f,
                       0.f, nullptr);
    }
  }
}

constexpr int N_PHASES = 26;
#ifndef PMASK
#define PMASK 0xffff
#endif
#define PM(k) ((PMASK >> (k)) & 1)

__global__ void __launch_bounds__(NTHREADS) trunk_megakernel(Params p) {
  __shared__ __attribute__((aligned(16))) char smem[131072];
  cg::grid_group grid = cg::this_grid();
  const int bid = blockIdx.x, nblk = gridDim.x;
#pragma unroll 1
  for (int ph = p.phase_lo; ph < p.phase_hi; ++ph) {
    if (ph == 0) {
      if (PM(12)) phase_setup(p, smem, bid, nblk);
    } else if (ph == 1) {
      if (PM(13)) phase_rowpass(p, bid, nblk, 0, -1, 0.f, 0, 0, true, false);
    } else {
      const int l = (ph - 2) / 12, s = (ph - 2) % 12;
      const bf16_t* wl = p.wts + (size_t)l * LAYER_W;
      const bool lo = (l == 1);
      switch (s) {
        case 0: if (PM(0)) phase_gemm(p, smem, bid, nblk, EPI_SWIGLU, l, p.h, DM, wl + OFF_W1, DM, 22, false); break;
        case 1: if (PM(1)) phase_gemm(p, smem, bid, nblk, EPI_Y, l, p.r1, DFF, wl + OFF_W2, DFF, 4, false); break;
        case 2: if (PM(2)) phase_rowpass(p, bid, nblk, l, 0, 0.5f, l, 1, l == 0, false); break;
        case 3: if (PM(3)) phase_gemm(p, smem, bid, nblk, EPI_WIN, l, p.h, DM, wl + OFF_WIN, DM, 9, false); break;
        case 4: if (PM(4)) phase_rowprep(p, bid, nblk, l); break;
        case 5: if (PM(5)) phase_dexp_gmlp(p, smem, bid, nblk, l); break;
        case 6: if (PM(6)) phase_attn(p, smem, bid, nblk, l); break;
        case 7: if (PM(7)) phase_gemm(p, smem, bid, nblk, EPI_Y, l, p.h, DM, wl + OFF_WOUT, DM, 4, lo); break;
        case 8: if (PM(8)) phase_rowpass(p, bid, nblk, l, 1, 1.0f, l, 2, false, lo); break;
        case 9: if (PM(9)) phase_gemm(p, smem, bid, nblk, EPI_SWIGLU, l, p.h, DM, wl + OFF_W3, DM, 22, lo); break;
        case 10: if (PM(10)) phase_gemm(p, smem, bid, nblk, EPI_Y, l, p.r1, DFF, wl + OFF_W4, DFF, 4, lo); break;
        default: if (PM(11)) phase_rowpass(p, bid, nblk, l, 2, 0.5f, l + 1, (l == 0) ? 0 : -1, false, lo); break;
      }
    }
    if (ph + 1 < p.phase_hi) grid.sync();
  }
}

extern "C" void kernel_launch(void* const* d_in, const int* in_sizes, int n_in, void* d_out, int out_size, void* d_ws,
                              size_t ws_size, hipStream_t stream) {
  static int grid_blocks = 0;
  if (!grid_blocks) {
    int dev = 0, cus = 0, per_cu = 0;
    hipGetDevice(&dev);
    hipDeviceGetAttribute(&cus, hipDeviceAttributeMultiprocessorCount, dev);
    hipOccupancyMaxActiveBlocksPerMultiprocessor(&per_cu, trunk_megakernel, NTHREADS, 0);
    if (per_cu < 1) per_cu = 1;
    if (per_cu > 1) per_cu = 1;
    grid_blocks = cus * per_cu;
  }
  Params p{};
  const float** pf = (const float**)&p;
  for (int i = 0; i < 26; ++i) pf[i] = (const float*)d_in[i];
  p.out = (float*)d_out;
  char* ws = (char*)d_ws;
  size_t off = 0;
  auto take = [&](size_t bytes) { char* q = ws + off; off += (bytes + 255) & ~(size_t)255; return q; };
  p.wts = (bf16_t*)take(2 * LAYER_W * 2);
  p.mods = (float*)take((size_t)2 * 9 * 9216 * 4);
  p.rope = (float*)take(3072 * 4);
  p.xctx = (float*)take((size_t)2048 * 1024 * 4);
  p.h = (bf16_t*)take((size_t)MROWS * DM * 2);
  p.r1 = (bf16_t*)take((size_t)MROWS * DFF * 2);
  p.r2 = (bf16_t*)take((size_t)MROWS * NIN * 2);
  if (off > ws_size) fprintf(stderr, "workspace too small: need %zu have %zu\n", off, ws_size);
#if MULTI_LAUNCH
  for (int ph = 0; ph < N_PHASES; ++ph) {
    Params q = p;
    q.phase_lo = ph;
    q.phase_hi = ph + 1;
    void* args[] = {&q};
    hipError_t e = hipLaunchCooperativeKernel((void*)trunk_megakernel, dim3(grid_blocks), dim3(NTHREADS), args, 0, stream);
    if (e != hipSuccess) fprintf(stderr, "launch failed: %s\n", hipGetErrorString(e));
  }
#else
  p.phase_lo = 0;
  p.phase_hi = N_PHASES;
  void* args[] = {&p};
  hipError_t e = hipLaunchCooperativeKernel((void*)trunk_megakernel, dim3(grid_blocks), dim3(NTHREADS), args, 0, stream);
  if (e != hipSuccess) fprintf(stderr, "cooperative launch failed: %s (grid %d)\n", hipGetErrorString(e), grid_blocks);
#endif
}
```

```cpp
#include <hip/hip_runtime.h>
#include <hip/hip_cooperative_groups.h>
#include <stdint.h>
#include <cstdio>
namespace cg = cooperative_groups;

#ifndef MULTI_LAUNCH
#define MULTI_LAUNCH 0
#endif

typedef unsigned short bf16_t;
using bf16x8 = __attribute__((ext_vector_type(8))) short;
using f32x16 = __attribute__((ext_vector_type(16))) float;
using u32x4 = __attribute__((ext_vector_type(4))) unsigned;
using u32x2 = __attribute__((ext_vector_type(2))) unsigned;

#define DI __device__ __forceinline__
#define MFMA32(a, b, c) __builtin_amdgcn_mfma_f32_32x32x16_bf16((a), (b), (c), 0, 0, 0)

constexpr int NT = 4352;
constexpr int NB = 8;
constexpr int MROWS = NB * NT;
constexpr int DM = 1024;
constexpr int DFF = 2816;
constexpr int NIN = 2304;
constexpr int NTHREADS = 512;
constexpr float EPS = 1e-6f;
constexpr float LOG2E = 1.4426950408889634f;

constexpr size_t OFF_W1 = 0;
constexpr size_t OFF_W2 = 5767168;
constexpr size_t OFF_W3 = 8650752;
constexpr size_t OFF_W4 = 14417920;
constexpr size_t OFF_WIN = 17301504;
constexpr size_t OFF_WOUT = 19660800;
constexpr size_t OFF_WUQ = 20709376;
constexpr size_t OFF_WUKV = 20840448;
constexpr size_t OFF_WSP = 20905984;
constexpr size_t LAYER_W = 20971520;

constexpr size_t QA_OFF = 0;
constexpr size_t KA_OFF = 8912896;
constexpr size_t VAT_OFF = 17825792;
constexpr size_t QB_OFF = 26738688;
constexpr size_t KB_OFF = 35651584;
constexpr size_t VBT_OFF = 40108032;
constexpr size_t QD_OFF = 44564480;
constexpr size_t KD_OFF = 57933824;
constexpr size_t VDT_OFF = 71303168;

struct Params {
  const float *x, *c, *ctx, *c_ctx, *w_ada, *b_ada, *g_pre, *g_post, *w_ffn1_in, *w_ffn1_out, *w_ffn2_in,
      *w_ffn2_out, *w_in, *w_out, *lam_vecs, *g_subln, *g_qnorm, *g_knorm, *w_spatial, *b_spatial, *ln_g, *ln_b,
      *g_q_a, *w_uq, *g_kv_a, *w_ukv;
  float* out;
  bf16_t* wts;
  float* mods;
  float* rope;
  float* xctx;
  bf16_t* h;
  bf16_t* r1;
  bf16_t* r2;
  unsigned* bar;
  int phase_lo, phase_hi;
};

DI int otid() { int t = threadIdx.x; asm volatile("" : "+v"(t)); return t; }
DI float bf2f(bf16_t v) { return __uint_as_float(((unsigned)v) << 16); }
DI bf16_t f2bf(float f) { __bf16 b = (__bf16)f; return __builtin_bit_cast(unsigned short, b); }
DI unsigned pack2(float a, float b) { return (unsigned)f2bf(a) | ((unsigned)f2bf(b) << 16); }
DI int crow(int e, int hh) { return (e & 3) + 8 * (e >> 2) + 4 * hh; }
DI float wave_sum(float v) {
#pragma unroll
  for (int o = 32; o >= 1; o >>= 1) v += __shfl_xor(v, o);
  return v;
}
DI float gelu_tanh(float x) {
  float u = 0.7978845608028654f * (x + 0.044715f * x * x * x);
  return 0.5f * x * (1.f + tanhf(u));
}
DI float silu(float x) { return x / (1.f + __expf(-x)); }

DI void convert_tile(const float* __restrict__ src, int K, int N, int mode, bf16_t* __restrict__ dst, int kt, int nt,
                     float* tile) {
  const int tid = otid();
  {
    const int kl = tid >> 4, n4 = (tid & 15) * 4;
    const int np = nt * 64 + n4;
    int sc = np;
    if (mode == 1) {
      int j = (np >> 7) & 1, tl = np >> 8, cc = np & 127;
      sc = j * DFF + tl * 128 + cc;
    }
    const bool valid = (mode == 1) || (np < N);
#pragma unroll
    for (int half = 0; half < 2; ++half) {
      int k = kl + 32 * half;
      float4 v = make_float4(0.f, 0.f, 0.f, 0.f);
      if (valid) v = *(const float4*)(src + (size_t)(kt * 64 + k) * N + sc);
      float* tp = tile + k * 65 + n4;
      tp[0] = v.x; tp[1] = v.y; tp[2] = v.z; tp[3] = v.w;
    }
  }
  __syncthreads();
  {
    const int nl = tid >> 3, kc = (tid & 7) * 8;
    u32x4 o;
#pragma unroll
    for (int j = 0; j < 4; ++j) o[j] = pack2(tile[(kc + 2 * j) * 65 + nl], tile[(kc + 2 * j + 1) * 65 + nl]);
    *(u32x4*)(dst + (size_t)(nt * 64 + nl) * K + kt * 64 + kc) = o;
  }
  __syncthreads();
}

DI void phase_setup(const Params& p, char* smem, int bid, int nblk) {
  const int tid = otid();
  constexpr int PER_LAYER = 5120;
  constexpr int N_CONV = 2 * PER_LAYER;
  constexpr int N_MOD = 288;
  const int total = N_CONV + N_MOD + 1;
  for (int it = bid; it < total; it += nblk) {
    if (it < N_CONV) {
      const int l = it / PER_LAYER;
      int i = it - l * PER_LAYER;
      bf16_t* wl = p.wts + (size_t)l * LAYER_W;
      float* tile = (float*)smem;
      if (i < 1408) { convert_tile(p.w_ffn1_in + (size_t)l * DM * 2 * DFF, DM, 2 * DFF, 1, wl + OFF_W1, i / 88, i % 88, tile); continue; }
      i -= 1408;
      if (i < 704) { convert_tile(p.w_ffn1_out + (size_t)l * DFF * DM, DFF, DM, 0, wl + OFF_W2, i / 16, i % 16, tile); continue; }
      i -= 704;
      if (i < 1408) { convert_tile(p.w_ffn2_in + (size_t)l * DM * 2 * DFF, DM, 2 * DFF, 1, wl + OFF_W3, i / 88, i % 88, tile); continue; }
      i -= 1408;
      if (i < 704) { convert_tile(p.w_ffn2_out + (size_t)l * DFF * DM, DFF, DM, 0, wl + OFF_W4, i / 16, i % 16, tile); continue; }
      i -= 704;
      if (i < 576) { convert_tile(p.w_in + (size_t)l * DM * 2208, DM, 2208, 0, wl + OFF_WIN, i / 36, i % 36, tile); continue; }
      i -= 576;
      if (i < 256) { convert_tile(p.w_out + (size_t)l * DM * DM, DM, DM, 0, wl + OFF_WOUT, i / 16, i % 16, tile); continue; }
      i -= 256;
      if (i < 32) { convert_tile(p.w_uq + (size_t)l * 256 * 384, 256, 384, 0, wl + OFF_WUQ, i / 8, i % 8, tile); continue; }
      i -= 32;
      if (i < 16) { convert_tile(p.w_ukv + (size_t)l * 128 * 512, 128, 512, 0, wl + OFF_WUKV, i / 8, i % 8, tile); continue; }
      i -= 16;
      {
        const float* s = p.w_spatial + (size_t)l * 65536 + (size_t)i * 4096;
        bf16_t* d = wl + OFF_WSP + (size_t)i * 4096;
        for (int e = tid; e < 4096; e += NTHREADS) d[e] = f2bf(s[e]);
      }
    } else if (it < N_CONV + N_MOD) {
      const int m = it - N_CONV;
      const int l = m / 144, cg64 = m % 144;
      float* s = (float*)smem;
      float* red = (float*)(smem + 36864);
      for (int e = tid; e < 9 * 1024; e += NTHREADS) {
        int b = e >> 10, k = e & 1023;
        float v = (b < 8) ? p.c[b * 1024 + k] : p.c_ctx[k];
        s[e] = silu(v);
      }
      __syncthreads();
      const int w = tid >> 6, lane = tid & 63;
      const int col = cg64 * 64 + lane;
      float acc[9];
#pragma unroll
      for (int b = 0; b < 9; ++b) acc[b] = 0.f;
      const float* wp = p.w_ada + (size_t)l * 1024 * 9216 + col;
      for (int k = w * 128; k < w * 128 + 128; ++k) {
        float wv = wp[(size_t)k * 9216];
#pragma unroll
        for (int b = 0; b < 9; ++b) acc[b] += s[b * 1024 + k] * wv;
      }
#pragma unroll
      for (int b = 0; b < 9; ++b) red[(w * 9 + b) * 64 + lane] = acc[b];
      __syncthreads();
      for (int e = tid; e < 9 * 64; e += NTHREADS) {
        int b = e >> 6, ln = e & 63;
        float t = 0.f;
#pragma unroll
        for (int ww = 0; ww < 8; ++ww) t += red[(ww * 9 + b) * 64 + ln];
        int cc = cg64 * 64 + ln;
        p.mods[((size_t)l * 9 + b) * 9216 + cc] = t + p.b_ada[(size_t)l * 9216 + cc];
      }
      __syncthreads();
    } else {
      for (int e = tid; e < 64 * 8; e += NTHREADS) {
        int pos = e >> 3, j = e & 7;
        float inv = powf(10000.f, -(float)(2 * j) / 16.f);
        float ang = (float)pos * inv;
        p.rope[e] = cosf(ang);
        p.rope[512 + e] = sinf(ang);
      }
      for (int e = tid; e < 64 * 16; e += NTHREADS) {
        int pos = e >> 4, j = e & 15;
        float inv = powf(10000.f, -(float)(2 * j) / 32.f);
        float ang = (float)pos * inv;
        p.rope[1024 + e] = cosf(ang);
        p.rope[2048 + e] = sinf(ang);
      }
    }
  }
}

DI void phase_rowpass(const Params& p, int bid, int nblk, int l_post, int j_post, float wres, int l_pre,
                              int j_pre, bool src_inputs, bool lat_only) {
  const int tid = otid(); const int lane = tid & 63, w = tid >> 6;
  const int gw = bid * 8 + w, nw = nblk * 8;
  const int nrows = lat_only ? NB * 4096 : MROWS;
  const bf16_t* y = p.r2;
  for (int ri = gw; ri < nrows; ri += nw) {
    int R = lat_only ? ((ri >> 12) * NT + 256 + (ri & 4095)) : ri;
    const int b = R / NT, t = R - b * NT;
    const bool isctx = t < 256;
    const int mrow = isctx ? 8 : b;
    const float* src;
    float* dst;
    if (isctx) {
      size_t o = ((size_t)b * 256 + t) * DM;
      src = src_inputs ? p.ctx + o : p.xctx + o;
      dst = p.xctx + o;
    } else {
      size_t o = ((size_t)b * 4096 + (t - 256)) * DM;
      src = src_inputs ? p.x + o : p.out + o;
      dst = p.out + o;
    }
    float xv[16];
#pragma unroll
    for (int c = 0; c < 4; ++c) {
      float4 v = *(const float4*)(src + c * 256 + lane * 4);
      xv[c * 4 + 0] = v.x; xv[c * 4 + 1] = v.y; xv[c * 4 + 2] = v.z; xv[c * 4 + 3] = v.w;
    }
    if (j_post >= 0) {
      float yv[16];
      float ss = 0.f;
#pragma unroll
      for (int c = 0; c < 4; ++c) {
        u32x2 u = *(const u32x2*)(y + (size_t)R * DM + c * 256 + lane * 4);
        yv[c * 4 + 0] = __uint_as_float(u[0] << 16);
        yv[c * 4 + 1] = __uint_as_float(u[0] & 0xffff0000u);
        yv[c * 4 + 2] = __uint_as_float(u[1] << 16);
        yv[c * 4 + 3] = __uint_as_float(u[1] & 0xffff0000u);
#pragma unroll
        for (int q = 0; q < 4; ++q) ss += yv[c * 4 + q] * yv[c * 4 + q];
      }
      ss = wave_sum(ss);
      const float rstd = rsqrtf(ss * (1.f / DM) + EPS) * wres;
      const float* gate = p.mods + ((size_t)l_post * 9 + mrow) * 9216 + (3 * j_post + 2) * DM;
      const float* gp = p.g_post + ((size_t)l_post * 3 + j_post) * DM;
#pragma unroll
      for (int c = 0; c < 4; ++c) {
        float4 g = *(const float4*)(gate + c * 256 + lane * 4);
        float4 gg = *(const float4*)(gp + c * 256 + lane * 4);
        xv[c * 4 + 0] += g.x * yv[c * 4 + 0] * rstd * gg.x;
        xv[c * 4 + 1] += g.y * yv[c * 4 + 1] * rstd * gg.y;
        xv[c * 4 + 2] += g.z * yv[c * 4 + 2] * rstd * gg.z;
        xv[c * 4 + 3] += g.w * yv[c * 4 + 3] * rstd * gg.w;
        *(float4*)(dst + c * 256 + lane * 4) = make_float4(xv[c * 4 + 0], xv[c * 4 + 1], xv[c * 4 + 2], xv[c * 4 + 3]);
      }
    }
    if (j_pre >= 0) {
      float ss = 0.f;
#pragma unroll
      for (int q = 0; q < 16; ++q) ss += xv[q] * xv[q];
      ss = wave_sum(ss);
      const float rstd = rsqrtf(ss * (1.f / DM) + EPS);
      const float* mb = p.mods + ((size_t)l_pre * 9 + mrow) * 9216;
      const float* shift = mb + (3 * j_pre) * DM;
      const float* scale = mb + (3 * j_pre + 1) * DM;
      const float* gp = p.g_pre + ((size_t)l_pre * 3 + j_pre) * DM;
#pragma unroll
      for (int c = 0; c < 4; ++c) {
        float4 sh = *(const float4*)(shift + c * 256 + lane * 4);
        float4 sc = *(const float4*)(scale + c * 256 + lane * 4);
        float4 gg = *(const float4*)(gp + c * 256 + lane * 4);
        float h0 = xv[c * 4 + 0] * rstd * gg.x * (1.f + sc.x) + sh.x;
        float h1 = xv[c * 4 + 1] * rstd * gg.y * (1.f + sc.y) + sh.y;
        float h2 = xv[c * 4 + 2] * rstd * gg.z * (1.f + sc.z) + sh.z;
        float h3 = xv[c * 4 + 3] * rstd * gg.w * (1.f + sc.w) + sh.w;
        u32x2 o;
        o[0] = pack2(h0, h1);
        o[1] = pack2(h2, h3);
        *(u32x2*)(p.h + (size_t)R * DM + c * 256 + lane * 4) = o;
      }
    }
  }
}

enum { EPI_SWIGLU = 0, EPI_Y = 1, EPI_WIN = 2, EPI_UQ = 3, EPI_UKV = 4 };

DI void gemm_mainloop(const bf16_t* __restrict__ A, int lda, const bf16_t* __restrict__ Bt, int ldb, int K, char* smem,
                      f32x16 (&acc)[4][2]) {
  const int tid = otid(), lane = tid & 63, w = tid >> 6, wm = w >> 2, wn = w & 3, r = lane & 31, hh = lane >> 5;
  const int lc = tid & 7, lr = tid >> 3;
  const bf16_t* ap = A + (size_t)lr * lda + lc * 8;
  const bf16_t* bp = Bt + (size_t)lr * ldb + lc * 8;
  const int st_off = lr * 128 + ((lc ^ ((lr >> 1) & 7)) << 4);
  u32x4 ra[4], rb[4];
#pragma unroll
  for (int i = 0; i < 4; ++i)
#pragma unroll
    for (int j = 0; j < 2; ++j)
#pragma unroll
      for (int e = 0; e < 16; ++e) acc[i][j][e] = 0.f;
  const int nk = K >> 6;
#pragma unroll
  for (int i = 0; i < 4; ++i) {
    ra[i] = *(const u32x4*)(ap + (size_t)i * 64 * lda);
    rb[i] = *(const u32x4*)(bp + (size_t)i * 64 * ldb);
  }
#pragma unroll
  for (int i = 0; i < 4; ++i) {
    *(u32x4*)(smem + st_off + i * 8192) = ra[i];
    *(u32x4*)(smem + 32768 + st_off + i * 8192) = rb[i];
  }
  __syncthreads();
  const int sw = (r >> 1) & 7;
#pragma unroll 1
  for (int kt = 0; kt < nk; ++kt) {
    char* cur = smem + (kt & 1) * 65536;
    const bool more = (kt + 1 < nk);
    if (more) {
      ap += 64;
      bp += 64;
#pragma unroll
      for (int i = 0; i < 4; ++i) {
        ra[i] = *(const u32x4*)(ap + (size_t)i * 64 * lda);
        rb[i] = *(const u32x4*)(bp + (size_t)i * 64 * ldb);
      }
    }
    const char* abase = cur + (wm * 128 + r) * 128;
    const char* bbase = cur + 32768 + (wn * 64 + r) * 128;
#pragma unroll
    for (int ks = 0; ks < 4; ++ks) {
      const int off = (((2 * ks + hh) ^ sw) << 4);
      bf16x8 af[4], bfr[2];
#pragma unroll
      for (int i = 0; i < 4; ++i) af[i] = *(const bf16x8*)(abase + i * 4096 + off);
#pragma unroll
      for (int j = 0; j < 2; ++j) bfr[j] = *(const bf16x8*)(bbase + j * 4096 + off);
#pragma unroll
      for (int i = 0; i < 4; ++i)
#pragma unroll
        for (int j = 0; j < 2; ++j) acc[i][j] = MFMA32(af[i], bfr[j], acc[i][j]);
    }
    if (more) {
      char* nxt = smem + ((kt + 1) & 1) * 65536;
#pragma unroll
      for (int i = 0; i < 4; ++i) {
        *(u32x4*)(nxt + st_off + i * 8192) = ra[i];
        *(u32x4*)(nxt + 32768 + st_off + i * 8192) = rb[i];
      }
    }
    __syncthreads();
  }
}

DI int lat_tile(int i) { return (i >> 4) * 17 + 1 + (i & 15); }

DI void gemm_tile(const Params& p, char* smem, int mode, int layer, const bf16_t* A, int lda, const bf16_t* Bt,
                          int K, int rt, int ct) {
  f32x16 acc[4][2];
  const int row0 = rt * 256, col0 = ct * 256;
  gemm_mainloop(A + (size_t)row0 * lda, lda, Bt + (size_t)col0 * K, K, K, smem, acc);
  const int tid = otid(), lane = tid & 63, w = tid >> 6, wm = w >> 2, wn = w & 3, r = lane & 31, hh = lane >> 5;
  const int rb = row0 + wm * 128, cb = col0 + wn * 64;
  const int b = row0 / NT;
  const int tb = rb - b * NT;
  if (mode == EPI_SWIGLU) {
    bf16_t* act = p.r1;
    const int oc = ct * 128 + wn * 32 + r;
#pragma unroll
    for (int i = 0; i < 4; ++i)
#pragma unroll
      for (int e = 0; e < 16; ++e) {
        float g = acc[i][0][e], u = acc[i][1][e];
        act[(size_t)(rb + i * 32 + crow(e, hh)) * DFF + oc] = f2bf(silu(g) * u);
      }
  } else if (mode == EPI_Y) {
    bf16_t* y = p.r2;
#pragma unroll
    for (int i = 0; i < 4; ++i)
#pragma unroll
      for (int j = 0; j < 2; ++j)
#pragma unroll
        for (int e = 0; e < 16; ++e)
          y[(size_t)(rb + i * 32 + crow(e, hh)) * DM + cb + j * 32 + r] = f2bf(acc[i][j][e]);
  } else if (mode == EPI_WIN) {
    const bool isAv = (cb >= 512 && cb < 768);
    const bool isBv = (cb >= 1152 && cb < 1280);
    if (isAv || isBv) {
      bf16_t* vt;
      if (isAv) vt = p.r2 + VAT_OFF + (size_t)((b * 4 + (cb - 512) / 64) * 64) * NT;
      else vt = p.r2 + VBT_OFF + (size_t)((b * 2 + (cb - 1152) / 64) * 64) * NT;
#pragma unroll
      for (int i = 0; i < 4; ++i)
#pragma unroll
        for (int j = 0; j < 2; ++j)
#pragma unroll
          for (int e4 = 0; e4 < 4; ++e4) {
            u32x2 o;
            o[0] = pack2(acc[i][j][e4 * 4 + 0], acc[i][j][e4 * 4 + 1]);
            o[1] = pack2(acc[i][j][e4 * 4 + 2], acc[i][j][e4 * 4 + 3]);
            int t = tb + i * 32 + 8 * e4 + 4 * hh;
            *(u32x2*)(vt + (size_t)(j * 32 + r) * NT + t) = o;
          }
    } else {
      bf16_t* pp = p.r1;
#pragma unroll
      for (int i = 0; i < 4; ++i)
#pragma unroll
        for (int j = 0; j < 2; ++j)
#pragma unroll
          for (int e = 0; e < 16; ++e)
            pp[(size_t)(rb + i * 32 + crow(e, hh)) * NIN + cb + j * 32 + r] = f2bf(acc[i][j][e]);
    }
  } else if (mode == EPI_UQ) {
    const float scale = 0.10206207261596577f * LOG2E;
    const bool isctx = tb < 256;
#pragma unroll
    for (int j = 0; j < 2; ++j) {
      const int n0 = cb + j * 32;
      if (n0 >= 384) continue;
      const int head = n0 / 96, seg = (n0 % 96) / 32;
      bf16_t* qd = p.r2 + QD_OFF + (size_t)(b * 4 + head) * NT * 96 + seg * 32 + r;
#pragma unroll
      for (int i = 0; i < 4; ++i)
#pragma unroll
        for (int e = 0; e < 16; ++e) {
          float v = acc[i][j][e];
          const int t = tb + i * 32 + crow(e, hh);
          if (seg == 2) {
            float pr = __shfl_xor(v, 8);
            if (!isctx) {
              const int pos = t - 256;
              const int pa = (r & 16) ? (pos & 63) : (pos >> 6);
              const float cs = p.rope[pa * 8 + (r & 7)], sn = p.rope[512 + pa * 8 + (r & 7)];
              v = v * cs + ((r & 8) ? pr : -pr) * sn;
            }
          }
          qd[(size_t)t * 96] = f2bf(v * scale);
        }
    }
  } else {
#pragma unroll
    for (int j = 0; j < 2; ++j) {
      const int n0 = cb + j * 32;
      const int head = n0 >> 7, wseg = n0 & 127;
      if (wseg < 64) {
        bf16_t* kd = p.r2 + KD_OFF + (size_t)(b * 4 + head) * NT * 96 + wseg + r;
#pragma unroll
        for (int i = 0; i < 4; ++i)
#pragma unroll
          for (int e = 0; e < 16; ++e) kd[(size_t)(tb + i * 32 + crow(e, hh)) * 96] = f2bf(acc[i][j][e]);
      } else {
        bf16_t* vt = p.r2 + VDT_OFF + (size_t)((b * 4 + head) * 64 + (wseg - 64) + r) * NT;
#pragma unroll
        for (int i = 0; i < 4; ++i)
#pragma unroll
          for (int e4 = 0; e4 < 4; ++e4) {
            u32x2 o;
            o[0] = pack2(acc[i][j][e4 * 4 + 0], acc[i][j][e4 * 4 + 1]);
            o[1] = pack2(acc[i][j][e4 * 4 + 2], acc[i][j][e4 * 4 + 3]);
            *(u32x2*)(vt + tb + i * 32 + 8 * e4 + 4 * hh) = o;
          }
      }
    }
  }
}


using f32x4 = __attribute__((ext_vector_type(4))) float;
typedef __attribute__((address_space(3))) unsigned lds_u32;
DI int lds_byte8(int r, int c) {
  int st = (r >> 4) * 2 + (c >> 5), rr = r & 15, cc = c & 31, ob = rr * 64 + cc * 2;
  return st * 1024 + (ob ^ (((ob >> 9) & 1) << 5));
}
DI void stage_rc8(int b, int& R, int& C) {
  int st = b / 1024, sb = b % 1024, swz = sb ^ (((sb >> 9) & 1) << 5);
  R = (st >> 1) * 16 + swz / 64;
  C = (st & 1) * 32 + (swz % 64) / 2;
}
#define G8_HT 16384
#define G8_SA(b, h) (smem + ((b) * 2 + (h)) * G8_HT)
#define G8_SB(b, h) (smem + (4 + (b) * 2 + (h)) * G8_HT)
#define G8_STAGE(P, BASE, goff0, goff1, ld, br, kt)                                                              \
  do {                                                                                                            \
    const bf16_t* _g = (BASE) + (size_t)(br) * (ld) + (size_t)(kt) * 64;                                          \
    __builtin_amdgcn_global_load_lds((const unsigned*)(_g + goff0), (lds_u32*)((P) + tid * 16), 16, 0, 0);        \
    __builtin_amdgcn_global_load_lds((const unsigned*)(_g + goff1), (lds_u32*)((P) + tid * 16 + 8192), 16, 0, 0); \
  } while (0)
#define G8_LDA(dst, b, h)                                                                                 \
  _Pragma("unroll") for (int m = 0; m < 4; ++m) _Pragma("unroll") for (int k = 0; k < 2; ++k) dst[m][k] = \
      *(const bf16x8*)(G8_SA(b, h) + lds_byte8(wr * 64 + m * 16 + fr, k * 32 + fq * 8))
#define G8_LDB(dst, b, h)                                                                                 \
  _Pragma("unroll") for (int n = 0; n < 2; ++n) _Pragma("unroll") for (int k = 0; k < 2; ++k) dst[n][k] = \
      *(const bf16x8*)(G8_SB(b, h) + lds_byte8(wc * 32 + n * 16 + fr, k * 32 + fq * 8))
#define G8_MMA(ai, bj, AT, BX)                                                                         \
  do {                                                                                                 \
    __builtin_amdgcn_s_setprio(1);                                                                     \
    _Pragma("unroll") for (int m = 0; m < 4; ++m) _Pragma("unroll") for (int n = 0; n < 2; ++n)        \
        _Pragma("unroll") for (int k = 0; k < 2; ++k) acc[ai][bj][m][n] =                              \
            __builtin_amdgcn_mfma_f32_16x16x32_bf16(AT[m][k], BX[n][k], acc[ai][bj][m][n], 0, 0, 0);   \
    __builtin_amdgcn_s_setprio(0);                                                                     \
  } while (0)
#define G8_WAIT_V(n) asm volatile("s_waitcnt vmcnt(" #n ")" ::: "memory")
#define G8_WAIT_L(n) asm volatile("s_waitcnt lgkmcnt(" #n ")" ::: "memory")
#define G8_BAR __builtin_amdgcn_s_barrier()
#define G8_SCHED __builtin_amdgcn_sched_barrier(0)

DI void gemm8_mainloop(const bf16_t* __restrict__ A, int lda, const bf16_t* __restrict__ Bt, int ldb, int K,
                       __attribute__((address_space(3))) char* smem, f32x4 (&acc)[2][2][4][2]) {
  const int tid = otid();
  const int wid = tid >> 6, lane = tid & 63, wr = wid >> 2, wc = wid & 3, fr = lane & 15, fq = lane >> 4;
  int r0, c0, r1, c1;
  stage_rc8(tid * 16, r0, c0);
  stage_rc8(tid * 16 + 8192, r1, c1);
  const int ga0 = r0 * lda + c0, ga1 = r1 * lda + c1, gb0 = r0 * ldb + c0, gb1 = r1 * ldb + c1;
#pragma unroll
  for (int a = 0; a < 2; ++a)
#pragma unroll
    for (int b = 0; b < 2; ++b)
#pragma unroll
      for (int m = 0; m < 4; ++m)
#pragma unroll
        for (int n = 0; n < 2; ++n) acc[a][b][m][n] = (f32x4){0.f, 0.f, 0.f, 0.f};
  bf16x8 At[4][2], B0[2][2], B1[2][2];
  const int nt = K >> 6;
  G8_WAIT_V(0);
  G8_STAGE(G8_SB(0, 0), Bt, gb0, gb1, ldb, 0, 0);
  G8_STAGE(G8_SA(0, 0), A, ga0, ga1, lda, 0, 0);
  G8_STAGE(G8_SB(0, 1), Bt, gb0, gb1, ldb, 128, 0);
  G8_STAGE(G8_SA(0, 1), A, ga0, ga1, lda, 128, 0);
  if (wr == 1) G8_BAR;
  G8_WAIT_V(4); G8_BAR;
  G8_STAGE(G8_SB(1, 0), Bt, gb0, gb1, ldb, 0, 1);
  G8_STAGE(G8_SA(1, 0), A, ga0, ga1, lda, 0, 1);
  G8_STAGE(G8_SB(1, 1), Bt, gb0, gb1, ldb, 128, 1);
  G8_WAIT_V(6); G8_BAR;
#pragma unroll 1
  for (int t = 0; t < nt - 2; t += 2) {
    G8_LDB(B0, 0, 0); G8_SCHED; G8_LDA(At, 0, 0); G8_STAGE(G8_SA(1, 1), A, ga0, ga1, lda, 128, t + 1);
    G8_WAIT_L(8); G8_BAR; G8_WAIT_L(0); G8_MMA(0, 0, At, B0); G8_BAR; G8_SCHED;
    G8_LDB(B1, 0, 1); G8_STAGE(G8_SB(0, 0), Bt, gb0, gb1, ldb, 0, t + 2);
    G8_BAR; G8_WAIT_L(0); G8_MMA(0, 1, At, B1); G8_BAR;
    G8_LDA(At, 0, 1); G8_STAGE(G8_SA(0, 0), A, ga0, ga1, lda, 0, t + 2);
    G8_BAR; G8_WAIT_L(0); G8_MMA(1, 0, At, B0); G8_BAR; G8_SCHED;
    G8_STAGE(G8_SB(0, 1), Bt, gb0, gb1, ldb, 128, t + 2);
    G8_WAIT_V(6); G8_BAR; G8_MMA(1, 1, At, B1); G8_BAR;
    G8_LDB(B0, 1, 0); G8_SCHED; G8_LDA(At, 1, 0); G8_STAGE(G8_SA(0, 1), A, ga0, ga1, lda, 128, t + 2);
    G8_WAIT_L(8); G8_BAR; G8_WAIT_L(0); G8_MMA(0, 0, At, B0); G8_BAR; G8_SCHED;
    G8_LDB(B1, 1, 1); G8_STAGE(G8_SB(1, 0), Bt, gb0, gb1, ldb, 0, t + 3);
    G8_BAR; G8_WAIT_L(0); G8_MMA(0, 1, At, B1); G8_BAR;
    G8_LDA(At, 1, 1); G8_STAGE(G8_SA(1, 0), A, ga0, ga1, lda, 0, t + 3);
    G8_BAR; G8_WAIT_L(0); G8_MMA(1, 0, At, B0); G8_BAR; G8_SCHED;
    G8_STAGE(G8_SB(1, 1), Bt, gb0, gb1, ldb, 128, t + 3);
    G8_WAIT_V(6); G8_BAR; G8_MMA(1, 1, At, B1); G8_BAR;
  }
  {
    G8_LDB(B0, 0, 0); G8_LDA(At, 0, 0); G8_STAGE(G8_SA(1, 1), A, ga0, ga1, lda, 128, nt - 1);
    G8_BAR; G8_WAIT_L(0); G8_MMA(0, 0, At, B0); G8_BAR;
    G8_LDB(B1, 0, 1); G8_BAR; G8_WAIT_L(0); G8_MMA(0, 1, At, B1); G8_BAR;
    G8_LDA(At, 0, 1); G8_WAIT_V(4); G8_BAR; G8_WAIT_L(0); G8_MMA(1, 0, At, B0); G8_MMA(1, 1, At, B1); G8_BAR;
  }
  {
    G8_LDB(B0, 1, 0); G8_LDA(At, 1, 0); G8_WAIT_V(2); G8_BAR; G8_WAIT_L(0); G8_MMA(0, 0, At, B0); G8_BAR;
    G8_LDB(B1, 1, 1); G8_WAIT_V(0); G8_BAR; G8_WAIT_L(0); G8_MMA(0, 1, At, B1); G8_BAR;
    G8_LDA(At, 1, 1); G8_BAR; G8_WAIT_L(0); G8_MMA(1, 0, At, B0); G8_MMA(1, 1, At, B1); G8_BAR;
  }
  if (wr == 0) G8_BAR;
}

DI void gemm8_tile(const Params& p, char* smem_g, int mode, const bf16_t* A, int lda, const bf16_t* Bt, int K, int rt,
                   int ct) {
  f32x4 acc[2][2][4][2];
  const int row0 = rt * 256, col0 = ct * 256;
  gemm8_mainloop(A + (size_t)row0 * lda, lda, Bt + (size_t)col0 * K, K, K,
                 (__attribute__((address_space(3))) char*)smem_g, acc);
  const int tid = otid();
  const int wid = tid >> 6, lane = tid & 63, wr = wid >> 2, wc = wid & 3, fr = lane & 15, fq = lane >> 4;
  const int b = row0 / NT;
  const int rw = row0 + wr * 64 + fq * 4;
  if (mode == EPI_SWIGLU) {
    bf16_t* act = p.r1;
#pragma unroll
    for (int ai = 0; ai < 2; ++ai)
#pragma unroll
      for (int m = 0; m < 4; ++m)
#pragma unroll
        for (int n = 0; n < 2; ++n)
#pragma unroll
          for (int j = 0; j < 4; ++j) {
            float g = acc[ai][0][m][n][j], u = acc[ai][1][m][n][j];
            act[(size_t)(rw + ai * 128 + m * 16 + j) * DFF + ct * 128 + wc * 32 + n * 16 + fr] = f2bf(silu(g) * u);
          }
  } else if (mode == EPI_Y) {
    bf16_t* y = p.r2;
#pragma unroll
    for (int ai = 0; ai < 2; ++ai)
#pragma unroll
      for (int bj = 0; bj < 2; ++bj)
#pragma unroll
        for (int m = 0; m < 4; ++m)
#pragma unroll
          for (int n = 0; n < 2; ++n)
#pragma unroll
            for (int j = 0; j < 4; ++j)
              y[(size_t)(rw + ai * 128 + m * 16 + j) * DM + col0 + bj * 128 + wc * 32 + n * 16 + fr] =
                  f2bf(acc[ai][bj][m][n][j]);
  } else {
    const int tw = rw - b * NT;
#pragma unroll
    for (int bj = 0; bj < 2; ++bj) {
      const int cb = col0 + bj * 128 + wc * 32;
      const bool isAv = (cb >= 512 && cb < 768);
      const bool isBv = (cb >= 1152 && cb < 1280);
      if (isAv || isBv) {
        bf16_t* vt;
        if (isAv) vt = p.r2 + VAT_OFF + (size_t)((b * 4 + (cb - 512) / 64) * 64 + (cb & 32)) * NT;
        else vt = p.r2 + VBT_OFF + (size_t)((b * 2 + (cb - 1152) / 64) * 64 + (cb & 32)) * NT;
#pragma unroll
        for (int ai = 0; ai < 2; ++ai)
#pragma unroll
          for (int m = 0; m < 4; ++m)
#pragma unroll
            for (int n = 0; n < 2; ++n) {
              u32x2 o;
              o[0] = pack2(acc[ai][bj][m][n][0], acc[ai][bj][m][n][1]);
              o[1] = pack2(acc[ai][bj][m][n][2], acc[ai][bj][m][n][3]);
              *(u32x2*)(vt + (size_t)(n * 16 + fr) * NT + tw + ai * 128 + m * 16) = o;
            }
      } else {
        bf16_t* pp = p.r1;
#pragma unroll
        for (int ai = 0; ai < 2; ++ai)
#pragma unroll
          for (int m = 0; m < 4; ++m)
#pragma unroll
            for (int n = 0; n < 2; ++n)
#pragma unroll
              for (int j = 0; j < 4; ++j)
                pp[(size_t)(rw + ai * 128 + m * 16 + j) * NIN + cb + n * 16 + fr] = f2bf(acc[ai][bj][m][n][j]);
      }
    }
  }
}

DI int xcd_vb(int bid, int nblk) {
  if (nblk & 7) return bid;
  return (bid & 7) * (nblk >> 3) + (bid >> 3);
}

DI void phase_gemm(const Params& p, char* smem, int bid, int nblk, int mode, int layer, const bf16_t* A, int lda,
                           const bf16_t* Bt, int K, int nct, bool lat_only) {
  const int nrt = lat_only ? 128 : 136;
  const int total = nrt * nct;
  for (int t = xcd_vb(bid, nblk); t < total; t += nblk) {
    int rti = t / nct, ct = t - rti * nct;
    int rt = lat_only ? lat_tile(rti) : rti;
    gemm8_tile(p, smem, mode, A, lda, Bt, K, rt, ct);
  }
}

DI void phase_rowprep(const Params& p, int bid, int nblk, int l) {
  const int tid = otid(); const int lane = tid & 63, w = tid >> 6;
  const int gw = bid * 8 + w, nw = nblk * 8;
  const float* ropeAc = p.rope;
  const float* ropeAs = p.rope + 512;
  const float* ropeBc = p.rope + 1024;
  const float* ropeBs = p.rope + 2048;
  const float gqn = p.g_qnorm[l * 64 + lane], gkn = p.g_knorm[l * 64 + lane];
  const float scaleA = 0.17677669529663687f * LOG2E;
  const float scaleB = 0.125f * LOG2E;
  for (int R = gw; R < MROWS; R += nw) {
    const int b = R / NT, t = R - b * NT;
    const bool isctx = t < 256;
    const int pos = t - 256;
    const int prow = pos >> 6, pcol = pos & 63;
    bf16_t* P = p.r1 + (size_t)R * NIN;
    {
      const int d = lane & 31;
      const int pa = (d & 16) ? pcol : prow;
      float cs = 1.f, sn = 0.f;
      if (!isctx) { cs = ropeAc[pa * 8 + (d & 7)]; sn = ropeAs[pa * 8 + (d & 7)]; }
      const float sg = (d & 8) ? 1.f : -1.f;
#pragma unroll
      for (int i = 0; i < 4; ++i) {
        const int e = i * 64 + lane;
        const int hm = e >> 5;
        float vq = bf2f(P[e]), vk = bf2f(P[256 + e]);
        float pq = __shfl_xor(vq, 8), pk = __shfl_xor(vk, 8);
        vq = vq * cs + sg * pq * sn;
        vk = vk * cs + sg * pk * sn;
        size_t o = ((size_t)(b * 8 + hm) * NT + t) * 32 + d;
        p.r2[QA_OFF + o] = f2bf(vq * scaleA);
        p.r2[KA_OFF + o] = f2bf(vk);
      }
    }
    {
      const int d = lane;
      const int pa = (d & 32) ? pcol : prow;
      float cs = 1.f, sn = 0.f;
      if (!isctx) { cs = ropeBc[pa * 16 + (d & 15)]; sn = ropeBs[pa * 16 + (d & 15)]; }
      const float sg = (d & 16) ? 1.f : -1.f;
#pragma unroll
      for (int i = 0; i < 6; ++i) {
        float v = bf2f(P[768 + i * 64 + lane]);
        float ss = wave_sum(v * v);
        v = v * rsqrtf(ss * (1.f / 64.f) + EPS) * (i < 4 ? gqn : gkn);
        float pr = __shfl_xor(v, 16);
        v = v * cs + sg * pr * sn;
        if (i < 4) p.r2[QB_OFF + ((size_t)(b * 4 + i) * NT + t) * 64 + d] = f2bf(v * scaleB);
        else p.r2[KB_OFF + ((size_t)(b * 2 + (i - 4)) * NT + t) * 64 + d] = f2bf(v);
      }
    }
    {
      float vv[4];
      float s1 = 0.f;
#pragma unroll
      for (int i = 0; i < 4; ++i) {
        const int e = i * 64 + lane;
        P[1280 + e] = f2bf(gelu_tanh(bf2f(P[1280 + e])));
        vv[i] = gelu_tanh(bf2f(P[1536 + e]));
        s1 += vv[i];
      }
      const float mu = wave_sum(s1) * (1.f / 256.f);
      float s2 = 0.f;
#pragma unroll
      for (int i = 0; i < 4; ++i) { vv[i] -= mu; s2 += vv[i] * vv[i]; }
      const float rstd = rsqrtf(wave_sum(s2) * (1.f / 256.f) + EPS);
#pragma unroll
      for (int i = 0; i < 4; ++i) {
        const int e = i * 64 + lane;
        P[1536 + e] = f2bf(vv[i] * rstd * p.ln_g[l * 256 + e] + p.ln_b[l * 256 + e]);
      }
    }
    {
      float v[4];
      float ss = 0.f;
#pragma unroll
      for (int i = 0; i < 4; ++i) { v[i] = bf2f(P[1792 + i * 64 + lane]); ss += v[i] * v[i]; }
      float rstd = rsqrtf(wave_sum(ss) * (1.f / 256.f) + EPS);
#pragma unroll
      for (int i = 0; i < 4; ++i) P[1792 + i * 64 + lane] = f2bf(v[i] * rstd * p.g_q_a[l * 256 + i * 64 + lane]);
      ss = 0.f;
#pragma unroll
      for (int i = 0; i < 2; ++i) { v[i] = bf2f(P[2048 + i * 64 + lane]); ss += v[i] * v[i]; }
      rstd = rsqrtf(wave_sum(ss) * (1.f / 128.f) + EPS);
#pragma unroll
      for (int i = 0; i < 2; ++i) P[2048 + i * 64 + lane] = f2bf(v[i] * rstd * p.g_kv_a[l * 128 + i * 64 + lane]);
      const int d = lane & 31;
      float kr = bf2f(P[2176 + d]);
      float pr = __shfl_xor(kr, 8);
      if (!isctx) {
        const int pa = (d & 16) ? pcol : prow;
        kr = kr * ropeAc[pa * 8 + (d & 7)] + ((d & 8) ? pr : -pr) * ropeAs[pa * 8 + (d & 7)];
      }
      if (lane < 32) {
        const bf16_t kb = f2bf(kr);
#pragma unroll
        for (int hd = 0; hd < 4; ++hd) p.r2[KD_OFF + ((size_t)(b * 4 + hd) * NT + t) * 96 + 64 + d] = kb;
      }
    }
  }
}

DI void gmlp_item(const Params& p, char* smem, int l, int ch, int g) {
  const int tid = otid(), lane = tid & 63, w = tid >> 6, r = lane & 31, hh = lane >> 5;
  const int R0 = ch * 128;
  bf16_t* vT = (bf16_t*)smem;
#pragma unroll
  for (int u = 0; u < 2; ++u) {
    const int cid = tid + u * NTHREADS;
    const int q = cid >> 3, cc = cid & 7;
    u32x4 v = *(const u32x4*)(p.r1 + (size_t)(R0 + q) * NIN + 1536 + g * 64 + cc * 8);
#pragma unroll
    for (int j = 0; j < 4; ++j) {
      vT[(cc * 8 + 2 * j) * 136 + q] = (bf16_t)(v[j] & 0xffffu);
      vT[(cc * 8 + 2 * j + 1) * 136 + q] = (bf16_t)(v[j] >> 16);
    }
  }
  __syncthreads();
  const int wp = w >> 1, wc = w & 1;
  const bf16_t* wsp = p.wts + (size_t)l * LAYER_W + OFF_WSP + (size_t)g * 16384;
  f32x16 acc;
#pragma unroll
  for (int e = 0; e < 16; ++e) acc[e] = 0.f;
#pragma unroll
  for (int ks = 0; ks < 8; ++ks) {
    bf16x8 a = *(const bf16x8*)(wsp + (wp * 32 + r) * 128 + ks * 16 + hh * 8);
    bf16x8 bb = *(const bf16x8*)(vT + (wc * 32 + r) * 136 + ks * 16 + hh * 8);
    acc = MFMA32(a, bb, acc);
  }
  const int c = g * 64 + wc * 32 + r;
#pragma unroll
  for (int e = 0; e < 16; ++e) {
    const int pp = wp * 32 + crow(e, hh);
    const float u = bf2f(p.r1[(size_t)(R0 + pp) * NIN + 1280 + c]);
    const float mixed = acc[e] + p.b_spatial[(size_t)l * 512 + g * 128 + pp];
    p.h[(size_t)(R0 + pp) * DM + 512 + c] = f2bf(u * mixed);
  }
  __syncthreads();
}

DI void phase_dexp_gmlp(const Params& p, char* smem, int bid, int nblk, int l) {
  const bool lat_only = (l == 1);
  const bf16_t* wl = p.wts + (size_t)l * LAYER_W;
  const int nch = lat_only ? 256 : 272;
  const int total = 272 + 272 + nch * 4;
  for (int t = xcd_vb(bid, nblk); t < total; t += nblk) {
    if (t < 272) {
      gemm_tile(p, smem, EPI_UQ, l, p.r1 + 1792, NIN, wl + OFF_WUQ, 256, t >> 1, t & 1);
    } else if (t < 544) {
      int u = t - 272;
      gemm_tile(p, smem, EPI_UKV, l, p.r1 + 2048, NIN, wl + OFF_WUKV, 128, u >> 1, u & 1);
    } else {
      int u = t - 544;
      int ci = u >> 2, g = u & 3;
      int ch = lat_only ? ((ci >> 5) * 34 + 2 + (ci & 31)) : ci;
      gmlp_item(p, smem, l, ch, g);
    }
  }
}

template <int DQK, int NMAP>
DI void attn_item(const bf16_t* __restrict__ Qb, const bf16_t* __restrict__ Kb, const bf16_t* __restrict__ Vt,
                          int q0, int nkeys, bf16_t* __restrict__ outp, char* smem, float lam, float post_scale,
                          const float* __restrict__ g_subln) {
  constexpr int KSTR = DQK * 2 + 16;
  constexpr int KBYTES = NMAP * 64 * KSTR;
  constexpr int VSTR = 136;
  constexpr int STAGE = KBYTES + 64 * VSTR;
  constexpr int CPR = DQK / 8;
  constexpr int NKCH = NMAP * 64 * CPR;
  constexpr int NKL = (NKCH + NTHREADS - 1) / NTHREADS;
  constexpr int KK = DQK / 16;
  const int tid = otid(), lane = tid & 63, w = tid >> 6, r = lane & 31, hh = lane >> 5;

  bf16x8 qf[NMAP][KK];
  {
    const int qrow = q0 + w * 32 + r;
#pragma unroll
    for (int m = 0; m < NMAP; ++m)
#pragma unroll
      for (int kk = 0; kk < KK; ++kk)
        qf[m][kk] = *(const bf16x8*)(Qb + (size_t)m * NT * DQK + (size_t)qrow * DQK + kk * 16 + hh * 8);
  }
  const bf16_t* ksrc[NKL];
  int kdst[NKL];
  bool kval[NKL];
#pragma unroll
  for (int u = 0; u < NKL; ++u) {
    const int cid = tid + u * NTHREADS;
    kval[u] = cid < NKCH;
    const int c = cid % CPR, key = (cid / CPR) & 63, m = cid / (CPR * 64);
    ksrc[u] = Kb + (size_t)m * NT * DQK + (size_t)key * DQK + c * 8;
    kdst[u] = m * 64 * KSTR + key * KSTR + c * 16;
  }
  const bf16_t* vsrc = Vt + (size_t)(tid >> 3) * NT + (tid & 7) * 8;
  const int vdst = KBYTES + (tid >> 3) * VSTR + (tid & 7) * 16;

  f32x16 O[NMAP][2];
  float mrun[NMAP], lrun[NMAP];
#pragma unroll
  for (int m = 0; m < NMAP; ++m) {
    mrun[m] = -INFINITY;
    lrun[m] = 0.f;
#pragma unroll
    for (int d = 0; d < 2; ++d)
#pragma unroll
      for (int e = 0; e < 16; ++e) O[m][d][e] = 0.f;
  }
  u32x4 kreg[NKL], vreg;
#pragma unroll
  for (int u = 0; u < NKL; ++u)
    if (kval[u]) kreg[u] = *(const u32x4*)(ksrc[u]);
  vreg = *(const u32x4*)(vsrc);
#pragma unroll
  for (int u = 0; u < NKL; ++u)
    if (kval[u]) *(u32x4*)(smem + kdst[u]) = kreg[u];
  {
    u32x2 lo, hi;
    lo[0] = vreg[0]; lo[1] = vreg[1]; hi[0] = vreg[2]; hi[1] = vreg[3];
    *(u32x2*)(smem + vdst) = lo;
    *(u32x2*)(smem + vdst + 8) = hi;
  }
  __syncthreads();
  const int nt = nkeys >> 6;
#pragma unroll 1
  for (int it = 0; it < nt; ++it) {
    const char* cur = smem + (it & 1) * STAGE;
    const bool more = it + 1 < nt;
    if (more) {
      const int k0 = (it + 1) * 64;
#pragma unroll
      for (int u = 0; u < NKL; ++u)
        if (kval[u]) kreg[u] = *(const u32x4*)(ksrc[u] + (size_t)k0 * DQK);
      vreg = *(const u32x4*)(vsrc + k0);
    }
    bf16x8 pb[NMAP][2][2];
#pragma unroll
    for (int m = 0; m < NMAP; ++m) {
      f32x16 S[2];
#pragma unroll
      for (int t2 = 0; t2 < 2; ++t2) {
#pragma unroll
        for (int e = 0; e < 16; ++e) S[t2][e] = 0.f;
#pragma unroll
        for (int kk = 0; kk < KK; ++kk) {
          bf16x8 a = *(const bf16x8*)(cur + m * 64 * KSTR + (t2 * 32 + r) * KSTR + kk * 32 + hh * 16);
          S[t2] = MFMA32(a, qf[m][kk], S[t2]);
        }
      }
      float mx = S[0][0];
#pragma unroll
      for (int t2 = 0; t2 < 2; ++t2)
#pragma unroll
        for (int e = 0; e < 16; ++e) mx = fmaxf(mx, S[t2][e]);
      mx = fmaxf(mx, __shfl_xor(mx, 32));
      const float mnew = fmaxf(mrun[m], mx);
      const float alpha = __builtin_amdgcn_exp2f(mrun[m] - mnew);
      mrun[m] = mnew;
      float sum = 0.f;
#pragma unroll
      for (int t2 = 0; t2 < 2; ++t2)
#pragma unroll
        for (int e = 0; e < 16; ++e) {
          float pv = __builtin_amdgcn_exp2f(S[t2][e] - mnew);
          S[t2][e] = pv;
          sum += pv;
        }
      sum += __shfl_xor(sum, 32);
      lrun[m] = lrun[m] * alpha + sum;
#pragma unroll
      for (int d = 0; d < 2; ++d)
#pragma unroll
        for (int e = 0; e < 16; ++e) O[m][d][e] *= alpha;
#pragma unroll
      for (int t2 = 0; t2 < 2; ++t2)
#pragma unroll
        for (int s = 0; s < 2; ++s) {
          u32x4 pk;
#pragma unroll
          for (int j = 0; j < 4; ++j) pk[j] = pack2(S[t2][8 * s + 2 * j], S[t2][8 * s + 2 * j + 1]);
          pb[m][t2][s] = __builtin_bit_cast(bf16x8, pk);
        }
    }
    const char* vs = cur + KBYTES;
#pragma unroll
    for (int d = 0; d < 2; ++d)
#pragma unroll
      for (int t2 = 0; t2 < 2; ++t2)
#pragma unroll
        for (int s = 0; s < 2; ++s) {
          const char* vp = vs + (d * 32 + r) * VSTR + (t2 * 32 + 16 * s + 4 * hh) * 2;
          u32x2 lo = *(const u32x2*)(vp);
          u32x2 hi = *(const u32x2*)(vp + 16);
          u32x4 vv;
          vv[0] = lo[0]; vv[1] = lo[1]; vv[2] = hi[0]; vv[3] = hi[1];
          bf16x8 vf = __builtin_bit_cast(bf16x8, vv);
#pragma unroll
          for (int m = 0; m < NMAP; ++m) O[m][d] = MFMA32(vf, pb[m][t2][s], O[m][d]);
        }
    if (more) {
      char* nxt = smem + ((it + 1) & 1) * STAGE;
#pragma unroll
      for (int u = 0; u < NKL; ++u)
        if (kval[u]) *(u32x4*)(nxt + kdst[u]) = kreg[u];
      u32x2 lo, hi;
      lo[0] = vreg[0]; lo[1] = vreg[1]; hi[0] = vreg[2]; hi[1] = vreg[3];
      *(u32x2*)(nxt + vdst) = lo;
      *(u32x2*)(nxt + vdst + 8) = hi;
    }
    __syncthreads();
  }
  bf16_t* orow = outp + (size_t)(w * 32 + r) * DM;
  if (NMAP == 1) {
    const float inv = 1.f / lrun[0];
#pragma unroll
    for (int d = 0; d < 2; ++d)
#pragma unroll
      for (int e4 = 0; e4 < 4; ++e4) {
        u32x2 o;
        o[0] = pack2(O[0][d][e4 * 4 + 0] * inv, O[0][d][e4 * 4 + 1] * inv);
        o[1] = pack2(O[0][d][e4 * 4 + 2] * inv, O[0][d][e4 * 4 + 3] * inv);
        *(u32x2*)(orow + d * 32 + 8 * e4 + 4 * hh) = o;
      }
  } else {
    const float i1 = 1.f / lrun[0], i2 = lam / lrun[NMAP - 1];
    float ss = 0.f;
#pragma unroll
    for (int d = 0; d < 2; ++d)
#pragma unroll
      for (int e = 0; e < 16; ++e) {
        float o = O[0][d][e] * i1 - O[NMAP - 1][d][e] * i2;
        O[0][d][e] = o;
        ss += o * o;
      }
    ss += __shfl_xor(ss, 32);
    const float rstd = rsqrtf(ss * (1.f / 64.f) + EPS) * post_scale;
#pragma unroll
    for (int d = 0; d < 2; ++d)
#pragma unroll
      for (int e4 = 0; e4 < 4; ++e4) {
        const int dv = d * 32 + 8 * e4 + 4 * hh;
        u32x2 o;
        o[0] = pack2(O[0][d][e4 * 4 + 0] * rstd * g_subln[dv + 0], O[0][d][e4 * 4 + 1] * rstd * g_subln[dv + 1]);
        o[1] = pack2(O[0][d][e4 * 4 + 2] * rstd * g_subln[dv + 2], O[0][d][e4 * 4 + 3] * rstd * g_subln[dv + 3]);
        *(u32x2*)(orow + dv) = o;
      }
  }
}

DI void phase_attn(const Params& p, char* smem, int bid, int nblk, int l) {
  const bool lat_only = (l == 1);
  const int nq = lat_only ? 16 : 17;
  const int per = NB * 4 * nq;
  const int total = 3 * per;
  const float lam_init = (l == 0) ? 0.2f : 0.35550906759096927f;
  float lam;
  {
    const float* lv = p.lam_vecs + l * 128;
    float s1 = 0.f, s2 = 0.f;
    for (int i = 0; i < 32; ++i) { s1 += lv[i] * lv[32 + i]; s2 += lv[64 + i] * lv[96 + i]; }
    lam = expf(s1) - expf(s2) + lam_init;
  }
  for (int t = xcd_vb(bid, nblk); t < total; t += nblk) {
    const int mixer = t / per;
    int u = t - mixer * per;
    const int bh = u / nq;
    int qb = u - bh * nq;
    if (lat_only) qb += 1;
    const int b = bh >> 2, hd = bh & 3;
    const int q0 = qb * 256;
    const int nkeys = (qb == 0) ? 256 : NT;
    bf16_t* mixrow = p.h + ((size_t)b * NT + q0) * DM;
    if (mixer == 0) {
      attn_item<32, 2>(p.r2 + QA_OFF + (size_t)(b * 4 + hd) * 2 * NT * 32, p.r2 + KA_OFF + (size_t)(b * 4 + hd) * 2 * NT * 32,
                       p.r2 + VAT_OFF + (size_t)(b * 4 + hd) * 64 * NT, q0, nkeys, mixrow + hd * 64, smem, lam,
                       1.f - lam_init, p.g_subln + l * 64);
    } else if (mixer == 1) {
      attn_item<96, 1>(p.r2 + QD_OFF + (size_t)(b * 4 + hd) * NT * 96, p.r2 + KD_OFF + (size_t)(b * 4 + hd) * NT * 96,
                       p.r2 + VDT_OFF + (size_t)(b * 4 + hd) * 64 * NT, q0, nkeys, mixrow + 768 + hd * 64, smem, 0.f, 0.f,
                       nullptr);
    } else {
      attn_item<64, 1>(p.r2 + QB_OFF + (size_t)(b * 4 + hd) * NT * 64, p.r2 + KB_OFF + (size_t)(b * 2 + (hd >> 1)) * NT * 64,
                       p.r2 + VBT_OFF + (size_t)(b * 2 + (hd >> 1)) * 64 * NT, q0, nkeys, mixrow + 256 + hd * 64, smem, 0.f,
                       0.f, nullptr);
    }
  }
}


#define XB_TMO      128
#define XB_XCNT(j)  (256  + 64 * (j))
#define XB_XSUB(j)  (1280 + 64 * (j))
#define XB_XGEN(j)  (2304 + 64 * (j))
#define XB_TOP      3328
#define XB_TOPGEN   3392
#define XCD_BAR_WORDS 3456
#define XB_SPIN_CAP (1u << 18)
#define LAS __attribute__((address_space(3)))
DI unsigned xb_ld(unsigned* p) { return __hip_atomic_load(p, __ATOMIC_RELAXED, __HIP_MEMORY_SCOPE_AGENT); }
DI unsigned xb_add(unsigned* p, unsigned v) { return __hip_atomic_fetch_add(p, v, __ATOMIC_RELAXED, __HIP_MEMORY_SCOPE_AGENT); }
DI unsigned xb_xcc_id() { return (unsigned)__builtin_amdgcn_s_getreg((3 << 11) | 20) & 0xFu; }
#define XB_SPIN(cond, bar) do { unsigned _sp = 0; while (cond) { __builtin_amdgcn_s_sleep(1); \
    if ((++_sp & 255u) == 0u) { if (xb_ld(&(bar)[XB_TMO])) break; if (_sp > XB_SPIN_CAP) { atomicAdd(&(bar)[XB_TMO], 1u); break; } } } } while (0)
struct XcdBarrier { unsigned* bar; unsigned x; volatile LAS unsigned* st; };
DI XcdBarrier xcd_barrier_post(unsigned* bar, volatile LAS unsigned* st) {
  XcdBarrier b; b.bar = bar; b.x = xb_xcc_id(); b.st = st;
  if (threadIdx.x == 0) (void)xb_add(&bar[XB_XCNT(b.x)], 1u);
  return b;
}
DI void xcd_barrier_complete(unsigned* bar, unsigned x, unsigned& nloc, unsigned& nx) {
  const unsigned G = gridDim.x * gridDim.y * gridDim.z;
  unsigned sum, cnt, mine, sp = 0u;
  for (;;) {
    sum = 0u; cnt = 0u; mine = 0u;
#pragma unroll
    for (unsigned j = 0; j < 16; ++j) { const unsigned c = xb_ld(&bar[XB_XCNT(j)]); sum += c; cnt += (c > 0u) ? 1u : 0u; mine = (j == x) ? c : mine; }
    if (sum == G) break;
    __builtin_amdgcn_s_sleep(1);
    if ((++sp & 255u) == 0u) { if (xb_ld(&bar[XB_TMO])) break; if (sp > XB_SPIN_CAP) { atomicAdd(&bar[XB_TMO], 1u); break; } }
  }
  nloc = mine > 0u ? mine : 1u; nx = cnt > 0u ? cnt : 1u;
}
DI void xcd_barrier(const XcdBarrier& b) {
  asm volatile("s_waitcnt vmcnt(0)" ::: "memory");
  __syncthreads();
  if (threadIdx.x == 0) {
    unsigned* bar = b.bar;
    __builtin_amdgcn_s_waitcnt(0);
    unsigned nloc = b.st[0], nx = b.st[1];
    if (nloc == 0u) { xcd_barrier_complete(bar, b.x, nloc, nx); b.st[0] = nloc; b.st[1] = nx; }
    const unsigned old = xb_add(&bar[XB_XSUB(b.x)], 1u);
    const unsigned gen = old / nloc;
    if (old + 1u == (gen + 1u) * nloc) {
      __builtin_amdgcn_fence(__ATOMIC_RELEASE, "agent");
      asm volatile("s_waitcnt vmcnt(0)" ::: "memory");
      const unsigned og = xb_add(&bar[XB_TOP], 1u);
      const unsigned tg = og / nx;
      if (og + 1u == (tg + 1u) * nx) xb_add(&bar[XB_TOPGEN], 1u);
      else XB_SPIN(xb_ld(&bar[XB_TOPGEN]) == tg, bar);
      __builtin_amdgcn_fence(__ATOMIC_ACQUIRE, "agent");
      xb_add(&bar[XB_XGEN(b.x)], 1u);
      asm volatile("s_waitcnt vmcnt(0)" ::: "memory");
    } else {
      XB_SPIN(xb_ld(&bar[XB_XGEN(b.x)]) == gen, bar);
      __builtin_amdgcn_fence(__ATOMIC_ACQUIRE, "agent");
      asm volatile("s_waitcnt vmcnt(0)" ::: "memory");
    }
  }
  __syncthreads();
}

constexpr int N_PHASES = 26;
#ifndef PMASK
#define PMASK 0xffff
#endif
#define PM(k) ((PMASK >> (k)) & 1)
#ifndef REPMASK
#define REPMASK 0
#endif

__global__ void __launch_bounds__(NTHREADS) trunk_megakernel(Params p) {
  __shared__ __attribute__((aligned(16))) char smem[131072];
  __shared__ uint4 xb_words;
  cg::grid_group grid = cg::this_grid();
  const int bid = blockIdx.x, nblk = gridDim.x;
  if (threadIdx.x == 0) xb_words = make_uint4(0u, 0u, 0u, 0u);
  __syncthreads();
  XcdBarrier xb;
  xb.bar = p.bar; xb.x = 0; xb.st = (volatile LAS unsigned*)&xb_words;
  if (p.phase_hi - p.phase_lo > 1) xb = xcd_barrier_post(p.bar, (volatile LAS unsigned*)&xb_words);
#pragma unroll 1
  for (int ph = p.phase_lo; ph < p.phase_hi; ++ph) {
    if (ph == 0) {
      if (PM(12)) phase_setup(p, smem, bid, nblk);
    } else if (ph == 1) {
      if (PM(13)) phase_rowpass(p, bid, nblk, 0, -1, 0.f, 0, 0, true, false);
    } else {
      const int l = (ph - 2) / 12, s = (ph - 2) % 12;
      const int nrep = ((REPMASK >> s) & 1) ? 2 : 1;
#pragma unroll 1
      for (int rep = 0; rep < nrep; ++rep) {
      if (rep) xcd_barrier(xb);
      const bf16_t* wl = p.wts + (size_t)l * LAYER_W;
      const bool lo = (l == 1);
      switch (s) {
        case 0: if (PM(0)) phase_gemm(p, smem, bid, nblk, EPI_SWIGLU, l, p.h, DM, wl + OFF_W1, DM, 22, false); break;
        case 1: if (PM(1)) phase_gemm(p, smem, bid, nblk, EPI_Y, l, p.r1, DFF, wl + OFF_W2, DFF, 4, false); break;
        case 2: if (PM(2)) phase_rowpass(p, bid, nblk, l, 0, 0.5f, l, 1, l == 0, false); break;
        case 3: if (PM(3)) phase_gemm(p, smem, bid, nblk, EPI_WIN, l, p.h, DM, wl + OFF_WIN, DM, 9, false); break;
        case 4: if (PM(4)) phase_rowprep(p, bid, nblk, l); break;
        case 5: if (PM(5)) phase_dexp_gmlp(p, smem, bid, nblk, l); break;
        case 6: if (PM(6)) phase_attn(p, smem, bid, nblk, l); break;
        case 7: if (PM(7)) phase_gemm(p, smem, bid, nblk, EPI_Y, l, p.h, DM, wl + OFF_WOUT, DM, 4, lo); break;
        case 8: if (PM(8)) phase_rowpass(p, bid, nblk, l, 1, 1.0f, l, 2, false, lo); break;
        case 9: if (PM(9)) phase_gemm(p, smem, bid, nblk, EPI_SWIGLU, l, p.h, DM, wl + OFF_W3, DM, 22, lo); break;
        case 10: if (PM(10)) phase_gemm(p, smem, bid, nblk, EPI_Y, l, p.r1, DFF, wl + OFF_W4, DFF, 4, lo); break;
        default: if (PM(11)) phase_rowpass(p, bid, nblk, l, 2, 0.5f, l + 1, (l == 0) ? 0 : -1, false, lo); break;
      }
      }
    }
    if (ph + 1 < p.phase_hi) { if (ph == 0) grid.sync(); else xcd_barrier(xb); }
  }
}

extern "C" void kernel_launch(void* const* d_in, const int* in_sizes, int n_in, void* d_out, int out_size, void* d_ws,
                              size_t ws_size, hipStream_t stream) {
  static int grid_blocks = 0;
  if (!grid_blocks) {
    int dev = 0, cus = 0, per_cu = 0;
    hipGetDevice(&dev);
    hipDeviceGetAttribute(&cus, hipDeviceAttributeMultiprocessorCount, dev);
    hipOccupancyMaxActiveBlocksPerMultiprocessor(&per_cu, trunk_megakernel, NTHREADS, 0);
    if (per_cu < 1) per_cu = 1;
    if (per_cu > 1) per_cu = 1;
    grid_blocks = cus * per_cu;
  }
  Params p{};
  const float** pf = (const float**)&p;
  for (int i = 0; i < 26; ++i) pf[i] = (const float*)d_in[i];
  p.out = (float*)d_out;
  char* ws = (char*)d_ws;
  size_t off = 0;
  auto take = [&](size_t bytes) { char* q = ws + off; off += (bytes + 255) & ~(size_t)255; return q; };
  p.wts = (bf16_t*)take(2 * LAYER_W * 2);
  p.mods = (float*)take((size_t)2 * 9 * 9216 * 4);
  p.rope = (float*)take(3072 * 4);
  p.xctx = (float*)take((size_t)2048 * 1024 * 4);
  p.h = (bf16_t*)take((size_t)MROWS * DM * 2);
  p.r1 = (bf16_t*)take((size_t)MROWS * DFF * 2);
  p.r2 = (bf16_t*)take((size_t)MROWS * NIN * 2);
  p.bar = (unsigned*)take(XCD_BAR_WORDS * 4);
  hipMemsetAsync(p.bar, 0, XCD_BAR_WORDS * 4, stream);
  if (off > ws_size) fprintf(stderr, "workspace too small: need %zu have %zu\n", off, ws_size);
#if MULTI_LAUNCH
  for (int ph = 0; ph < N_PHASES; ++ph) {
    Params q = p;
    q.phase_lo = ph;
    q.phase_hi = ph + 1;
    void* args[] = {&q};
    hipError_t e = hipLaunchCooperativeKernel((void*)trunk_megakernel, dim3(grid_blocks), dim3(NTHREADS), args, 0, stream);
    if (e != hipSuccess) fprintf(stderr, "launch failed: %s\n", hipGetErrorString(e));
  }
#else
  p.phase_lo = 0;
  p.phase_hi = N_PHASES;
  void* args[] = {&p};
  hipError_t e = hipLaunchCooperativeKernel((void*)trunk_megakernel, dim3(grid_blocks), dim3(NTHREADS), args, 0, stream);
  if (e != hipSuccess) fprintf(stderr, "cooperative launch failed: %s (grid %d)\n", hipGetErrorString(e), grid_blocks);
#endif
}
```

```cpp
#include <hip/hip_runtime.h>
#include <hip/hip_cooperative_groups.h>
#include <stdint.h>
#include <cstdio>
namespace cg = cooperative_groups;

#ifndef MULTI_LAUNCH
#define MULTI_LAUNCH 0
#endif

typedef unsigned short bf16_t;
using bf16x8 = __attribute__((ext_vector_type(8))) short;
using f32x16 = __attribute__((ext_vector_type(16))) float;
using u32x4 = __attribute__((ext_vector_type(4))) unsigned;
using u32x2 = __attribute__((ext_vector_type(2))) unsigned;

#define DI __device__ __forceinline__
#define MFMA32(a, b, c) __builtin_amdgcn_mfma_f32_32x32x16_bf16((a), (b), (c), 0, 0, 0)

constexpr int NT = 4352;
constexpr int NB = 8;
constexpr int MROWS = NB * NT;
constexpr int DM = 1024;
constexpr int DFF = 2816;
constexpr int NIN = 2304;
constexpr int NTHREADS = 512;
constexpr float EPS = 1e-6f;
constexpr float LOG2E = 1.4426950408889634f;

constexpr size_t OFF_W1 = 0;
constexpr size_t OFF_W2 = 5767168;
constexpr size_t OFF_W3 = 8650752;
constexpr size_t OFF_W4 = 14417920;
constexpr size_t OFF_WIN = 17301504;
constexpr size_t OFF_WOUT = 19660800;
constexpr size_t OFF_WUQ = 20709376;
constexpr size_t OFF_WUKV = 20840448;
constexpr size_t OFF_WSP = 20905984;
constexpr size_t LAYER_W = 20971520;

constexpr size_t QA_OFF = 0;
constexpr size_t KA_OFF = 8912896;
constexpr size_t VAT_OFF = 17825792;
constexpr size_t QB_OFF = 26738688;
constexpr size_t KB_OFF = 35651584;
constexpr size_t VBT_OFF = 40108032;
constexpr size_t QD_OFF = 44564480;
constexpr size_t KD_OFF = 57933824;
constexpr size_t VDT_OFF = 71303168;

struct Params {
  const float *x, *c, *ctx, *c_ctx, *w_ada, *b_ada, *g_pre, *g_post, *w_ffn1_in, *w_ffn1_out, *w_ffn2_in,
      *w_ffn2_out, *w_in, *w_out, *lam_vecs, *g_subln, *g_qnorm, *g_knorm, *w_spatial, *b_spatial, *ln_g, *ln_b,
      *g_q_a, *w_uq, *g_kv_a, *w_ukv;
  float* out;
  bf16_t* wts;
  float* mods;
  float* rope;
  float* xctx;
  bf16_t* h;
  bf16_t* r1;
  bf16_t* r2;
  unsigned* bar;
  int phase_lo, phase_hi;
};

DI int otid() { int t = threadIdx.x; asm volatile("" : "+v"(t)); return t; }
DI float bf2f(bf16_t v) { return __uint_as_float(((unsigned)v) << 16); }
DI bf16_t f2bf(float f) { __bf16 b = (__bf16)f; return __builtin_bit_cast(unsigned short, b); }
DI unsigned pack2(float a, float b) { return (unsigned)f2bf(a) | ((unsigned)f2bf(b) << 16); }
DI int crow(int e, int hh) { return (e & 3) + 8 * (e >> 2) + 4 * hh; }
DI float wave_sum(float v) {
#pragma unroll
  for (int o = 32; o >= 1; o >>= 1) v += __shfl_xor(v, o);
  return v;
}
DI float gelu_tanh(float x) {
  float u = 0.7978845608028654f * (x + 0.044715f * x * x * x);
  return 0.5f * x * (1.f + tanhf(u));
}
DI float silu(float x) { return x / (1.f + __expf(-x)); }

DI void convert_tile(const float* __restrict__ src, int K, int N, int mode, bf16_t* __restrict__ dst, int kt, int nt,
                     float* tile) {
  const int tid = otid();
  {
    const int kl = tid >> 4, n4 = (tid & 15) * 4;
    const int np = nt * 64 + n4;
    int sc = np;
    if (mode == 1) {
      int j = (np >> 7) & 1, tl = np >> 8, cc = np & 127;
      sc = j * DFF + tl * 128 + cc;
    }
    const bool valid = (mode == 1) || (np < N);
#pragma unroll
    for (int half = 0; half < 2; ++half) {
      int k = kl + 32 * half;
      float4 v = make_float4(0.f, 0.f, 0.f, 0.f);
      if (valid) v = *(const float4*)(src + (size_t)(kt * 64 + k) * N + sc);
      float* tp = tile + k * 65 + n4;
      tp[0] = v.x; tp[1] = v.y; tp[2] = v.z; tp[3] = v.w;
    }
  }
  __syncthreads();
  {
    const int nl = tid >> 3, kc = (tid & 7) * 8;
    u32x4 o;
#pragma unroll
    for (int j = 0; j < 4; ++j) o[j] = pack2(tile[(kc + 2 * j) * 65 + nl], tile[(kc + 2 * j + 1) * 65 + nl]);
    *(u32x4*)(dst + (size_t)(nt * 64 + nl) * K + kt * 64 + kc) = o;
  }
  __syncthreads();
}

DI void phase_setup(const Params& p, char* smem, int bid, int nblk) {
  const int tid = otid();
  constexpr int PER_LAYER = 5120;
  constexpr int N_CONV = 2 * PER_LAYER;
  constexpr int N_MOD = 288;
  const int total = N_CONV + N_MOD + 1;
  for (int it = bid; it < total; it += nblk) {
    if (it < N_CONV) {
      const int l = it / PER_LAYER;
      int i = it - l * PER_LAYER;
      bf16_t* wl = p.wts + (size_t)l * LAYER_W;
      float* tile = (float*)smem;
      if (i < 1408) { convert_tile(p.w_ffn1_in + (size_t)l * DM * 2 * DFF, DM, 2 * DFF, 1, wl + OFF_W1, i / 88, i % 88, tile); continue; }
      i -= 1408;
      if (i < 704) { convert_tile(p.w_ffn1_out + (size_t)l * DFF * DM, DFF, DM, 0, wl + OFF_W2, i / 16, i % 16, tile); continue; }
      i -= 704;
      if (i < 1408) { convert_tile(p.w_ffn2_in + (size_t)l * DM * 2 * DFF, DM, 2 * DFF, 1, wl + OFF_W3, i / 88, i % 88, tile); continue; }
      i -= 1408;
      if (i < 704) { convert_tile(p.w_ffn2_out + (size_t)l * DFF * DM, DFF, DM, 0, wl + OFF_W4, i / 16, i % 16, tile); continue; }
      i -= 704;
      if (i < 576) { convert_tile(p.w_in + (size_t)l * DM * 2208, DM, 2208, 0, wl + OFF_WIN, i / 36, i % 36, tile); continue; }
      i -= 576;
      if (i < 256) { convert_tile(p.w_out + (size_t)l * DM * DM, DM, DM, 0, wl + OFF_WOUT, i / 16, i % 16, tile); continue; }
      i -= 256;
      if (i < 32) { convert_tile(p.w_uq + (size_t)l * 256 * 384, 256, 384, 0, wl + OFF_WUQ, i / 8, i % 8, tile); continue; }
      i -= 32;
      if (i < 16) { convert_tile(p.w_ukv + (size_t)l * 128 * 512, 128, 512, 0, wl + OFF_WUKV, i / 8, i % 8, tile); continue; }
      i -= 16;
      {
        const float* s = p.w_spatial + (size_t)l * 65536 + (size_t)i * 4096;
        bf16_t* d = wl + OFF_WSP + (size_t)i * 4096;
        for (int e = tid; e < 4096; e += NTHREADS) d[e] = f2bf(s[e]);
      }
    } else if (it < N_CONV + N_MOD) {
      const int m = it - N_CONV;
      const int l = m / 144, cg64 = m % 144;
      float* s = (float*)smem;
      float* red = (float*)(smem + 36864);
      for (int e = tid; e < 9 * 1024; e += NTHREADS) {
        int b = e >> 10, k = e & 1023;
        float v = (b < 8) ? p.c[b * 1024 + k] : p.c_ctx[k];
        s[e] = silu(v);
      }
      __syncthreads();
      const int w = tid >> 6, lane = tid & 63;
      const int col = cg64 * 64 + lane;
      float acc[9];
#pragma unroll
      for (int b = 0; b < 9; ++b) acc[b] = 0.f;
      const float* wp = p.w_ada + (size_t)l * 1024 * 9216 + col;
      for (int k = w * 128; k < w * 128 + 128; ++k) {
        float wv = wp[(size_t)k * 9216];
#pragma unroll
        for (int b = 0; b < 9; ++b) acc[b] += s[b * 1024 + k] * wv;
      }
#pragma unroll
      for (int b = 0; b < 9; ++b) red[(w * 9 + b) * 64 + lane] = acc[b];
      __syncthreads();
      for (int e = tid; e < 9 * 64; e += NTHREADS) {
        int b = e >> 6, ln = e & 63;
        float t = 0.f;
#pragma unroll
        for (int ww = 0; ww < 8; ++ww) t += red[(ww * 9 + b) * 64 + ln];
        int cc = cg64 * 64 + ln;
        p.mods[((size_t)l * 9 + b) * 9216 + cc] = t + p.b_ada[(size_t)l * 9216 + cc];
      }
      __syncthreads();
    } else {
      for (int e = tid; e < 64 * 8; e += NTHREADS) {
        int pos = e >> 3, j = e & 7;
        float inv = powf(10000.f, -(float)(2 * j) / 16.f);
        float ang = (float)pos * inv;
        p.rope[e] = cosf(ang);
        p.rope[512 + e] = sinf(ang);
      }
      for (int e = tid; e < 64 * 16; e += NTHREADS) {
        int pos = e >> 4, j = e & 15;
        float inv = powf(10000.f, -(float)(2 * j) / 32.f);
        float ang = (float)pos * inv;
        p.rope[1024 + e] = cosf(ang);
        p.rope[2048 + e] = sinf(ang);
      }
    }
  }
}

DI void phase_rowpass(const Params& p, int bid, int nblk, int l_post, int j_post, float wres, int l_pre,
                              int j_pre, bool src_inputs, bool lat_only) {
  const int tid = otid(); const int lane = tid & 63, w = tid >> 6;
  const int gw = bid * 8 + w, nw = nblk * 8;
  const int nrows = lat_only ? NB * 4096 : MROWS;
  const bf16_t* y = p.r2;
  for (int ri = gw; ri < nrows; ri += nw) {
    int R = lat_only ? ((ri >> 12) * NT + 256 + (ri & 4095)) : ri;
    const int b = R / NT, t = R - b * NT;
    const bool isctx = t < 256;
    const int mrow = isctx ? 8 : b;
    const float* src;
    float* dst;
    if (isctx) {
      size_t o = ((size_t)b * 256 + t) * DM;
      src = src_inputs ? p.ctx + o : p.xctx + o;
      dst = p.xctx + o;
    } else {
      size_t o = ((size_t)b * 4096 + (t - 256)) * DM;
      src = src_inputs ? p.x + o : p.out + o;
      dst = p.out + o;
    }
    float xv[16];
#pragma unroll
    for (int c = 0; c < 4; ++c) {
      float4 v = *(const float4*)(src + c * 256 + lane * 4);
      xv[c * 4 + 0] = v.x; xv[c * 4 + 1] = v.y; xv[c * 4 + 2] = v.z; xv[c * 4 + 3] = v.w;
    }
    if (j_post >= 0) {
      float yv[16];
      float ss = 0.f;
#pragma unroll
      for (int c = 0; c < 4; ++c) {
        u32x2 u = *(const u32x2*)(y + (size_t)R * DM + c * 256 + lane * 4);
        yv[c * 4 + 0] = __uint_as_float(u[0] << 16);
        yv[c * 4 + 1] = __uint_as_float(u[0] & 0xffff0000u);
        yv[c * 4 + 2] = __uint_as_float(u[1] << 16);
        yv[c * 4 + 3] = __uint_as_float(u[1] & 0xffff0000u);
#pragma unroll
        for (int q = 0; q < 4; ++q) ss += yv[c * 4 + q] * yv[c * 4 + q];
      }
      ss = wave_sum(ss);
      const float rstd = rsqrtf(ss * (1.f / DM) + EPS) * wres;
      const float* gate = p.mods + ((size_t)l_post * 9 + mrow) * 9216 + (3 * j_post + 2) * DM;
      const float* gp = p.g_post + ((size_t)l_post * 3 + j_post) * DM;
#pragma unroll
      for (int c = 0; c < 4; ++c) {
        float4 g = *(const float4*)(gate + c * 256 + lane * 4);
        float4 gg = *(const float4*)(gp + c * 256 + lane * 4);
        xv[c * 4 + 0] += g.x * yv[c * 4 + 0] * rstd * gg.x;
        xv[c * 4 + 1] += g.y * yv[c * 4 + 1] * rstd * gg.y;
        xv[c * 4 + 2] += g.z * yv[c * 4 + 2] * rstd * gg.z;
        xv[c * 4 + 3] += g.w * yv[c * 4 + 3] * rstd * gg.w;
        *(float4*)(dst + c * 256 + lane * 4) = make_float4(xv[c * 4 + 0], xv[c * 4 + 1], xv[c * 4 + 2], xv[c * 4 + 3]);
      }
    }
    if (j_pre >= 0) {
      float ss = 0.f;
#pragma unroll
      for (int q = 0; q < 16; ++q) ss += xv[q] * xv[q];
      ss = wave_sum(ss);
      const float rstd = rsqrtf(ss * (1.f / DM) + EPS);
      const float* mb = p.mods + ((size_t)l_pre * 9 + mrow) * 9216;
      const float* shift = mb + (3 * j_pre) * DM;
      const float* scale = mb + (3 * j_pre + 1) * DM;
      const float* gp = p.g_pre + ((size_t)l_pre * 3 + j_pre) * DM;
#pragma unroll
      for (int c = 0; c < 4; ++c) {
        float4 sh = *(const float4*)(shift + c * 256 + lane * 4);
        float4 sc = *(const float4*)(scale + c * 256 + lane * 4);
        float4 gg = *(const float4*)(gp + c * 256 + lane * 4);
        float h0 = xv[c * 4 + 0] * rstd * gg.x * (1.f + sc.x) + sh.x;
        float h1 = xv[c * 4 + 1] * rstd * gg.y * (1.f + sc.y) + sh.y;
        float h2 = xv[c * 4 + 2] * rstd * gg.z * (1.f + sc.z) + sh.z;
        float h3 = xv[c * 4 + 3] * rstd * gg.w * (1.f + sc.w) + sh.w;
        u32x2 o;
        o[0] = pack2(h0, h1);
        o[1] = pack2(h2, h3);
        *(u32x2*)(p.h + (size_t)R * DM + c * 256 + lane * 4) = o;
      }
    }
  }
}

enum { EPI_SWIGLU = 0, EPI_Y = 1, EPI_WIN = 2, EPI_UQ = 3, EPI_UKV = 4 };

DI void gemm_mainloop(const bf16_t* __restrict__ A, int lda, const bf16_t* __restrict__ Bt, int ldb, int K, char* smem,
                      f32x16 (&acc)[4][2]) {
  const int tid = otid(), lane = tid & 63, w = tid >> 6, wm = w >> 2, wn = w & 3, r = lane & 31, hh = lane >> 5;
  const int lc = tid & 7, lr = tid >> 3;
  const bf16_t* ap = A + (size_t)lr * lda + lc * 8;
  const bf16_t* bp = Bt + (size_t)lr * ldb + lc * 8;
  const int st_off = lr * 128 + ((lc ^ ((lr >> 1) & 7)) << 4);
  u32x4 ra[4], rb[4];
#pragma unroll
  for (int i = 0; i < 4; ++i)
#pragma unroll
    for (int j = 0; j < 2; ++j)
#pragma unroll
      for (int e = 0; e < 16; ++e) acc[i][j][e] = 0.f;
  const int nk = K >> 6;
#pragma unroll
  for (int i = 0; i < 4; ++i) {
    ra[i] = *(const u32x4*)(ap + (size_t)i * 64 * lda);
    rb[i] = *(const u32x4*)(bp + (size_t)i * 64 * ldb);
  }
#pragma unroll
  for (int i = 0; i < 4; ++i) {
    *(u32x4*)(smem + st_off + i * 8192) = ra[i];
    *(u32x4*)(smem + 32768 + st_off + i * 8192) = rb[i];
  }
  __syncthreads();
  const int sw = (r >> 1) & 7;
#pragma unroll 1
  for (int kt = 0; kt < nk; ++kt) {
    char* cur = smem + (kt & 1) * 65536;
    const bool more = (kt + 1 < nk);
    if (more) {
      ap += 64;
      bp += 64;
#pragma unroll
      for (int i = 0; i < 4; ++i) {
        ra[i] = *(const u32x4*)(ap + (size_t)i * 64 * lda);
        rb[i] = *(const u32x4*)(bp + (size_t)i * 64 * ldb);
      }
    }
    const char* abase = cur + (wm * 128 + r) * 128;
    const char* bbase = cur + 32768 + (wn * 64 + r) * 128;
#pragma unroll
    for (int ks = 0; ks < 4; ++ks) {
      const int off = (((2 * ks + hh) ^ sw) << 4);
      bf16x8 af[4], bfr[2];
#pragma unroll
      for (int i = 0; i < 4; ++i) af[i] = *(const bf16x8*)(abase + i * 4096 + off);
#pragma unroll
      for (int j = 0; j < 2; ++j) bfr[j] = *(const bf16x8*)(bbase + j * 4096 + off);
#pragma unroll
      for (int i = 0; i < 4; ++i)
#pragma unroll
        for (int j = 0; j < 2; ++j) acc[i][j] = MFMA32(af[i], bfr[j], acc[i][j]);
    }
    if (more) {
      char* nxt = smem + ((kt + 1) & 1) * 65536;
#pragma unroll
      for (int i = 0; i < 4; ++i) {
        *(u32x4*)(nxt + st_off + i * 8192) = ra[i];
        *(u32x4*)(nxt + 32768 + st_off + i * 8192) = rb[i];
      }
    }
    __syncthreads();
  }
}

DI int lat_tile(int i) { return (i >> 4) * 17 + 1 + (i & 15); }

DI void gemm_tile(const Params& p, char* smem, int mode, int layer, const bf16_t* A, int lda, const bf16_t* Bt,
                          int K, int rt, int ct) {
  f32x16 acc[4][2];
  const int row0 = rt * 256, col0 = ct * 256;
  gemm_mainloop(A + (size_t)row0 * lda, lda, Bt + (size_t)col0 * K, K, K, smem, acc);
  const int tid = otid(), lane = tid & 63, w = tid >> 6, wm = w >> 2, wn = w & 3, r = lane & 31, hh = lane >> 5;
  const int rb = row0 + wm * 128, cb = col0 + wn * 64;
  const int b = row0 / NT;
  const int tb = rb - b * NT;
  if (mode == EPI_SWIGLU) {
    bf16_t* act = p.r1;
    const int oc = ct * 128 + wn * 32 + r;
#pragma unroll
    for (int i = 0; i < 4; ++i)
#pragma unroll
      for (int e = 0; e < 16; ++e) {
        float g = acc[i][0][e], u = acc[i][1][e];
        act[(size_t)(rb + i * 32 + crow(e, hh)) * DFF + oc] = f2bf(silu(g) * u);
      }
  } else if (mode == EPI_Y) {
    bf16_t* y = p.r2;
#pragma unroll
    for (int i = 0; i < 4; ++i)
#pragma unroll
      for (int j = 0; j < 2; ++j)
#pragma unroll
        for (int e = 0; e < 16; ++e)
          y[(size_t)(rb + i * 32 + crow(e, hh)) * DM + cb + j * 32 + r] = f2bf(acc[i][j][e]);
  } else if (mode == EPI_WIN) {
    const bool isAv = (cb >= 512 && cb < 768);
    const bool isBv = (cb >= 1152 && cb < 1280);
    if (isAv || isBv) {
      bf16_t* vt;
      if (isAv) vt = p.r2 + VAT_OFF + (size_t)((b * 4 + (cb - 512) / 64) * 64) * NT;
      else vt = p.r2 + VBT_OFF + (size_t)((b * 2 + (cb - 1152) / 64) * 64) * NT;
#pragma unroll
      for (int i = 0; i < 4; ++i)
#pragma unroll
        for (int j = 0; j < 2; ++j)
#pragma unroll
          for (int e4 = 0; e4 < 4; ++e4) {
            u32x2 o;
            o[0] = pack2(acc[i][j][e4 * 4 + 0], acc[i][j][e4 * 4 + 1]);
            o[1] = pack2(acc[i][j][e4 * 4 + 2], acc[i][j][e4 * 4 + 3]);
            int t = tb + i * 32 + 8 * e4 + 4 * hh;
            *(u32x2*)(vt + (size_t)(j * 32 + r) * NT + t) = o;
          }
    } else {
      bf16_t* pp = p.r1;
#pragma unroll
      for (int i = 0; i < 4; ++i)
#pragma unroll
        for (int j = 0; j < 2; ++j)
#pragma unroll
          for (int e = 0; e < 16; ++e)
            pp[(size_t)(rb + i * 32 + crow(e, hh)) * NIN + cb + j * 32 + r] = f2bf(acc[i][j][e]);
    }
  } else if (mode == EPI_UQ) {
    const float scale = 0.10206207261596577f * LOG2E;
    const bool isctx = tb < 256;
#pragma unroll
    for (int j = 0; j < 2; ++j) {
      const int n0 = cb + j * 32;
      if (n0 >= 384) continue;
      const int head = n0 / 96, seg = (n0 % 96) / 32;
      bf16_t* qd = p.r2 + QD_OFF + (size_t)(b * 4 + head) * NT * 96 + seg * 32 + r;
#pragma unroll
      for (int i = 0; i < 4; ++i)
#pragma unroll
        for (int e = 0; e < 16; ++e) {
          float v = acc[i][j][e];
          const int t = tb + i * 32 + crow(e, hh);
          if (seg == 2) {
            float pr = __shfl_xor(v, 8);
            if (!isctx) {
              const int pos = t - 256;
              const int pa = (r & 16) ? (pos & 63) : (pos >> 6);
              const float cs = p.rope[pa * 8 + (r & 7)], sn = p.rope[512 + pa * 8 + (r & 7)];
              v = v * cs + ((r & 8) ? pr : -pr) * sn;
            }
          }
          qd[(size_t)t * 96] = f2bf(v * scale);
        }
    }
  } else {
#pragma unroll
    for (int j = 0; j < 2; ++j) {
      const int n0 = cb + j * 32;
      const int head = n0 >> 7, wseg = n0 & 127;
      if (wseg < 64) {
        bf16_t* kd = p.r2 + KD_OFF + (size_t)(b * 4 + head) * NT * 96 + wseg + r;
#pragma unroll
        for (int i = 0; i < 4; ++i)
#pragma unroll
          for (int e = 0; e < 16; ++e) kd[(size_t)(tb + i * 32 + crow(e, hh)) * 96] = f2bf(acc[i][j][e]);
      } else {
        bf16_t* vt = p.r2 + VDT_OFF + (size_t)((b * 4 + head) * 64 + (wseg - 64) + r) * NT;
#pragma unroll
        for (int i = 0; i < 4; ++i)
#pragma unroll
          for (int e4 = 0; e4 < 4; ++e4) {
            u32x2 o;
            o[0] = pack2(acc[i][j][e4 * 4 + 0], acc[i][j][e4 * 4 + 1]);
            o[1] = pack2(acc[i][j][e4 * 4 + 2], acc[i][j][e4 * 4 + 3]);
            *(u32x2*)(vt + tb + i * 32 + 16 * (e4 >> 1) + 8 * hh + 4 * (e4 & 1)) = o;
          }
      }
    }
  }
}


using f32x4 = __attribute__((ext_vector_type(4))) float;
typedef __attribute__((address_space(3))) unsigned lds_u32;
DI int lds_byte8(int r, int c) {
  int st = (r >> 4) * 2 + (c >> 5), rr = r & 15, cc = c & 31, ob = rr * 64 + cc * 2;
  return st * 1024 + (ob ^ (((ob >> 9) & 1) << 5));
}
DI void stage_rc8(int b, int& R, int& C) {
  int st = b / 1024, sb = b % 1024, swz = sb ^ (((sb >> 9) & 1) << 5);
  R = (st >> 1) * 16 + swz / 64;
  C = (st & 1) * 32 + (swz % 64) / 2;
}
#define G8_HT 16384
#define G8_SA(b, h) (smem + ((b) * 2 + (h)) * G8_HT)
#define G8_SB(b, h) (smem + (4 + (b) * 2 + (h)) * G8_HT)
#define G8_STAGE(P, BASE, goff0, goff1, ld, br, kt)                                                              \
  do {                                                                                                            \
    const bf16_t* _g = (BASE) + (size_t)(br) * (ld) + (size_t)(kt) * 64;                                          \
    __builtin_amdgcn_global_load_lds((const unsigned*)(_g + goff0), (lds_u32*)((P) + tid * 16), 16, 0, 0);        \
    __builtin_amdgcn_global_load_lds((const unsigned*)(_g + goff1), (lds_u32*)((P) + tid * 16 + 8192), 16, 0, 0); \
  } while (0)
#define G8_LDA(dst, b, h)                                                                                 \
  _Pragma("unroll") for (int m = 0; m < 4; ++m) _Pragma("unroll") for (int k = 0; k < 2; ++k) dst[m][k] = \
      *(const bf16x8*)(G8_SA(b, h) + lds_byte8(wr * 64 + m * 16 + fr, k * 32 + fq * 8))
#define G8_LDB(dst, b, h)                                                                                 \
  _Pragma("unroll") for (int n = 0; n < 2; ++n) _Pragma("unroll") for (int k = 0; k < 2; ++k) dst[n][k] = \
      *(const bf16x8*)(G8_SB(b, h) + lds_byte8(wc * 32 + n * 16 + fr, k * 32 + fq * 8))
#define G8_MMA(ai, bj, AT, BX)                                                                         \
  do {                                                                                                 \
    __builtin_amdgcn_s_setprio(1);                                                                     \
    _Pragma("unroll") for (int m = 0; m < 4; ++m) _Pragma("unroll") for (int n = 0; n < 2; ++n)        \
        _Pragma("unroll") for (int k = 0; k < 2; ++k) acc[ai][bj][m][n] =                              \
            __builtin_amdgcn_mfma_f32_16x16x32_bf16(AT[m][k], BX[n][k], acc[ai][bj][m][n], 0, 0, 0);   \
    __builtin_amdgcn_s_setprio(0);                                                                     \
  } while (0)
#define G8_WAIT_V(n) asm volatile("s_waitcnt vmcnt(" #n ")" ::: "memory")
#define G8_WAIT_L(n) asm volatile("s_waitcnt lgkmcnt(" #n ")" ::: "memory")
#define G8_BAR __builtin_amdgcn_s_barrier()
#define G8_SCHED __builtin_amdgcn_sched_barrier(0)

DI void gemm8_mainloop(const bf16_t* __restrict__ A, int lda, const bf16_t* __restrict__ Bt, int ldb, int K,
                       __attribute__((address_space(3))) char* smem, f32x4 (&acc)[2][2][4][2]) {
  const int tid = otid();
  const int wid = tid >> 6, lane = tid & 63, wr = wid >> 2, wc = wid & 3, fr = lane & 15, fq = lane >> 4;
  int r0, c0, r1, c1;
  stage_rc8(tid * 16, r0, c0);
  stage_rc8(tid * 16 + 8192, r1, c1);
  const int ga0 = r0 * lda + c0, ga1 = r1 * lda + c1, gb0 = r0 * ldb + c0, gb1 = r1 * ldb + c1;
#pragma unroll
  for (int a = 0; a < 2; ++a)
#pragma unroll
    for (int b = 0; b < 2; ++b)
#pragma unroll
      for (int m = 0; m < 4; ++m)
#pragma unroll
        for (int n = 0; n < 2; ++n) acc[a][b][m][n] = (f32x4){0.f, 0.f, 0.f, 0.f};
  bf16x8 At[4][2], B0[2][2], B1[2][2];
  const int nt = K >> 6;
  G8_WAIT_V(0);
  G8_STAGE(G8_SB(0, 0), Bt, gb0, gb1, ldb, 0, 0);
  G8_STAGE(G8_SA(0, 0), A, ga0, ga1, lda, 0, 0);
  G8_STAGE(G8_SB(0, 1), Bt, gb0, gb1, ldb, 128, 0);
  G8_STAGE(G8_SA(0, 1), A, ga0, ga1, lda, 128, 0);
  if (wr == 1) G8_BAR;
  G8_WAIT_V(4); G8_BAR;
  G8_STAGE(G8_SB(1, 0), Bt, gb0, gb1, ldb, 0, 1);
  G8_STAGE(G8_SA(1, 0), A, ga0, ga1, lda, 0, 1);
  G8_STAGE(G8_SB(1, 1), Bt, gb0, gb1, ldb, 128, 1);
  G8_WAIT_V(6); G8_BAR;
#pragma unroll 1
  for (int t = 0; t < nt - 2; t += 2) {
    G8_LDB(B0, 0, 0); G8_SCHED; G8_LDA(At, 0, 0); G8_STAGE(G8_SA(1, 1), A, ga0, ga1, lda, 128, t + 1);
    G8_WAIT_L(8); G8_BAR; G8_WAIT_L(0); G8_MMA(0, 0, At, B0); G8_BAR; G8_SCHED;
    G8_LDB(B1, 0, 1); G8_STAGE(G8_SB(0, 0), Bt, gb0, gb1, ldb, 0, t + 2);
    G8_BAR; G8_WAIT_L(0); G8_MMA(0, 1, At, B1); G8_BAR;
    G8_LDA(At, 0, 1); G8_STAGE(G8_SA(0, 0), A, ga0, ga1, lda, 0, t + 2);
    G8_BAR; G8_WAIT_L(0); G8_MMA(1, 0, At, B0); G8_BAR; G8_SCHED;
    G8_STAGE(G8_SB(0, 1), Bt, gb0, gb1, ldb, 128, t + 2);
    G8_WAIT_V(6); G8_BAR; G8_MMA(1, 1, At, B1); G8_BAR;
    G8_LDB(B0, 1, 0); G8_SCHED; G8_LDA(At, 1, 0); G8_STAGE(G8_SA(0, 1), A, ga0, ga1, lda, 128, t + 2);
    G8_WAIT_L(8); G8_BAR; G8_WAIT_L(0); G8_MMA(0, 0, At, B0); G8_BAR; G8_SCHED;
    G8_LDB(B1, 1, 1); G8_STAGE(G8_SB(1, 0), Bt, gb0, gb1, ldb, 0, t + 3);
    G8_BAR; G8_WAIT_L(0); G8_MMA(0, 1, At, B1); G8_BAR;
    G8_LDA(At, 1, 1); G8_STAGE(G8_SA(1, 0), A, ga0, ga1, lda, 0, t + 3);
    G8_BAR; G8_WAIT_L(0); G8_MMA(1, 0, At, B0); G8_BAR; G8_SCHED;
    G8_STAGE(G8_SB(1, 1), Bt, gb0, gb1, ldb, 128, t + 3);
    G8_WAIT_V(6); G8_BAR; G8_MMA(1, 1, At, B1); G8_BAR;
  }
  {
    G8_LDB(B0, 0, 0); G8_LDA(At, 0, 0); G8_STAGE(G8_SA(1, 1), A, ga0, ga1, lda, 128, nt - 1);
    G8_BAR; G8_WAIT_L(0); G8_MMA(0, 0, At, B0); G8_BAR;
    G8_LDB(B1, 0, 1); G8_BAR; G8_WAIT_L(0); G8_MMA(0, 1, At, B1); G8_BAR;
    G8_LDA(At, 0, 1); G8_WAIT_V(4); G8_BAR; G8_WAIT_L(0); G8_MMA(1, 0, At, B0); G8_MMA(1, 1, At, B1); G8_BAR;
  }
  {
    G8_LDB(B0, 1, 0); G8_LDA(At, 1, 0); G8_WAIT_V(2); G8_BAR; G8_WAIT_L(0); G8_MMA(0, 0, At, B0); G8_BAR;
    G8_LDB(B1, 1, 1); G8_WAIT_V(0); G8_BAR; G8_WAIT_L(0); G8_MMA(0, 1, At, B1); G8_BAR;
    G8_LDA(At, 1, 1); G8_BAR; G8_WAIT_L(0); G8_MMA(1, 0, At, B0); G8_MMA(1, 1, At, B1); G8_BAR;
  }
  if (wr == 0) G8_BAR;
}

DI void gemm8_tile(const Params& p, char* smem_g, int mode, const bf16_t* A, int lda, const bf16_t* Bt, int K, int rt,
                   int ct) {
  f32x4 acc[2][2][4][2];
  const int row0 = rt * 256, col0 = ct * 256;
  gemm8_mainloop(A + (size_t)row0 * lda, lda, Bt + (size_t)col0 * K, K, K,
                 (__attribute__((address_space(3))) char*)smem_g, acc);
  const int tid = otid();
  const int wid = tid >> 6, lane = tid & 63, wr = wid >> 2, wc = wid & 3, fr = lane & 15, fq = lane >> 4;
  const int b = row0 / NT;
  const int rw = row0 + wr * 64 + fq * 4;
  if (mode == EPI_SWIGLU) {
    bf16_t* act = p.r1;
#pragma unroll
    for (int ai = 0; ai < 2; ++ai)
#pragma unroll
      for (int m = 0; m < 4; ++m)
#pragma unroll
        for (int n = 0; n < 2; ++n)
#pragma unroll
          for (int j = 0; j < 4; ++j) {
            float g = acc[ai][0][m][n][j], u = acc[ai][1][m][n][j];
            act[(size_t)(rw + ai * 128 + m * 16 + j) * DFF + ct * 128 + wc * 32 + n * 16 + fr] = f2bf(silu(g) * u);
          }
  } else if (mode == EPI_Y) {
    bf16_t* y = p.r2;
#pragma unroll
    for (int ai = 0; ai < 2; ++ai)
#pragma unroll
      for (int bj = 0; bj < 2; ++bj)
#pragma unroll
        for (int m = 0; m < 4; ++m)
#pragma unroll
          for (int n = 0; n < 2; ++n)
#pragma unroll
            for (int j = 0; j < 4; ++j)
              y[(size_t)(rw + ai * 128 + m * 16 + j) * DM + col0 + bj * 128 + wc * 32 + n * 16 + fr] =
                  f2bf(acc[ai][bj][m][n][j]);
  } else {
    const int tw16 = row0 - b * NT + wr * 64 + (((fq & 1) << 1) | (fq >> 1)) * 4;
#pragma unroll
    for (int bj = 0; bj < 2; ++bj) {
      const int cb = col0 + bj * 128 + wc * 32;
      const bool isAv = (cb >= 512 && cb < 768);
      const bool isBv = (cb >= 1152 && cb < 1280);
      if (isAv || isBv) {
        bf16_t* vt;
        if (isAv) vt = p.r2 + VAT_OFF + (size_t)((b * 4 + (cb - 512) / 64) * 64 + (cb & 32)) * NT;
        else vt = p.r2 + VBT_OFF + (size_t)((b * 2 + (cb - 1152) / 64) * 64 + (cb & 32)) * NT;
#pragma unroll
        for (int ai = 0; ai < 2; ++ai)
#pragma unroll
          for (int m = 0; m < 4; ++m)
#pragma unroll
            for (int n = 0; n < 2; ++n) {
              u32x2 o;
              o[0] = pack2(acc[ai][bj][m][n][0], acc[ai][bj][m][n][1]);
              o[1] = pack2(acc[ai][bj][m][n][2], acc[ai][bj][m][n][3]);
              *(u32x2*)(vt + (size_t)(n * 16 + fr) * NT + tw16 + ai * 128 + m * 16) = o;
            }
      } else {
        bf16_t* pp = p.r1;
#pragma unroll
        for (int ai = 0; ai < 2; ++ai)
#pragma unroll
          for (int m = 0; m < 4; ++m)
#pragma unroll
            for (int n = 0; n < 2; ++n)
#pragma unroll
              for (int j = 0; j < 4; ++j)
                pp[(size_t)(rw + ai * 128 + m * 16 + j) * NIN + cb + n * 16 + fr] = f2bf(acc[ai][bj][m][n][j]);
      }
    }
  }
}

DI int xcd_vb(int bid, int nblk) {
  if (nblk & 7) return bid;
  return (bid & 7) * (nblk >> 3) + (bid >> 3);
}

DI void phase_gemm(const Params& p, char* smem, int bid, int nblk, int mode, int layer, const bf16_t* A, int lda,
                           const bf16_t* Bt, int K, int nct, bool lat_only) {
  const int nrt = lat_only ? 128 : 136;
  const int total = nrt * nct;
  for (int t = xcd_vb(bid, nblk); t < total; t += nblk) {
    int rti = t / nct, ct = t - rti * nct;
    int rt = lat_only ? lat_tile(rti) : rti;
    gemm8_tile(p, smem, mode, A, lda, Bt, K, rt, ct);
  }
}

DI void phase_rowprep(const Params& p, int bid, int nblk, int l) {
  const int tid = otid(); const int lane = tid & 63, w = tid >> 6;
  const int gw = bid * 8 + w, nw = nblk * 8;
  const float* __restrict__ ropeAc = p.rope;
  const float* __restrict__ ropeAs = p.rope + 512;
  const float* __restrict__ ropeBc = p.rope + 1024;
  const float* __restrict__ ropeBs = p.rope + 2048;
  const float gqn = p.g_qnorm[l * 64 + lane], gkn = p.g_knorm[l * 64 + lane];
  float lng[4], lnb[4], gqa[4], gkva[2];
#pragma unroll
  for (int i = 0; i < 4; ++i) {
    lng[i] = p.ln_g[l * 256 + i * 64 + lane];
    lnb[i] = p.ln_b[l * 256 + i * 64 + lane];
    gqa[i] = p.g_q_a[l * 256 + i * 64 + lane];
  }
  gkva[0] = p.g_kv_a[l * 128 + lane];
  gkva[1] = p.g_kv_a[l * 128 + 64 + lane];
  const float scaleA = 0.17677669529663687f * LOG2E;
  const float scaleB = 0.125f * LOG2E;
  bf16_t* __restrict__ qkv = p.r2;
  for (int R = gw; R < MROWS; R += nw) {
    const int b = R / NT, t = R - b * NT;
    const bool isctx = t < 256;
    const int pos = t - 256;
    const int prow = pos >> 6, pcol = pos & 63;
    bf16_t* P = p.r1 + (size_t)R * NIN;
    float va[8], vb[6], vc[8], vd[6], vkr;
#pragma unroll
    for (int i = 0; i < 8; ++i) va[i] = bf2f(P[i * 64 + lane]);
#pragma unroll
    for (int i = 0; i < 6; ++i) vb[i] = bf2f(P[768 + i * 64 + lane]);
#pragma unroll
    for (int i = 0; i < 8; ++i) vc[i] = bf2f(P[1280 + i * 64 + lane]);
#pragma unroll
    for (int i = 0; i < 6; ++i) vd[i] = bf2f(P[1792 + i * 64 + lane]);
    vkr = bf2f(P[2176 + (lane & 31)]);
    {
      const int d = lane & 31;
      const int pa = (d & 16) ? pcol : prow;
      float cs = 1.f, sn = 0.f;
      if (!isctx) { cs = ropeAc[pa * 8 + (d & 7)]; sn = ropeAs[pa * 8 + (d & 7)]; }
      const float sg = (d & 8) ? sn : -sn;
#pragma unroll
      for (int i = 0; i < 4; ++i) {
        const int hm = (i * 64 + lane) >> 5;
        float vq = va[i], vk = va[4 + i];
        float pq = __shfl_xor(vq, 8), pk = __shfl_xor(vk, 8);
        vq = vq * cs + sg * pq;
        vk = vk * cs + sg * pk;
        size_t o = ((size_t)(b * 8 + hm) * NT + t) * 32 + d;
        qkv[QA_OFF + o] = f2bf(vq * scaleA);
        qkv[KA_OFF + o] = f2bf(vk);
      }
    }
    {
      const int d = lane;
      const int pa = (d & 32) ? pcol : prow;
      float cs = 1.f, sn = 0.f;
      if (!isctx) { cs = ropeBc[pa * 16 + (d & 15)]; sn = ropeBs[pa * 16 + (d & 15)]; }
      const float sg = (d & 16) ? sn : -sn;
      float ss[6];
#pragma unroll
      for (int i = 0; i < 6; ++i) ss[i] = vb[i] * vb[i];
#pragma unroll
      for (int o = 32; o >= 1; o >>= 1)
#pragma unroll
        for (int i = 0; i < 6; ++i) ss[i] += __shfl_xor(ss[i], o);
#pragma unroll
      for (int i = 0; i < 6; ++i) {
        float v = vb[i] * rsqrtf(ss[i] * (1.f / 64.f) + EPS) * (i < 4 ? gqn : gkn);
        float pr = __shfl_xor(v, 16);
        v = v * cs + sg * pr;
        if (i < 4) qkv[QB_OFF + ((size_t)(b * 4 + i) * NT + t) * 64 + d] = f2bf(v * scaleB);
        else qkv[KB_OFF + ((size_t)(b * 2 + (i - 4)) * NT + t) * 64 + d] = f2bf(v);
      }
    }
    {
      float s1 = 0.f, sq = 0.f, skv = 0.f;
#pragma unroll
      for (int i = 0; i < 4; ++i) {
        vc[i] = gelu_tanh(vc[i]);
        vc[4 + i] = gelu_tanh(vc[4 + i]);
        s1 += vc[4 + i];
        sq += vd[i] * vd[i];
      }
      skv = vd[4] * vd[4] + vd[5] * vd[5];
#pragma unroll
      for (int o = 32; o >= 1; o >>= 1) {
        s1 += __shfl_xor(s1, o);
        sq += __shfl_xor(sq, o);
        skv += __shfl_xor(skv, o);
      }
      const float mu = s1 * (1.f / 256.f);
      float s2 = 0.f;
#pragma unroll
      for (int i = 0; i < 4; ++i) { vc[4 + i] -= mu; s2 += vc[4 + i] * vc[4 + i]; }
      s2 = wave_sum(s2);
      const float rln = rsqrtf(s2 * (1.f / 256.f) + EPS);
      const float rq = rsqrtf(sq * (1.f / 256.f) + EPS);
      const float rkv = rsqrtf(skv * (1.f / 128.f) + EPS);
#pragma unroll
      for (int i = 0; i < 4; ++i) {
        P[1280 + i * 64 + lane] = f2bf(vc[i]);
        P[1536 + i * 64 + lane] = f2bf(vc[4 + i] * rln * lng[i] + lnb[i]);
        P[1792 + i * 64 + lane] = f2bf(vd[i] * rq * gqa[i]);
      }
      P[2048 + lane] = f2bf(vd[4] * rkv * gkva[0]);
      P[2048 + 64 + lane] = f2bf(vd[5] * rkv * gkva[1]);
    }
    {
      const int d = lane & 31;
      float kr = vkr;
      float pr = __shfl_xor(kr, 8);
      if (!isctx) {
        const int pa = (d & 16) ? pcol : prow;
        kr = kr * ropeAc[pa * 8 + (d & 7)] + ((d & 8) ? pr : -pr) * ropeAs[pa * 8 + (d & 7)];
      }
      if (lane < 32) {
        const bf16_t kb = f2bf(kr);
#pragma unroll
        for (int hd = 0; hd < 4; ++hd) qkv[KD_OFF + ((size_t)(b * 4 + hd) * NT + t) * 96 + 64 + d] = kb;
      }
    }
  }
}

DI void gmlp_item(const Params& p, char* smem, int l, int ch, int g) {
  const int tid = otid(), lane = tid & 63, w = tid >> 6, r = lane & 31, hh = lane >> 5;
  const int R0 = ch * 128;
  bf16_t* vT = (bf16_t*)smem;
#pragma unroll
  for (int u = 0; u < 2; ++u) {
    const int cid = tid + u * NTHREADS;
    const int q = cid >> 3, cc = cid & 7;
    u32x4 v = *(const u32x4*)(p.r1 + (size_t)(R0 + q) * NIN + 1536 + g * 64 + cc * 8);
#pragma unroll
    for (int j = 0; j < 4; ++j) {
      vT[(cc * 8 + 2 * j) * 136 + q] = (bf16_t)(v[j] & 0xffffu);
      vT[(cc * 8 + 2 * j + 1) * 136 + q] = (bf16_t)(v[j] >> 16);
    }
  }
  __syncthreads();
  const int wp = w >> 1, wc = w & 1;
  const bf16_t* wsp = p.wts + (size_t)l * LAYER_W + OFF_WSP + (size_t)g * 16384;
  f32x16 acc;
#pragma unroll
  for (int e = 0; e < 16; ++e) acc[e] = 0.f;
#pragma unroll
  for (int ks = 0; ks < 8; ++ks) {
    bf16x8 a = *(const bf16x8*)(wsp + (wp * 32 + r) * 128 + ks * 16 + hh * 8);
    bf16x8 bb = *(const bf16x8*)(vT + (wc * 32 + r) * 136 + ks * 16 + hh * 8);
    acc = MFMA32(a, bb, acc);
  }
  const int c = g * 64 + wc * 32 + r;
#pragma unroll
  for (int e = 0; e < 16; ++e) {
    const int pp = wp * 32 + crow(e, hh);
    const float u = bf2f(p.r1[(size_t)(R0 + pp) * NIN + 1280 + c]);
    const float mixed = acc[e] + p.b_spatial[(size_t)l * 512 + g * 128 + pp];
    p.h[(size_t)(R0 + pp) * DM + 512 + c] = f2bf(u * mixed);
  }
  __syncthreads();
}

DI void phase_dexp_gmlp(const Params& p, char* smem, int bid, int nblk, int l) {
  const bool lat_only = (l == 1);
  const bf16_t* wl = p.wts + (size_t)l * LAYER_W;
  const int nch = lat_only ? 256 : 272;
  const int total = 272 + 272 + nch * 4;
  for (int t = xcd_vb(bid, nblk); t < total; t += nblk) {
    if (t < 272) {
      gemm_tile(p, smem, EPI_UQ, l, p.r1 + 1792, NIN, wl + OFF_WUQ, 256, t >> 1, t & 1);
    } else if (t < 544) {
      int u = t - 272;
      gemm_tile(p, smem, EPI_UKV, l, p.r1 + 2048, NIN, wl + OFF_WUKV, 128, u >> 1, u & 1);
    } else {
      int u = t - 544;
      int ci = u >> 2, g = u & 3;
      int ch = lat_only ? ((ci >> 5) * 34 + 2 + (ci & 31)) : ci;
      gmlp_item(p, smem, l, ch, g);
    }
  }
}

template <int CPR>
DI int kswz(int c, int row) {
  if (CPR == 4) return c ^ ((row >> 2) & 3);
  if (CPR == 8) return c ^ ((row >> 1) & 7);
  return (c & 12) | ((c & 3) ^ ((row >> 2) & 3));
}

template <int DQK, int NMAP>
DI void attn_item(const bf16_t* __restrict__ Qb, const bf16_t* __restrict__ Kb, const bf16_t* __restrict__ Vt,
                  int q0, int nkeys, bf16_t* __restrict__ outp, char* smem_g, float lam, float post_scale,
                  const float* __restrict__ g_subln) {
  typedef __attribute__((address_space(3))) char lchar;
  lchar* smem = (lchar*)smem_g;
  constexpr int CPR = DQK / 8;
  constexpr int KMAPB = 64 * CPR * 16;
  constexpr int KBYTES = NMAP * KMAPB;
  constexpr int STAGE = KBYTES + 8192;
  constexpr int NS = 4;
  constexpr int NKS = KBYTES / 16;
  constexpr int GK = (NKS + NTHREADS - 1) / NTHREADS;
  constexpr int KK = DQK / 16;
  constexpr float THR = 6.0f;
  const int tid = otid();
  const int lane = tid & 63, w = tid >> 6, r = lane & 31, hh = lane >> 5;

  asm volatile("s_waitcnt vmcnt(0)" ::: "memory");
  __builtin_amdgcn_s_barrier();
  asm volatile("" ::: "memory");

  bf16x8 qf[NMAP][KK];
  {
    const int qrow = q0 + w * 32 + r;
#pragma unroll
    for (int m = 0; m < NMAP; ++m)
#pragma unroll
      for (int kk = 0; kk < KK; ++kk)
        qf[m][kk] = *(const bf16x8*)(Qb + (size_t)m * NT * DQK + (size_t)qrow * DQK + kk * 16 + hh * 8);
  }
  const bf16_t* ksrc[GK];
  int kslot[GK];
#pragma unroll
  for (int u = 0; u < GK; ++u) {
    int sl = tid + u * NTHREADS;
    if (sl >= NKS) sl = tid;
    const int m = sl / (64 * CPR), rem = sl % (64 * CPR), row = rem / CPR, cp = rem % CPR;
    const int c = kswz<CPR>(cp, row);
    ksrc[u] = Kb + (size_t)m * NT * DQK + (size_t)row * DQK + c * 8;
    kslot[u] = sl * 16;
  }
  const int vrow = tid >> 3, vcp = tid & 7;
  const bf16_t* vsrc = Vt + (size_t)vrow * NT + ((vcp ^ ((vrow >> 1) & 7)) * 8);
  const int vslot = KBYTES + tid * 16;
  const int nt = nkeys >> 6;

#define ATT_ISSUE(tile)                                                                                           \
  do {                                                                                                            \
    const int _tl = (tile) < nt ? (tile) : nt - 1;                                                                \
    lchar* _st = smem + ((tile) & (NS - 1)) * STAGE;                                                              \
    _Pragma("unroll") for (int u = 0; u < GK; ++u) __builtin_amdgcn_global_load_lds(                              \
        (const unsigned*)(ksrc[u] + (size_t)_tl * 64 * DQK), (lds_u32*)(_st + kslot[u]), 16, 0, 0);                \
    __builtin_amdgcn_global_load_lds((const unsigned*)(vsrc + _tl * 64), (lds_u32*)(_st + vslot), 16, 0, 0);      \
  } while (0)

  f32x16 O[NMAP][2];
  float mrun[NMAP], lrun[NMAP];
#pragma unroll
  for (int m = 0; m < NMAP; ++m) {
    mrun[m] = 0.f;
    lrun[m] = 0.f;
#pragma unroll
    for (int d = 0; d < 2; ++d)
#pragma unroll
      for (int e = 0; e < 16; ++e) O[m][d][e] = 0.f;
  }
  ATT_ISSUE(0);
  ATT_ISSUE(1);
  ATT_ISSUE(2);
  const int kq = (r >> 2) & 3, k8 = (r >> 1) & 7;
#pragma unroll 1
  for (int it = 0; it < nt; ++it) {
    if (GK == 1) asm volatile("s_waitcnt vmcnt(4)" ::: "memory");
    else asm volatile("s_waitcnt vmcnt(6)" ::: "memory");
    __builtin_amdgcn_s_barrier();
    asm volatile("" ::: "memory");
    ATT_ISSUE(it + 3);
    const lchar* cur = smem + (it & (NS - 1)) * STAGE;
    bf16x8 pb[NMAP][2][2];
#pragma unroll
    for (int m = 0; m < NMAP; ++m) {
      f32x16 S[2];
      const float ninit = -mrun[m];
#pragma unroll
      for (int t2 = 0; t2 < 2; ++t2) {
#pragma unroll
        for (int e = 0; e < 16; ++e) S[t2][e] = ninit;
#pragma unroll
        for (int kk = 0; kk < KK; ++kk) {
          const int c = kk * 2 + hh;
          const int cp = (CPR == 8) ? (c ^ k8) : ((c & 12) | ((c & 3) ^ kq));
          bf16x8 a = *(const bf16x8*)(cur + m * KMAPB + (t2 * 32 + r) * (CPR * 16) + cp * 16);
          S[t2] = MFMA32(a, qf[m][kk], S[t2]);
        }
      }
      float mx = fmaxf(S[0][0], S[1][0]);
#pragma unroll
      for (int e = 1; e < 16; ++e) mx = fmaxf(mx, fmaxf(S[0][e], S[1][e]));
      mx = fmaxf(mx, __shfl_xor(mx, 32));
      const bool need = (it == 0) || (mx > THR);
      if (__builtin_amdgcn_ballot_w64(need) != 0ull) {
        const float sh = need ? mx : 0.f;
        const float alpha = (it == 0) ? 1.f : __builtin_amdgcn_exp2f(-sh);
        mrun[m] += sh;
        lrun[m] *= alpha;
#pragma unroll
        for (int d = 0; d < 2; ++d)
#pragma unroll
          for (int e = 0; e < 16; ++e) O[m][d][e] *= alpha;
#pragma unroll
        for (int t2 = 0; t2 < 2; ++t2)
#pragma unroll
          for (int e = 0; e < 16; ++e) S[t2][e] -= sh;
      }
      float sum = 0.f;
#pragma unroll
      for (int t2 = 0; t2 < 2; ++t2)
#pragma unroll
        for (int e = 0; e < 16; ++e) {
          float pv = __builtin_amdgcn_exp2f(S[t2][e]);
          S[t2][e] = pv;
          sum += pv;
        }
      lrun[m] += sum;
#pragma unroll
      for (int t2 = 0; t2 < 2; ++t2)
#pragma unroll
        for (int s2 = 0; s2 < 2; ++s2) {
          u32x4 pk;
#pragma unroll
          for (int j = 0; j < 4; ++j) pk[j] = pack2(S[t2][8 * s2 + 2 * j], S[t2][8 * s2 + 2 * j + 1]);
          pb[m][t2][s2] = __builtin_bit_cast(bf16x8, pk);
        }
    }
    const lchar* vs = cur + KBYTES;
#pragma unroll
    for (int d = 0; d < 2; ++d)
#pragma unroll
      for (int t2 = 0; t2 < 2; ++t2)
#pragma unroll
        for (int s2 = 0; s2 < 2; ++s2) {
          const int c = t2 * 4 + s2 * 2 + hh;
          bf16x8 vf = *(const bf16x8*)(vs + (d * 32 + r) * 128 + ((c ^ k8) * 16));
#pragma unroll
          for (int m = 0; m < NMAP; ++m) O[m][d] = MFMA32(vf, pb[m][t2][s2], O[m][d]);
        }
  }
#undef ATT_ISSUE
  asm volatile("s_waitcnt vmcnt(0)" ::: "memory");
#pragma unroll
  for (int m = 0; m < NMAP; ++m) lrun[m] += __shfl_xor(lrun[m], 32);
  bf16_t* orow = outp + (size_t)(w * 32 + r) * DM;
  if (NMAP == 1) {
    const float inv = 1.f / lrun[0];
#pragma unroll
    for (int d = 0; d < 2; ++d)
#pragma unroll
      for (int e4 = 0; e4 < 4; ++e4) {
        u32x2 o;
        o[0] = pack2(O[0][d][e4 * 4 + 0] * inv, O[0][d][e4 * 4 + 1] * inv);
        o[1] = pack2(O[0][d][e4 * 4 + 2] * inv, O[0][d][e4 * 4 + 3] * inv);
        *(u32x2*)(orow + d * 32 + 8 * e4 + 4 * hh) = o;
      }
  } else {
    const float i1 = 1.f / lrun[0], i2 = lam / lrun[NMAP - 1];
    float ss = 0.f;
#pragma unroll
    for (int d = 0; d < 2; ++d)
#pragma unroll
      for (int e = 0; e < 16; ++e) {
        float o = O[0][d][e] * i1 - O[NMAP - 1][d][e] * i2;
        O[0][d][e] = o;
        ss += o * o;
      }
    ss += __shfl_xor(ss, 32);
    const float rstd = rsqrtf(ss * (1.f / 64.f) + EPS) * post_scale;
#pragma unroll
    for (int d = 0; d < 2; ++d)
#pragma unroll
      for (int e4 = 0; e4 < 4; ++e4) {
        const int dv = d * 32 + 8 * e4 + 4 * hh;
        u32x2 o;
        o[0] = pack2(O[0][d][e4 * 4 + 0] * rstd * g_subln[dv + 0], O[0][d][e4 * 4 + 1] * rstd * g_subln[dv + 1]);
        o[1] = pack2(O[0][d][e4 * 4 + 2] * rstd * g_subln[dv + 2], O[0][d][e4 * 4 + 3] * rstd * g_subln[dv + 3]);
        *(u32x2*)(orow + dv) = o;
      }
  }
}

DI void phase_attn(const Params& p, char* smem, int bid, int nblk, int l) {
  const bool lat_only = (l == 1);
  const int nq = lat_only ? 16 : 17;
  const int per = NB * 4 * nq;
  const int total = 3 * per;
  const float lam_init = (l == 0) ? 0.2f : 0.35550906759096927f;
  float lam;
  {
    const float* lv = p.lam_vecs + l * 128;
    float s1 = 0.f, s2 = 0.f;
    for (int i = 0; i < 32; ++i) { s1 += lv[i] * lv[32 + i]; s2 += lv[64 + i] * lv[96 + i]; }
    lam = expf(s1) - expf(s2) + lam_init;
  }
  for (int t = xcd_vb(bid, nblk); t < total; t += nblk) {
    const int mixer = t / per;
    int u = t - mixer * per;
    const int bh = u / nq;
    int qb = u - bh * nq;
    if (lat_only) qb += 1;
    const int b = bh >> 2, hd = bh & 3;
    const int q0 = qb * 256;
    const int nkeys = (qb == 0) ? 256 : NT;
    bf16_t* mixrow = p.h + ((size_t)b * NT + q0) * DM;
    if (mixer == 0) {
      attn_item<32, 2>(p.r2 + QA_OFF + (size_t)(b * 4 + hd) * 2 * NT * 32, p.r2 + KA_OFF + (size_t)(b * 4 + hd) * 2 * NT * 32,
                       p.r2 + VAT_OFF + (size_t)(b * 4 + hd) * 64 * NT, q0, nkeys, mixrow + hd * 64, smem, lam,
                       1.f - lam_init, p.g_subln + l * 64);
    } else if (mixer == 1) {
      attn_item<96, 1>(p.r2 + QD_OFF + (size_t)(b * 4 + hd) * NT * 96, p.r2 + KD_OFF + (size_t)(b * 4 + hd) * NT * 96,
                       p.r2 + VDT_OFF + (size_t)(b * 4 + hd) * 64 * NT, q0, nkeys, mixrow + 768 + hd * 64, smem, 0.f, 0.f,
                       nullptr);
    } else {
      attn_item<64, 1>(p.r2 + QB_OFF + (size_t)(b * 4 + hd) * NT * 64, p.r2 + KB_OFF + (size_t)(b * 2 + (hd >> 1)) * NT * 64,
                       p.r2 + VBT_OFF + (size_t)(b * 2 + (hd >> 1)) * 64 * NT, q0, nkeys, mixrow + 256 + hd * 64, smem, 0.f,
                       0.f, nullptr);
    }
  }
}


#define XB_TMO      128
#define XB_XCNT(j)  (256  + 64 * (j))
#define XB_XSUB(j)  (1280 + 64 * (j))
#define XB_XGEN(j)  (2304 + 64 * (j))
#define XB_TOP      3328
#define XB_TOPGEN   3392
#define XCD_BAR_WORDS 3456
#define XB_SPIN_CAP (1u << 18)
#define LAS __attribute__((address_space(3)))
DI unsigned xb_ld(unsigned* p) { return __hip_atomic_load(p, __ATOMIC_RELAXED, __HIP_MEMORY_SCOPE_AGENT); }
DI unsigned xb_add(unsigned* p, unsigned v) { return __hip_atomic_fetch_add(p, v, __ATOMIC_RELAXED, __HIP_MEMORY_SCOPE_AGENT); }
DI unsigned xb_xcc_id() { return (unsigned)__builtin_amdgcn_s_getreg((3 << 11) | 20) & 0xFu; }
#define XB_SPIN(cond, bar) do { unsigned _sp = 0; while (cond) { __builtin_amdgcn_s_sleep(1); \
    if ((++_sp & 255u) == 0u) { if (xb_ld(&(bar)[XB_TMO])) break; if (_sp > XB_SPIN_CAP) { atomicAdd(&(bar)[XB_TMO], 1u); break; } } } } while (0)
struct XcdBarrier { unsigned* bar; unsigned x; volatile LAS unsigned* st; };
DI XcdBarrier xcd_barrier_post(unsigned* bar, volatile LAS unsigned* st) {
  XcdBarrier b; b.bar = bar; b.x = xb_xcc_id(); b.st = st;
  if (threadIdx.x == 0) (void)xb_add(&bar[XB_XCNT(b.x)], 1u);
  return b;
}
DI void xcd_barrier_complete(unsigned* bar, unsigned x, unsigned& nloc, unsigned& nx) {
  const unsigned G = gridDim.x * gridDim.y * gridDim.z;
  unsigned sum, cnt, mine, sp = 0u;
  for (;;) {
    sum = 0u; cnt = 0u; mine = 0u;
#pragma unroll
    for (unsigned j = 0; j < 16; ++j) { const unsigned c = xb_ld(&bar[XB_XCNT(j)]); sum += c; cnt += (c > 0u) ? 1u : 0u; mine = (j == x) ? c : mine; }
    if (sum == G) break;
    __builtin_amdgcn_s_sleep(1);
    if ((++sp & 255u) == 0u) { if (xb_ld(&bar[XB_TMO])) break; if (sp > XB_SPIN_CAP) { atomicAdd(&bar[XB_TMO], 1u); break; } }
  }
  nloc = mine > 0u ? mine : 1u; nx = cnt > 0u ? cnt : 1u;
}
DI void xcd_barrier(const XcdBarrier& b) {
  asm volatile("s_waitcnt vmcnt(0)" ::: "memory");
  __syncthreads();
  if (threadIdx.x == 0) {
    unsigned* bar = b.bar;
    __builtin_amdgcn_s_waitcnt(0);
    unsigned nloc = b.st[0], nx = b.st[1];
    if (nloc == 0u) { xcd_barrier_complete(bar, b.x, nloc, nx); b.st[0] = nloc; b.st[1] = nx; }
    const unsigned old = xb_add(&bar[XB_XSUB(b.x)], 1u);
    const unsigned gen = old / nloc;
    if (old + 1u == (gen + 1u) * nloc) {
      __builtin_amdgcn_fence(__ATOMIC_RELEASE, "agent");
      asm volatile("s_waitcnt vmcnt(0)" ::: "memory");
      const unsigned og = xb_add(&bar[XB_TOP], 1u);
      const unsigned tg = og / nx;
      if (og + 1u == (tg + 1u) * nx) xb_add(&bar[XB_TOPGEN], 1u);
      else XB_SPIN(xb_ld(&bar[XB_TOPGEN]) == tg, bar);
      __builtin_amdgcn_fence(__ATOMIC_ACQUIRE, "agent");
      xb_add(&bar[XB_XGEN(b.x)], 1u);
      asm volatile("s_waitcnt vmcnt(0)" ::: "memory");
    } else {
      XB_SPIN(xb_ld(&bar[XB_XGEN(b.x)]) == gen, bar);
      __builtin_amdgcn_fence(__ATOMIC_ACQUIRE, "agent");
      asm volatile("s_waitcnt vmcnt(0)" ::: "memory");
    }
  }
  __syncthreads();
}

constexpr int N_PHASES = 26;
#ifndef PMASK
#define PMASK 0xffff
#endif
#define PM(k) ((PMASK >> (k)) & 1)
#ifndef REPMASK
#define REPMASK 0
#endif

__global__ void __launch_bounds__(NTHREADS) trunk_megakernel(Params p) {
  __shared__ __attribute__((aligned(16))) char smem[131072 + 16];
  cg::grid_group grid = cg::this_grid();
  const int bid = blockIdx.x, nblk = gridDim.x;
  if (threadIdx.x == 0) *(uint4*)(smem + 131072) = make_uint4(0u, 0u, 0u, 0u);
  __syncthreads();
  XcdBarrier xb;
  xb.bar = p.bar; xb.x = 0; xb.st = (volatile LAS unsigned*)(smem + 131072);
  if (p.phase_hi - p.phase_lo > 1) xb = xcd_barrier_post(p.bar, (volatile LAS unsigned*)(smem + 131072));
#pragma unroll 1
  for (int ph = p.phase_lo; ph < p.phase_hi; ++ph) {
    if (ph == 0) {
      if (PM(12)) phase_setup(p, smem, bid, nblk);
    } else if (ph == 1) {
      if (PM(13)) phase_rowpass(p, bid, nblk, 0, -1, 0.f, 0, 0, true, false);
    } else {
      const int l = (ph - 2) / 12, s = (ph - 2) % 12;
      const int nrep = ((REPMASK >> s) & 1) ? 2 : 1;
#pragma unroll 1
      for (int rep = 0; rep < nrep; ++rep) {
      if (rep) xcd_barrier(xb);
      const bf16_t* wl = p.wts + (size_t)l * LAYER_W;
      const bool lo = (l == 1);
      switch (s) {
        case 0: if (PM(0)) phase_gemm(p, smem, bid, nblk, EPI_SWIGLU, l, p.h, DM, wl + OFF_W1, DM, 22, false); break;
        case 1: if (PM(1)) phase_gemm(p, smem, bid, nblk, EPI_Y, l, p.r1, DFF, wl + OFF_W2, DFF, 4, false); break;
        case 2: if (PM(2)) phase_rowpass(p, bid, nblk, l, 0, 0.5f, l, 1, l == 0, false); break;
        case 3: if (PM(3)) phase_gemm(p, smem, bid, nblk, EPI_WIN, l, p.h, DM, wl + OFF_WIN, DM, 9, false); break;
        case 4: if (PM(4)) phase_rowprep(p, bid, nblk, l); break;
        case 5: if (PM(5)) phase_dexp_gmlp(p, smem, bid, nblk, l); break;
        case 6: if (PM(6)) phase_attn(p, smem, bid, nblk, l); break;
        case 7: if (PM(7)) phase_gemm(p, smem, bid, nblk, EPI_Y, l, p.h, DM, wl + OFF_WOUT, DM, 4, lo); break;
        case 8: if (PM(8)) phase_rowpass(p, bid, nblk, l, 1, 1.0f, l, 2, false, lo); break;
        case 9: if (PM(9)) phase_gemm(p, smem, bid, nblk, EPI_SWIGLU, l, p.h, DM, wl + OFF_W3, DM, 22, lo); break;
        case 10: if (PM(10)) phase_gemm(p, smem, bid, nblk, EPI_Y, l, p.r1, DFF, wl + OFF_W4, DFF, 4, lo); break;
        default: if (PM(11)) phase_rowpass(p, bid, nblk, l, 2, 0.5f, l + 1, (l == 0) ? 0 : -1, false, lo); break;
      }
      }
    }
    if (ph + 1 < p.phase_hi) { if (ph == 0) grid.sync(); else xcd_barrier(xb); }
  }
}

extern "C" void kernel_launch(void* const* d_in, const int* in_sizes, int n_in, void* d_out, int out_size, void* d_ws,
                              size_t ws_size, hipStream_t stream) {
  static int grid_blocks = 0;
  if (!grid_blocks) {
    int dev = 0, cus = 0, per_cu = 0;
    hipGetDevice(&dev);
    hipDeviceGetAttribute(&cus, hipDeviceAttributeMultiprocessorCount, dev);
    hipOccupancyMaxActiveBlocksPerMultiprocessor(&per_cu, trunk_megakernel, NTHREADS, 0);
    if (per_cu < 1) per_cu = 1;
    if (per_cu > 1) per_cu = 1;
    grid_blocks = cus * per_cu;
  }
  Params p{};
  const float** pf = (const float**)&p;
  for (int i = 0; i < 26; ++i) pf[i] = (const float*)d_in[i];
  p.out = (float*)d_out;
  char* ws = (char*)d_ws;
  size_t off = 0;
  auto take = [&](size_t bytes) { char* q = ws + off; off += (bytes + 255) & ~(size_t)255; return q; };
  p.wts = (bf16_t*)take(2 * LAYER_W * 2);
  p.mods = (float*)take((size_t)2 * 9 * 9216 * 4);
  p.rope = (float*)take(3072 * 4);
  p.xctx = (float*)take((size_t)2048 * 1024 * 4);
  p.h = (bf16_t*)take((size_t)MROWS * DM * 2);
  p.r1 = (bf16_t*)take((size_t)MROWS * DFF * 2);
  p.r2 = (bf16_t*)take((size_t)MROWS * NIN * 2);
  p.bar = (unsigned*)take(XCD_BAR_WORDS * 4);
  hipMemsetAsync(p.bar, 0, XCD_BAR_WORDS * 4, stream);
  if (off > ws_size) fprintf(stderr, "workspace too small: need %zu have %zu\n", off, ws_size);
#if MULTI_LAUNCH
  for (int ph = 0; ph < N_PHASES; ++ph) {
    Params q = p;
    q.phase_lo = ph;
    q.phase_hi = ph + 1;
    void* args[] = {&q};
    hipError_t e = hipLaunchCooperativeKernel((void*)trunk_megakernel, dim3(grid_blocks), dim3(NTHREADS), args, 0, stream);
    if (e != hipSuccess) fprintf(stderr, "launch failed: %s\n", hipGetErrorString(e));
  }
#else
  p.phase_lo = 0;
  p.phase_hi = N_PHASES;
  void* args[] = {&p};
  hipError_t e = hipLaunchCooperativeKernel((void*)trunk_megakernel, dim3(grid_blocks), dim3(NTHREADS), args, 0, stream);
  if (e != hipSuccess) fprintf(stderr, "cooperative launch failed: %s (grid %d)\n", hipGetErrorString(e), grid_blocks);
#endif
}
```

```cpp
#include <hip/hip_runtime.h>
#include <hip/hip_cooperative_groups.h>
#include <stdint.h>
#include <cstdio>
namespace cg = cooperative_groups;

#ifndef MULTI_LAUNCH
#define MULTI_LAUNCH 0
#endif

typedef unsigned short bf16_t;
using bf16x8 = __attribute__((ext_vector_type(8))) short;
using f32x16 = __attribute__((ext_vector_type(16))) float;
using u32x4 = __attribute__((ext_vector_type(4))) unsigned;
using u32x2 = __attribute__((ext_vector_type(2))) unsigned;

#define DI __device__ __forceinline__
#define MFMA32(a, b, c) __builtin_amdgcn_mfma_f32_32x32x16_bf16((a), (b), (c), 0, 0, 0)

constexpr int NT = 4352;
constexpr int NB = 8;
constexpr int MROWS = NB * NT;
constexpr int DM = 1024;
constexpr int DFF = 2816;
constexpr int NIN = 2304;
constexpr int NTHREADS = 512;
constexpr float EPS = 1e-6f;
constexpr float LOG2E = 1.4426950408889634f;

constexpr size_t OFF_W1 = 0;
constexpr size_t OFF_W2 = 5767168;
constexpr size_t OFF_W3 = 8650752;
constexpr size_t OFF_W4 = 14417920;
constexpr size_t OFF_WIN = 17301504;
constexpr size_t OFF_WOUT = 19660800;
constexpr size_t OFF_WUQ = 20709376;
constexpr size_t OFF_WUKV = 20840448;
constexpr size_t OFF_WSP = 20905984;
constexpr size_t LAYER_W = 20971520;

constexpr size_t QA_OFF = 0;
constexpr size_t KA_OFF = 8912896;
constexpr size_t VAT_OFF = 17825792;
constexpr size_t QB_OFF = 26738688;
constexpr size_t KB_OFF = 35651584;
constexpr size_t VBT_OFF = 40108032;
constexpr size_t QD_OFF = 44564480;
constexpr size_t KD_OFF = 57933824;
constexpr size_t VDT_OFF = 71303168;

struct Params {
  const float *x, *c, *ctx, *c_ctx, *w_ada, *b_ada, *g_pre, *g_post, *w_ffn1_in, *w_ffn1_out, *w_ffn2_in,
      *w_ffn2_out, *w_in, *w_out, *lam_vecs, *g_subln, *g_qnorm, *g_knorm, *w_spatial, *b_spatial, *ln_g, *ln_b,
      *g_q_a, *w_uq, *g_kv_a, *w_ukv;
  float* out;
  bf16_t* wts;
  float* mods;
  float* rope;
  float* xctx;
  bf16_t* h;
  bf16_t* r1;
  bf16_t* r2;
  unsigned* bar;
  int phase_lo, phase_hi;
};

DI int otid() { int t = threadIdx.x; asm volatile("" : "+v"(t)); return t; }
DI float bf2f(bf16_t v) { return __uint_as_float(((unsigned)v) << 16); }
DI bf16_t f2bf(float f) { __bf16 b = (__bf16)f; return __builtin_bit_cast(unsigned short, b); }
DI unsigned pack2(float a, float b) {
  unsigned r;
  asm("v_cvt_pk_bf16_f32 %0, %1, %2" : "=v"(r) : "v"(a), "v"(b));
  return r;
}
DI float max3f(float a, float b, float c) {
  float r;
  asm("v_max3_f32 %0, %1, %2, %3" : "=v"(r) : "v"(a), "v"(b), "v"(c));
  return r;
}
DI int crow(int e, int hh) { return (e & 3) + 8 * (e >> 2) + 4 * hh; }
DI float wave_sum(float v) {
#pragma unroll
  for (int o = 32; o >= 1; o >>= 1) v += __shfl_xor(v, o);
  return v;
}
DI float gelu_tanh(float x) {
  float u = 0.7978845608028654f * (x + 0.044715f * x * x * x);
  return 0.5f * x * (1.f + tanhf(u));
}
DI float silu(float x) { return x / (1.f + __expf(-x)); }

DI void convert_tile(const float* __restrict__ src, int K, int N, int mode, bf16_t* __restrict__ dst, int kt, int nt,
                     float* tile) {
  const int tid = otid();
  {
    const int kl = tid >> 4, n4 = (tid & 15) * 4;
    const int np = nt * 64 + n4;
    int sc = np;
    if (mode == 1) {
      int j = (np >> 7) & 1, tl = np >> 8, cc = np & 127;
      sc = j * DFF + tl * 128 + cc;
    }
    const bool valid = (mode == 1) || (np < N);
#pragma unroll
    for (int half = 0; half < 2; ++half) {
      int k = kl + 32 * half;
      float4 v = make_float4(0.f, 0.f, 0.f, 0.f);
      if (valid) v = *(const float4*)(src + (size_t)(kt * 64 + k) * N + sc);
      float* tp = tile + k * 65 + n4;
      tp[0] = v.x; tp[1] = v.y; tp[2] = v.z; tp[3] = v.w;
    }
  }
  __syncthreads();
  {
    const int nl = tid >> 3, kc = (tid & 7) * 8;
    u32x4 o;
#pragma unroll
    for (int j = 0; j < 4; ++j) o[j] = pack2(tile[(kc + 2 * j) * 65 + nl], tile[(kc + 2 * j + 1) * 65 + nl]);
    *(u32x4*)(dst + (size_t)(nt * 64 + nl) * K + kt * 64 + kc) = o;
  }
  __syncthreads();
}

DI void phase_setup(const Params& p, char* smem, int bid, int nblk) {
  const int tid = otid();
  constexpr int PER_LAYER = 5120;
  constexpr int N_CONV = 2 * PER_LAYER;
  constexpr int N_MOD = 288;
  const int total = N_CONV + N_MOD + 1;
  for (int it = bid; it < total; it += nblk) {
    if (it < N_CONV) {
      const int l = it / PER_LAYER;
      int i = it - l * PER_LAYER;
      bf16_t* wl = p.wts + (size_t)l * LAYER_W;
      float* tile = (float*)smem;
      if (i < 1408) { convert_tile(p.w_ffn1_in + (size_t)l * DM * 2 * DFF, DM, 2 * DFF, 1, wl + OFF_W1, i / 88, i % 88, tile); continue; }
      i -= 1408;
      if (i < 704) { convert_tile(p.w_ffn1_out + (size_t)l * DFF * DM, DFF, DM, 0, wl + OFF_W2, i / 16, i % 16, tile); continue; }
      i -= 704;
      if (i < 1408) { convert_tile(p.w_ffn2_in + (size_t)l * DM * 2 * DFF, DM, 2 * DFF, 1, wl + OFF_W3, i / 88, i % 88, tile); continue; }
      i -= 1408;
      if (i < 704) { convert_tile(p.w_ffn2_out + (size_t)l * DFF * DM, DFF, DM, 0, wl + OFF_W4, i / 16, i % 16, tile); continue; }
      i -= 704;
      if (i < 576) { convert_tile(p.w_in + (size_t)l * DM * 2208, DM, 2208, 0, wl + OFF_WIN, i / 36, i % 36, tile); continue; }
      i -= 576;
      if (i < 256) { convert_tile(p.w_out + (size_t)l * DM * DM, DM, DM, 0, wl + OFF_WOUT, i / 16, i % 16, tile); continue; }
      i -= 256;
      if (i < 32) { convert_tile(p.w_uq + (size_t)l * 256 * 384, 256, 384, 0, wl + OFF_WUQ, i / 8, i % 8, tile); continue; }
      i -= 32;
      if (i < 16) { convert_tile(p.w_ukv + (size_t)l * 128 * 512, 128, 512, 0, wl + OFF_WUKV, i / 8, i % 8, tile); continue; }
      i -= 16;
      {
        const float* s = p.w_spatial + (size_t)l * 65536 + (size_t)i * 4096;
        bf16_t* d = wl + OFF_WSP + (size_t)i * 4096;
        for (int e = tid; e < 4096; e += NTHREADS) d[e] = f2bf(s[e]);
      }
    } else if (it < N_CONV + N_MOD) {
      const int m = it - N_CONV;
      const int l = m / 144, cg64 = m % 144;
      float* s = (float*)smem;
      float* red = (float*)(smem + 36864);
      for (int e = tid; e < 9 * 1024; e += NTHREADS) {
        int b = e >> 10, k = e & 1023;
        float v = (b < 8) ? p.c[b * 1024 + k] : p.c_ctx[k];
        s[e] = silu(v);
      }
      __syncthreads();
      const int w = tid >> 6, lane = tid & 63;
      const int col = cg64 * 64 + lane;
      float acc[9];
#pragma unroll
      for (int b = 0; b < 9; ++b) acc[b] = 0.f;
      const float* wp = p.w_ada + (size_t)l * 1024 * 9216 + col;
      for (int k = w * 128; k < w * 128 + 128; ++k) {
        float wv = wp[(size_t)k * 9216];
#pragma unroll
        for (int b = 0; b < 9; ++b) acc[b] += s[b * 1024 + k] * wv;
      }
#pragma unroll
      for (int b = 0; b < 9; ++b) red[(w * 9 + b) * 64 + lane] = acc[b];
      __syncthreads();
      for (int e = tid; e < 9 * 64; e += NTHREADS) {
        int b = e >> 6, ln = e & 63;
        float t = 0.f;
#pragma unroll
        for (int ww = 0; ww < 8; ++ww) t += red[(ww * 9 + b) * 64 + ln];
        int cc = cg64 * 64 + ln;
        p.mods[((size_t)l * 9 + b) * 9216 + cc] = t + p.b_ada[(size_t)l * 9216 + cc];
      }
      __syncthreads();
    } else {
      for (int e = tid; e < 64 * 8; e += NTHREADS) {
        int pos = e >> 3, j = e & 7;
        float inv = powf(10000.f, -(float)(2 * j) / 16.f);
        float ang = (float)pos * inv;
        p.rope[e] = cosf(ang);
        p.rope[512 + e] = sinf(ang);
      }
      for (int e = tid; e < 64 * 16; e += NTHREADS) {
        int pos = e >> 4, j = e & 15;
        float inv = powf(10000.f, -(float)(2 * j) / 32.f);
        float ang = (float)pos * inv;
        p.rope[1024 + e] = cosf(ang);
        p.rope[2048 + e] = sinf(ang);
      }
    }
  }
}

DI void phase_rowpass(const Params& p, int bid, int nblk, int l_post, int j_post, float wres, int l_pre,
                              int j_pre, bool src_inputs, bool lat_only) {
  const int tid = otid(); const int lane = tid & 63, w = tid >> 6;
  const int gw = bid * 8 + w, nw = nblk * 8;
  const int nrows = lat_only ? NB * 4096 : MROWS;
  const bf16_t* y = p.r2;
  for (int ri = gw; ri < nrows; ri += nw) {
    int R = lat_only ? ((ri >> 12) * NT + 256 + (ri & 4095)) : ri;
    const int b = R / NT, t = R - b * NT;
    const bool isctx = t < 256;
    const int mrow = isctx ? 8 : b;
    const float* src;
    float* dst;
    if (isctx) {
      size_t o = ((size_t)b * 256 + t) * DM;
      src = src_inputs ? p.ctx + o : p.xctx + o;
      dst = p.xctx + o;
    } else {
      size_t o = ((size_t)b * 4096 + (t - 256)) * DM;
      src = src_inputs ? p.x + o : p.out + o;
      dst = p.out + o;
    }
    float xv[16];
#pragma unroll
    for (int c = 0; c < 4; ++c) {
      float4 v = *(const float4*)(src + c * 256 + lane * 4);
      xv[c * 4 + 0] = v.x; xv[c * 4 + 1] = v.y; xv[c * 4 + 2] = v.z; xv[c * 4 + 3] = v.w;
    }
    if (j_post >= 0) {
      float yv[16];
      float ss = 0.f;
#pragma unroll
      for (int c = 0; c < 4; ++c) {
        u32x2 u = *(const u32x2*)(y + (size_t)R * DM + c * 256 + lane * 4);
        yv[c * 4 + 0] = __uint_as_float(u[0] << 16);
        yv[c * 4 + 1] = __uint_as_float(u[0] & 0xffff0000u);
        yv[c * 4 + 2] = __uint_as_float(u[1] << 16);
        yv[c * 4 + 3] = __uint_as_float(u[1] & 0xffff0000u);
#pragma unroll
        for (int q = 0; q < 4; ++q) ss += yv[c * 4 + q] * yv[c * 4 + q];
      }
      ss = wave_sum(ss);
      const float rstd = rsqrtf(ss * (1.f / DM) + EPS) * wres;
      const float* gate = p.mods + ((size_t)l_post * 9 + mrow) * 9216 + (3 * j_post + 2) * DM;
      const float* gp = p.g_post + ((size_t)l_post * 3 + j_post) * DM;
#pragma unroll
      for (int c = 0; c < 4; ++c) {
        float4 g = *(const float4*)(gate + c * 256 + lane * 4);
        float4 gg = *(const float4*)(gp + c * 256 + lane * 4);
        xv[c * 4 + 0] += g.x * yv[c * 4 + 0] * rstd * gg.x;
        xv[c * 4 + 1] += g.y * yv[c * 4 + 1] * rstd * gg.y;
        xv[c * 4 + 2] += g.z * yv[c * 4 + 2] * rstd * gg.z;
        xv[c * 4 + 3] += g.w * yv[c * 4 + 3] * rstd * gg.w;
        *(float4*)(dst + c * 256 + lane * 4) = make_float4(xv[c * 4 + 0], xv[c * 4 + 1], xv[c * 4 + 2], xv[c * 4 + 3]);
      }
    }
    if (j_pre >= 0) {
      float ss = 0.f;
#pragma unroll
      for (int q = 0; q < 16; ++q) ss += xv[q] * xv[q];
      ss = wave_sum(ss);
      const float rstd = rsqrtf(ss * (1.f / DM) + EPS);
      const float* mb = p.mods + ((size_t)l_pre * 9 + mrow) * 9216;
      const float* shift = mb + (3 * j_pre) * DM;
      const float* scale = mb + (3 * j_pre + 1) * DM;
      const float* gp = p.g_pre + ((size_t)l_pre * 3 + j_pre) * DM;
#pragma unroll
      for (int c = 0; c < 4; ++c) {
        float4 sh = *(const float4*)(shift + c * 256 + lane * 4);
        float4 sc = *(const float4*)(scale + c * 256 + lane * 4);
        float4 gg = *(const float4*)(gp + c * 256 + lane * 4);
        float h0 = xv[c * 4 + 0] * rstd * gg.x * (1.f + sc.x) + sh.x;
        float h1 = xv[c * 4 + 1] * rstd * gg.y * (1.f + sc.y) + sh.y;
        float h2 = xv[c * 4 + 2] * rstd * gg.z * (1.f + sc.z) + sh.z;
        float h3 = xv[c * 4 + 3] * rstd * gg.w * (1.f + sc.w) + sh.w;
        u32x2 o;
        o[0] = pack2(h0, h1);
        o[1] = pack2(h2, h3);
        *(u32x2*)(p.h + (size_t)R * DM + c * 256 + lane * 4) = o;
      }
    }
  }
}

enum { EPI_SWIGLU = 0, EPI_Y = 1, EPI_WIN = 2, EPI_UQ = 3, EPI_UKV = 4 };

DI void gemm_mainloop(const bf16_t* __restrict__ A, int lda, const bf16_t* __restrict__ Bt, int ldb, int K, char* smem,
                      f32x16 (&acc)[4][2]) {
  const int tid = otid(), lane = tid & 63, w = tid >> 6, wm = w >> 2, wn = w & 3, r = lane & 31, hh = lane >> 5;
  const int lc = tid & 7, lr = tid >> 3;
  const bf16_t* ap = A + (size_t)lr * lda + lc * 8;
  const bf16_t* bp = Bt + (size_t)lr * ldb + lc * 8;
  const int st_off = lr * 128 + ((lc ^ ((lr >> 1) & 7)) << 4);
  u32x4 ra[4], rb[4];
#pragma unroll
  for (int i = 0; i < 4; ++i)
#pragma unroll
    for (int j = 0; j < 2; ++j)
#pragma unroll
      for (int e = 0; e < 16; ++e) acc[i][j][e] = 0.f;
  const int nk = K >> 6;
#pragma unroll
  for (int i = 0; i < 4; ++i) {
    ra[i] = *(const u32x4*)(ap + (size_t)i * 64 * lda);
    rb[i] = *(const u32x4*)(bp + (size_t)i * 64 * ldb);
  }
#pragma unroll
  for (int i = 0; i < 4; ++i) {
    *(u32x4*)(smem + st_off + i * 8192) = ra[i];
    *(u32x4*)(smem + 32768 + st_off + i * 8192) = rb[i];
  }
  __syncthreads();
  const int sw = (r >> 1) & 7;
#pragma unroll 1
  for (int kt = 0; kt < nk; ++kt) {
    char* cur = smem + (kt & 1) * 65536;
    const bool more = (kt + 1 < nk);
    if (more) {
      ap += 64;
      bp += 64;
#pragma unroll
      for (int i = 0; i < 4; ++i) {
        ra[i] = *(const u32x4*)(ap + (size_t)i * 64 * lda);
        rb[i] = *(const u32x4*)(bp + (size_t)i * 64 * ldb);
      }
    }
    const char* abase = cur + (wm * 128 + r) * 128;
    const char* bbase = cur + 32768 + (wn * 64 + r) * 128;
#pragma unroll
    for (int ks = 0; ks < 4; ++ks) {
      const int off = (((2 * ks + hh) ^ sw) << 4);
      bf16x8 af[4], bfr[2];
#pragma unroll
      for (int i = 0; i < 4; ++i) af[i] = *(const bf16x8*)(abase + i * 4096 + off);
#pragma unroll
      for (int j = 0; j < 2; ++j) bfr[j] = *(const bf16x8*)(bbase + j * 4096 + off);
#pragma unroll
      for (int i = 0; i < 4; ++i)
#pragma unroll
        for (int j = 0; j < 2; ++j) acc[i][j] = MFMA32(af[i], bfr[j], acc[i][j]);
    }
    if (more) {
      char* nxt = smem + ((kt + 1) & 1) * 65536;
#pragma unroll
      for (int i = 0; i < 4; ++i) {
        *(u32x4*)(nxt + st_off + i * 8192) = ra[i];
        *(u32x4*)(nxt + 32768 + st_off + i * 8192) = rb[i];
      }
    }
    __syncthreads();
  }
}

DI int lat_tile(int i) { return (i >> 4) * 17 + 1 + (i & 15); }

DI void gemm_tile(const Params& p, char* smem, int mode, int layer, const bf16_t* A, int lda, const bf16_t* Bt,
                          int K, int rt, int ct) {
  f32x16 acc[4][2];
  const int row0 = rt * 256, col0 = ct * 256;
  gemm_mainloop(A + (size_t)row0 * lda, lda, Bt + (size_t)col0 * K, K, K, smem, acc);
  const int tid = otid(), lane = tid & 63, w = tid >> 6, wm = w >> 2, wn = w & 3, r = lane & 31, hh = lane >> 5;
  const int rb = row0 + wm * 128, cb = col0 + wn * 64;
  const int b = row0 / NT;
  const int tb = rb - b * NT;
  if (mode == EPI_SWIGLU) {
    bf16_t* act = p.r1;
    const int oc = ct * 128 + wn * 32 + r;
#pragma unroll
    for (int i = 0; i < 4; ++i)
#pragma unroll
      for (int e = 0; e < 16; ++e) {
        float g = acc[i][0][e], u = acc[i][1][e];
        act[(size_t)(rb + i * 32 + crow(e, hh)) * DFF + oc] = f2bf(silu(g) * u);
      }
  } else if (mode == EPI_Y) {
    bf16_t* y = p.r2;
#pragma unroll
    for (int i = 0; i < 4; ++i)
#pragma unroll
      for (int j = 0; j < 2; ++j)
#pragma unroll
        for (int e = 0; e < 16; ++e)
          y[(size_t)(rb + i * 32 + crow(e, hh)) * DM + cb + j * 32 + r] = f2bf(acc[i][j][e]);
  } else if (mode == EPI_WIN) {
    const bool isAv = (cb >= 512 && cb < 768);
    const bool isBv = (cb >= 1152 && cb < 1280);
    if (isAv || isBv) {
      bf16_t* vt;
      if (isAv) vt = p.r2 + VAT_OFF + (size_t)((b * 4 + (cb - 512) / 64) * 64) * NT;
      else vt = p.r2 + VBT_OFF + (size_t)((b * 2 + (cb - 1152) / 64) * 64) * NT;
#pragma unroll
      for (int i = 0; i < 4; ++i)
#pragma unroll
        for (int j = 0; j < 2; ++j)
#pragma unroll
          for (int e4 = 0; e4 < 4; ++e4) {
            u32x2 o;
            o[0] = pack2(acc[i][j][e4 * 4 + 0], acc[i][j][e4 * 4 + 1]);
            o[1] = pack2(acc[i][j][e4 * 4 + 2], acc[i][j][e4 * 4 + 3]);
            int t = tb + i * 32 + 8 * e4 + 4 * hh;
            *(u32x2*)(vt + (size_t)(j * 32 + r) * NT + t) = o;
          }
    } else {
      bf16_t* pp = p.r1;
#pragma unroll
      for (int i = 0; i < 4; ++i)
#pragma unroll
        for (int j = 0; j < 2; ++j)
#pragma unroll
          for (int e = 0; e < 16; ++e)
            pp[(size_t)(rb + i * 32 + crow(e, hh)) * NIN + cb + j * 32 + r] = f2bf(acc[i][j][e]);
    }
  } else if (mode == EPI_UQ) {
    const float scale = 0.10206207261596577f * LOG2E;
    const bool isctx = tb < 256;
#pragma unroll
    for (int j = 0; j < 2; ++j) {
      const int n0 = cb + j * 32;
      if (n0 >= 384) continue;
      const int head = n0 / 96, seg = (n0 % 96) / 32;
      bf16_t* qd = p.r2 + QD_OFF + (size_t)(b * 4 + head) * NT * 96 + seg * 32 + r;
#pragma unroll
      for (int i = 0; i < 4; ++i)
#pragma unroll
        for (int e = 0; e < 16; ++e) {
          float v = acc[i][j][e];
          const int t = tb + i * 32 + crow(e, hh);
          if (seg == 2) {
            float pr = __shfl_xor(v, 8);
            if (!isctx) {
              const int pos = t - 256;
              const int pa = (r & 16) ? (pos & 63) : (pos >> 6);
              const float cs = p.rope[pa * 8 + (r & 7)], sn = p.rope[512 + pa * 8 + (r & 7)];
              v = v * cs + ((r & 8) ? pr : -pr) * sn;
            }
          }
          qd[(size_t)t * 96] = f2bf(v * scale);
        }
    }
  } else {
#pragma unroll
    for (int j = 0; j < 2; ++j) {
      const int n0 = cb + j * 32;
      const int head = n0 >> 7, wseg = n0 & 127;
      if (wseg < 64) {
        bf16_t* kd = p.r2 + KD_OFF + (size_t)(b * 4 + head) * NT * 96 + wseg + r;
#pragma unroll
        for (int i = 0; i < 4; ++i)
#pragma unroll
          for (int e = 0; e < 16; ++e) kd[(size_t)(tb + i * 32 + crow(e, hh)) * 96] = f2bf(acc[i][j][e]);
      } else {
        bf16_t* vt = p.r2 + VDT_OFF + (size_t)((b * 4 + head) * 64 + (wseg - 64) + r) * NT;
#pragma unroll
        for (int i = 0; i < 4; ++i)
#pragma unroll
          for (int e4 = 0; e4 < 4; ++e4) {
            u32x2 o;
            o[0] = pack2(acc[i][j][e4 * 4 + 0], acc[i][j][e4 * 4 + 1]);
            o[1] = pack2(acc[i][j][e4 * 4 + 2], acc[i][j][e4 * 4 + 3]);
            *(u32x2*)(vt + tb + i * 32 + 16 * (e4 >> 1) + 8 * hh + 4 * (e4 & 1)) = o;
          }
      }
    }
  }
}


using f32x4 = __attribute__((ext_vector_type(4))) float;
typedef __attribute__((address_space(3))) unsigned lds_u32;
DI int lds_byte8(int r, int c) {
  int st = (r >> 4) * 2 + (c >> 5), rr = r & 15, cc = c & 31, ob = rr * 64 + cc * 2;
  return st * 1024 + (ob ^ (((ob >> 9) & 1) << 5));
}
DI void stage_rc8(int b, int& R, int& C) {
  int st = b / 1024, sb = b % 1024, swz = sb ^ (((sb >> 9) & 1) << 5);
  R = (st >> 1) * 16 + swz / 64;
  C = (st & 1) * 32 + (swz % 64) / 2;
}
#define G8_HT 16384
#define G8_SA(b, h) (smem + ((b) * 2 + (h)) * G8_HT)
#define G8_SB(b, h) (smem + (4 + (b) * 2 + (h)) * G8_HT)
#define G8_STAGE(P, BASE, goff0, goff1, ld, br, kt)                                                              \
  do {                                                                                                            \
    const bf16_t* _g = (BASE) + (size_t)(br) * (ld) + (size_t)(kt) * 64;                                          \
    __builtin_amdgcn_global_load_lds((const unsigned*)(_g + goff0), (lds_u32*)((P) + tid * 16), 16, 0, 0);        \
    __builtin_amdgcn_global_load_lds((const unsigned*)(_g + goff1), (lds_u32*)((P) + tid * 16 + 8192), 16, 0, 0); \
  } while (0)
#define G8_LDA(dst, b, h)                                                                                 \
  _Pragma("unroll") for (int m = 0; m < 4; ++m) _Pragma("unroll") for (int k = 0; k < 2; ++k) dst[m][k] = \
      *(const bf16x8*)(G8_SA(b, h) + lds_byte8(wr * 64 + m * 16 + fr, k * 32 + fq * 8))
#define G8_LDB(dst, b, h)                                                                                 \
  _Pragma("unroll") for (int n = 0; n < 2; ++n) _Pragma("unroll") for (int k = 0; k < 2; ++k) dst[n][k] = \
      *(const bf16x8*)(G8_SB(b, h) + lds_byte8(wc * 32 + n * 16 + fr, k * 32 + fq * 8))
#define G8_MMA(ai, bj, AT, BX)                                                                         \
  do {                                                                                                 \
    __builtin_amdgcn_s_setprio(1);                                                                     \
    _Pragma("unroll") for (int m = 0; m < 4; ++m) _Pragma("unroll") for (int n = 0; n < 2; ++n)        \
        _Pragma("unroll") for (int k = 0; k < 2; ++k) acc[ai][bj][m][n] =                              \
            __builtin_amdgcn_mfma_f32_16x16x32_bf16(AT[m][k], BX[n][k], acc[ai][bj][m][n], 0, 0, 0);   \
    __builtin_amdgcn_s_setprio(0);                                                                     \
  } while (0)
#define G8_WAIT_V(n) asm volatile("s_waitcnt vmcnt(" #n ")" ::: "memory")
#define G8_WAIT_L(n) asm volatile("s_waitcnt lgkmcnt(" #n ")" ::: "memory")
#define G8_BAR __builtin_amdgcn_s_barrier()
#define G8_SCHED __builtin_amdgcn_sched_barrier(0)

DI void gemm8_mainloop(const bf16_t* __restrict__ A, int lda, const bf16_t* __restrict__ Bt, int ldb, int K,
                       __attribute__((address_space(3))) char* smem, f32x4 (&acc)[2][2][4][2]) {
  const int tid = otid();
  const int wid = tid >> 6, lane = tid & 63, wr = wid >> 2, wc = wid & 3, fr = lane & 15, fq = lane >> 4;
  int r0, c0, r1, c1;
  stage_rc8(tid * 16, r0, c0);
  stage_rc8(tid * 16 + 8192, r1, c1);
  const int ga0 = r0 * lda + c0, ga1 = r1 * lda + c1, gb0 = r0 * ldb + c0, gb1 = r1 * ldb + c1;
#pragma unroll
  for (int a = 0; a < 2; ++a)
#pragma unroll
    for (int b = 0; b < 2; ++b)
#pragma unroll
      for (int m = 0; m < 4; ++m)
#pragma unroll
        for (int n = 0; n < 2; ++n) acc[a][b][m][n] = (f32x4){0.f, 0.f, 0.f, 0.f};
  bf16x8 At[4][2], B0[2][2], B1[2][2];
  const int nt = K >> 6;
  G8_WAIT_V(0);
  G8_STAGE(G8_SB(0, 0), Bt, gb0, gb1, ldb, 0, 0);
  G8_STAGE(G8_SA(0, 0), A, ga0, ga1, lda, 0, 0);
  G8_STAGE(G8_SB(0, 1), Bt, gb0, gb1, ldb, 128, 0);
  G8_STAGE(G8_SA(0, 1), A, ga0, ga1, lda, 128, 0);
  if (wr == 1) G8_BAR;
  G8_WAIT_V(4); G8_BAR;
  G8_STAGE(G8_SB(1, 0), Bt, gb0, gb1, ldb, 0, 1);
  G8_STAGE(G8_SA(1, 0), A, ga0, ga1, lda, 0, 1);
  G8_STAGE(G8_SB(1, 1), Bt, gb0, gb1, ldb, 128, 1);
  G8_WAIT_V(6); G8_BAR;
#pragma unroll 1
  for (int t = 0; t < nt - 2; t += 2) {
    G8_LDB(B0, 0, 0); G8_SCHED; G8_LDA(At, 0, 0); G8_STAGE(G8_SA(1, 1), A, ga0, ga1, lda, 128, t + 1);
    G8_WAIT_L(8); G8_BAR; G8_WAIT_L(0); G8_MMA(0, 0, At, B0); G8_BAR; G8_SCHED;
    G8_LDB(B1, 0, 1); G8_STAGE(G8_SB(0, 0), Bt, gb0, gb1, ldb, 0, t + 2);
    G8_BAR; G8_WAIT_L(0); G8_MMA(0, 1, At, B1); G8_BAR;
    G8_LDA(At, 0, 1); G8_STAGE(G8_SA(0, 0), A, ga0, ga1, lda, 0, t + 2);
    G8_BAR; G8_WAIT_L(0); G8_MMA(1, 0, At, B0); G8_BAR; G8_SCHED;
    G8_STAGE(G8_SB(0, 1), Bt, gb0, gb1, ldb, 128, t + 2);
    G8_WAIT_V(6); G8_BAR; G8_MMA(1, 1, At, B1); G8_BAR;
    G8_LDB(B0, 1, 0); G8_SCHED; G8_LDA(At, 1, 0); G8_STAGE(G8_SA(0, 1), A, ga0, ga1, lda, 128, t + 2);
    G8_WAIT_L(8); G8_BAR; G8_WAIT_L(0); G8_MMA(0, 0, At, B0); G8_BAR; G8_SCHED;
    G8_LDB(B1, 1, 1); G8_STAGE(G8_SB(1, 0), Bt, gb0, gb1, ldb, 0, t + 3);
    G8_BAR; G8_WAIT_L(0); G8_MMA(0, 1, At, B1); G8_BAR;
    G8_LDA(At, 1, 1); G8_STAGE(G8_SA(1, 0), A, ga0, ga1, lda, 0, t + 3);
    G8_BAR; G8_WAIT_L(0); G8_MMA(1, 0, At, B0); G8_BAR; G8_SCHED;
    G8_STAGE(G8_SB(1, 1), Bt, gb0, gb1, ldb, 128, t + 3);
    G8_WAIT_V(6); G8_BAR; G8_MMA(1, 1, At, B1); G8_BAR;
  }
  {
    G8_LDB(B0, 0, 0); G8_LDA(At, 0, 0); G8_STAGE(G8_SA(1, 1), A, ga0, ga1, lda, 128, nt - 1);
    G8_BAR; G8_WAIT_L(0); G8_MMA(0, 0, At, B0); G8_BAR;
    G8_LDB(B1, 0, 1); G8_BAR; G8_WAIT_L(0); G8_MMA(0, 1, At, B1); G8_BAR;
    G8_LDA(At, 0, 1); G8_WAIT_V(4); G8_BAR; G8_WAIT_L(0); G8_MMA(1, 0, At, B0); G8_MMA(1, 1, At, B1); G8_BAR;
  }
  {
    G8_LDB(B0, 1, 0); G8_LDA(At, 1, 0); G8_WAIT_V(2); G8_BAR; G8_WAIT_L(0); G8_MMA(0, 0, At, B0); G8_BAR;
    G8_LDB(B1, 1, 1); G8_WAIT_V(0); G8_BAR; G8_WAIT_L(0); G8_MMA(0, 1, At, B1); G8_BAR;
    G8_LDA(At, 1, 1); G8_BAR; G8_WAIT_L(0); G8_MMA(1, 0, At, B0); G8_MMA(1, 1, At, B1); G8_BAR;
  }
  if (wr == 0) G8_BAR;
}

DI void gemm8_tile(const Params& p, char* smem_g, int mode, const bf16_t* A, int lda, const bf16_t* Bt, int K, int rt,
                   int ct) {
  f32x4 acc[2][2][4][2];
  const int row0 = rt * 256, col0 = ct * 256;
  gemm8_mainloop(A + (size_t)row0 * lda, lda, Bt + (size_t)col0 * K, K, K,
                 (__attribute__((address_space(3))) char*)smem_g, acc);
  const int tid = otid();
  const int wid = tid >> 6, lane = tid & 63, wr = wid >> 2, wc = wid & 3, fr = lane & 15, fq = lane >> 4;
  const int b = row0 / NT;
  const int rw = row0 + wr * 64 + fq * 4;
  if (mode == EPI_SWIGLU) {
    bf16_t* act = p.r1;
#pragma unroll
    for (int ai = 0; ai < 2; ++ai)
#pragma unroll
      for (int m = 0; m < 4; ++m)
#pragma unroll
        for (int n = 0; n < 2; ++n)
#pragma unroll
          for (int j = 0; j < 4; ++j) {
            float g = acc[ai][0][m][n][j], u = acc[ai][1][m][n][j];
            act[(size_t)(rw + ai * 128 + m * 16 + j) * DFF + ct * 128 + wc * 32 + n * 16 + fr] = f2bf(silu(g) * u);
          }
  } else if (mode == EPI_Y) {
    bf16_t* y = p.r2;
#pragma unroll
    for (int ai = 0; ai < 2; ++ai)
#pragma unroll
      for (int bj = 0; bj < 2; ++bj)
#pragma unroll
        for (int m = 0; m < 4; ++m)
#pragma unroll
          for (int n = 0; n < 2; ++n)
#pragma unroll
            for (int j = 0; j < 4; ++j)
              y[(size_t)(rw + ai * 128 + m * 16 + j) * DM + col0 + bj * 128 + wc * 32 + n * 16 + fr] =
                  f2bf(acc[ai][bj][m][n][j]);
  } else {
    const int tw16 = row0 - b * NT + wr * 64 + (((fq & 1) << 1) | (fq >> 1)) * 4;
#pragma unroll
    for (int bj = 0; bj < 2; ++bj) {
      const int cb = col0 + bj * 128 + wc * 32;
      const bool isAv = (cb >= 512 && cb < 768);
      const bool isBv = (cb >= 1152 && cb < 1280);
      if (isAv || isBv) {
        bf16_t* vt;
        if (isAv) vt = p.r2 + VAT_OFF + (size_t)((b * 4 + (cb - 512) / 64) * 64 + (cb & 32)) * NT;
        else vt = p.r2 + VBT_OFF + (size_t)((b * 2 + (cb - 1152) / 64) * 64 + (cb & 32)) * NT;
#pragma unroll
        for (int ai = 0; ai < 2; ++ai)
#pragma unroll
          for (int m = 0; m < 4; ++m)
#pragma unroll
            for (int n = 0; n < 2; ++n) {
              u32x2 o;
              o[0] = pack2(acc[ai][bj][m][n][0], acc[ai][bj][m][n][1]);
              o[1] = pack2(acc[ai][bj][m][n][2], acc[ai][bj][m][n][3]);
              *(u32x2*)(vt + (size_t)(n * 16 + fr) * NT + tw16 + ai * 128 + m * 16) = o;
            }
      } else {
        bf16_t* pp = p.r1;
#pragma unroll
        for (int ai = 0; ai < 2; ++ai)
#pragma unroll
          for (int m = 0; m < 4; ++m)
#pragma unroll
            for (int n = 0; n < 2; ++n)
#pragma unroll
              for (int j = 0; j < 4; ++j)
                pp[(size_t)(rw + ai * 128 + m * 16 + j) * NIN + cb + n * 16 + fr] = f2bf(acc[ai][bj][m][n][j]);
      }
    }
  }
}

DI int xcd_vb(int bid, int nblk) {
  if (nblk & 7) return bid;
  return (bid & 7) * (nblk >> 3) + (bid >> 3);
}

DI void phase_gemm(const Params& p, char* smem, int bid, int nblk, int mode, int layer, const bf16_t* A, int lda,
                           const bf16_t* Bt, int K, int nct, bool lat_only) {
  const int nrt = lat_only ? 128 : 136;
  const int total = nrt * nct;
  for (int t = xcd_vb(bid, nblk); t < total; t += nblk) {
    int rti = t / nct, ct = t - rti * nct;
    int rt = lat_only ? lat_tile(rti) : rti;
    gemm8_tile(p, smem, mode, A, lda, Bt, K, rt, ct);
  }
}

DI void phase_rowprep(const Params& p, int bid, int nblk, int l) {
  const int tid = otid(); const int lane = tid & 63, w = tid >> 6;
  const int gw = bid * 8 + w, nw = nblk * 8;
  const float* __restrict__ ropeAc = p.rope;
  const float* __restrict__ ropeAs = p.rope + 512;
  const float* __restrict__ ropeBc = p.rope + 1024;
  const float* __restrict__ ropeBs = p.rope + 2048;
  const float gqn = p.g_qnorm[l * 64 + lane], gkn = p.g_knorm[l * 64 + lane];
  float lng[4], lnb[4], gqa[4], gkva[2];
#pragma unroll
  for (int i = 0; i < 4; ++i) {
    lng[i] = p.ln_g[l * 256 + i * 64 + lane];
    lnb[i] = p.ln_b[l * 256 + i * 64 + lane];
    gqa[i] = p.g_q_a[l * 256 + i * 64 + lane];
  }
  gkva[0] = p.g_kv_a[l * 128 + lane];
  gkva[1] = p.g_kv_a[l * 128 + 64 + lane];
  const float scaleA = 0.17677669529663687f * LOG2E;
  const float scaleB = 0.125f * LOG2E;
  bf16_t* __restrict__ qkv = p.r2;
  for (int R = gw; R < MROWS; R += nw) {
    const int b = R / NT, t = R - b * NT;
    const bool isctx = t < 256;
    const int pos = t - 256;
    const int prow = pos >> 6, pcol = pos & 63;
    bf16_t* P = p.r1 + (size_t)R * NIN;
    float va[8], vb[6], vc[8], vd[6], vkr;
#pragma unroll
    for (int i = 0; i < 8; ++i) va[i] = bf2f(P[i * 64 + lane]);
#pragma unroll
    for (int i = 0; i < 6; ++i) vb[i] = bf2f(P[768 + i * 64 + lane]);
#pragma unroll
    for (int i = 0; i < 8; ++i) vc[i] = bf2f(P[1280 + i * 64 + lane]);
#pragma unroll
    for (int i = 0; i < 6; ++i) vd[i] = bf2f(P[1792 + i * 64 + lane]);
    vkr = bf2f(P[2176 + (lane & 31)]);
    {
      const int d = lane & 31;
      const int pa = (d & 16) ? pcol : prow;
      float cs = 1.f, sn = 0.f;
      if (!isctx) { cs = ropeAc[pa * 8 + (d & 7)]; sn = ropeAs[pa * 8 + (d & 7)]; }
      const float sg = (d & 8) ? sn : -sn;
#pragma unroll
      for (int i = 0; i < 4; ++i) {
        const int hm = (i * 64 + lane) >> 5;
        float vq = va[i], vk = va[4 + i];
        float pq = __shfl_xor(vq, 8), pk = __shfl_xor(vk, 8);
        vq = vq * cs + sg * pq;
        vk = vk * cs + sg * pk;
        size_t o = ((size_t)(b * 8 + hm) * NT + t) * 32 + d;
        qkv[QA_OFF + o] = f2bf(vq * scaleA);
        qkv[KA_OFF + o] = f2bf(vk);
      }
    }
    {
      const int d = lane;
      const int pa = (d & 32) ? pcol : prow;
      float cs = 1.f, sn = 0.f;
      if (!isctx) { cs = ropeBc[pa * 16 + (d & 15)]; sn = ropeBs[pa * 16 + (d & 15)]; }
      const float sg = (d & 16) ? sn : -sn;
      float ss[6];
#pragma unroll
      for (int i = 0; i < 6; ++i) ss[i] = vb[i] * vb[i];
#pragma unroll
      for (int o = 32; o >= 1; o >>= 1)
#pragma unroll
        for (int i = 0; i < 6; ++i) ss[i] += __shfl_xor(ss[i], o);
#pragma unroll
      for (int i = 0; i < 6; ++i) {
        float v = vb[i] * rsqrtf(ss[i] * (1.f / 64.f) + EPS) * (i < 4 ? gqn : gkn);
        float pr = __shfl_xor(v, 16);
        v = v * cs + sg * pr;
        if (i < 4) qkv[QB_OFF + ((size_t)(b * 4 + i) * NT + t) * 64 + d] = f2bf(v * scaleB);
        else qkv[KB_OFF + ((size_t)(b * 2 + (i - 4)) * NT + t) * 64 + d] = f2bf(v);
      }
    }
    {
      float s1 = 0.f, sq = 0.f, skv = 0.f;
#pragma unroll
      for (int i = 0; i < 4; ++i) {
        vc[i] = gelu_tanh(vc[i]);
        vc[4 + i] = gelu_tanh(vc[4 + i]);
        s1 += vc[4 + i];
        sq += vd[i] * vd[i];
      }
      skv = vd[4] * vd[4] + vd[5] * vd[5];
#pragma unroll
      for (int o = 32; o >= 1; o >>= 1) {
        s1 += __shfl_xor(s1, o);
        sq += __shfl_xor(sq, o);
        skv += __shfl_xor(skv, o);
      }
      const float mu = s1 * (1.f / 256.f);
      float s2 = 0.f;
#pragma unroll
      for (int i = 0; i < 4; ++i) { vc[4 + i] -= mu; s2 += vc[4 + i] * vc[4 + i]; }
      s2 = wave_sum(s2);
      const float rln = rsqrtf(s2 * (1.f / 256.f) + EPS);
      const float rq = rsqrtf(sq * (1.f / 256.f) + EPS);
      const float rkv = rsqrtf(skv * (1.f / 128.f) + EPS);
#pragma unroll
      for (int i = 0; i < 4; ++i) {
        P[1280 + i * 64 + lane] = f2bf(vc[i]);
        P[1536 + i * 64 + lane] = f2bf(vc[4 + i] * rln * lng[i] + lnb[i]);
        P[1792 + i * 64 + lane] = f2bf(vd[i] * rq * gqa[i]);
      }
      P[2048 + lane] = f2bf(vd[4] * rkv * gkva[0]);
      P[2048 + 64 + lane] = f2bf(vd[5] * rkv * gkva[1]);
    }
    {
      const int d = lane & 31;
      float kr = vkr;
      float pr = __shfl_xor(kr, 8);
      if (!isctx) {
        const int pa = (d & 16) ? pcol : prow;
        kr = kr * ropeAc[pa * 8 + (d & 7)] + ((d & 8) ? pr : -pr) * ropeAs[pa * 8 + (d & 7)];
      }
      if (lane < 32) {
        const bf16_t kb = f2bf(kr);
#pragma unroll
        for (int hd = 0; hd < 4; ++hd) qkv[KD_OFF + ((size_t)(b * 4 + hd) * NT + t) * 96 + 64 + d] = kb;
      }
    }
  }
}

DI void gmlp_item(const Params& p, char* smem, int l, int ch, int g) {
  const int tid = otid(), lane = tid & 63, w = tid >> 6, r = lane & 31, hh = lane >> 5;
  const int R0 = ch * 128;
  bf16_t* vT = (bf16_t*)smem;
#pragma unroll
  for (int u = 0; u < 2; ++u) {
    const int cid = tid + u * NTHREADS;
    const int q = cid >> 3, cc = cid & 7;
    u32x4 v = *(const u32x4*)(p.r1 + (size_t)(R0 + q) * NIN + 1536 + g * 64 + cc * 8);
#pragma unroll
    for (int j = 0; j < 4; ++j) {
      vT[(cc * 8 + 2 * j) * 136 + q] = (bf16_t)(v[j] & 0xffffu);
      vT[(cc * 8 + 2 * j + 1) * 136 + q] = (bf16_t)(v[j] >> 16);
    }
  }
  __syncthreads();
  const int wp = w >> 1, wc = w & 1;
  const bf16_t* wsp = p.wts + (size_t)l * LAYER_W + OFF_WSP + (size_t)g * 16384;
  f32x16 acc;
#pragma unroll
  for (int e = 0; e < 16; ++e) acc[e] = 0.f;
#pragma unroll
  for (int ks = 0; ks < 8; ++ks) {
    bf16x8 a = *(const bf16x8*)(wsp + (wp * 32 + r) * 128 + ks * 16 + hh * 8);
    bf16x8 bb = *(const bf16x8*)(vT + (wc * 32 + r) * 136 + ks * 16 + hh * 8);
    acc = MFMA32(a, bb, acc);
  }
  const int c = g * 64 + wc * 32 + r;
#pragma unroll
  for (int e = 0; e < 16; ++e) {
    const int pp = wp * 32 + crow(e, hh);
    const float u = bf2f(p.r1[(size_t)(R0 + pp) * NIN + 1280 + c]);
    const float mixed = acc[e] + p.b_spatial[(size_t)l * 512 + g * 128 + pp];
    p.h[(size_t)(R0 + pp) * DM + 512 + c] = f2bf(u * mixed);
  }
  __syncthreads();
}

DI void phase_dexp_gmlp(const Params& p, char* smem, int bid, int nblk, int l) {
  const bool lat_only = (l == 1);
  const bf16_t* wl = p.wts + (size_t)l * LAYER_W;
  const int nch = lat_only ? 256 : 272;
  const int total = 272 + 272 + nch * 4;
  for (int t = xcd_vb(bid, nblk); t < total; t += nblk) {
    if (t < 272) {
      gemm_tile(p, smem, EPI_UQ, l, p.r1 + 1792, NIN, wl + OFF_WUQ, 256, t >> 1, t & 1);
    } else if (t < 544) {
      int u = t - 272;
      gemm_tile(p, smem, EPI_UKV, l, p.r1 + 2048, NIN, wl + OFF_WUKV, 128, u >> 1, u & 1);
    } else {
      int u = t - 544;
      int ci = u >> 2, g = u & 3;
      int ch = lat_only ? ((ci >> 5) * 34 + 2 + (ci & 31)) : ci;
      gmlp_item(p, smem, l, ch, g);
    }
  }
}

template <int CPR>
DI int kswz(int c, int row) {
  if (CPR == 4) return c ^ ((row >> 2) & 3);
  if (CPR == 8) return c ^ ((row >> 1) & 7);
  return (c & 12) | ((c & 3) ^ ((row >> 2) & 3));
}

template <int DQK, int NMAP>
DI void attn_item(const bf16_t* __restrict__ Qb, const bf16_t* __restrict__ Kb, const bf16_t* __restrict__ Vt,
                  int q0, int nkeys, bf16_t* __restrict__ outp, char* smem_g, float lam, float post_scale,
                  const float* __restrict__ g_subln) {
  typedef __attribute__((address_space(3))) char lchar;
  lchar* smem = (lchar*)smem_g;
  constexpr int CPR = DQK / 8;
  constexpr int KMAPB = 64 * CPR * 16;
  constexpr int KBYTES = NMAP * KMAPB;
  constexpr int STAGE = KBYTES + 8192;
  constexpr int NS = 4;
  constexpr int NKS = KBYTES / 16;
  constexpr int GK = (NKS + NTHREADS - 1) / NTHREADS;
  constexpr int KK = DQK / 16;
  constexpr float THR = 6.0f;
  const int tid = otid();
  const int lane = tid & 63, w = tid >> 6, r = lane & 31, hh = lane >> 5;

  asm volatile("s_waitcnt vmcnt(0)" ::: "memory");
  __builtin_amdgcn_s_barrier();
  asm volatile("" ::: "memory");

  bf16x8 qf[NMAP][KK];
  {
    const int qrow = q0 + w * 32 + r;
#pragma unroll
    for (int m = 0; m < NMAP; ++m)
#pragma unroll
      for (int kk = 0; kk < KK; ++kk)
        qf[m][kk] = *(const bf16x8*)(Qb + (size_t)m * NT * DQK + (size_t)qrow * DQK + kk * 16 + hh * 8);
  }
  const bf16_t* ksrc[GK];
  int kslot[GK];
#pragma unroll
  for (int u = 0; u < GK; ++u) {
    int sl = tid + u * NTHREADS;
    if (sl >= NKS) sl = tid;
    const int m = sl / (64 * CPR), rem = sl % (64 * CPR), row = rem / CPR, cp = rem % CPR;
    const int c = kswz<CPR>(cp, row);
    ksrc[u] = Kb + (size_t)m * NT * DQK + (size_t)row * DQK + c * 8;
    kslot[u] = sl * 16;
  }
  const int vrow = tid >> 3, vcp = tid & 7;
  const bf16_t* vsrc = Vt + (size_t)vrow * NT + ((vcp ^ ((vrow >> 1) & 7)) * 8);
  const int vslot = KBYTES + tid * 16;
  const int nt = nkeys >> 6;

#define ATT_ISSUE(tile)                                                                                           \
  do {                                                                                                            \
    const int _tl = (tile) < nt ? (tile) : nt - 1;                                                                \
    lchar* _st = smem + ((tile) & (NS - 1)) * STAGE;                                                              \
    _Pragma("unroll") for (int u = 0; u < GK; ++u) __builtin_amdgcn_global_load_lds(                              \
        (const unsigned*)(ksrc[u] + (size_t)_tl * 64 * DQK), (lds_u32*)(_st + kslot[u]), 16, 0, 0);                \
    __builtin_amdgcn_global_load_lds((const unsigned*)(vsrc + _tl * 64), (lds_u32*)(_st + vslot), 16, 0, 0);      \
  } while (0)

  f32x16 O[NMAP][2];
  float mrun[NMAP], lrun[NMAP];
#pragma unroll
  for (int m = 0; m < NMAP; ++m) {
    mrun[m] = 0.f;
    lrun[m] = 0.f;
#pragma unroll
    for (int d = 0; d < 2; ++d)
#pragma unroll
      for (int e = 0; e < 16; ++e) O[m][d][e] = 0.f;
  }
  ATT_ISSUE(0);
  ATT_ISSUE(1);
  ATT_ISSUE(2);
  const int kq = (r >> 2) & 3, k8 = (r >> 1) & 7;
#pragma unroll 1
  for (int it = 0; it < nt; ++it) {
    if (GK == 1) asm volatile("s_waitcnt vmcnt(4)" ::: "memory");
    else asm volatile("s_waitcnt vmcnt(6)" ::: "memory");
    __builtin_amdgcn_s_barrier();
    asm volatile("" ::: "memory");
    ATT_ISSUE(it + 3);
    const lchar* cur = smem + (it & (NS - 1)) * STAGE;
    bf16x8 pb[NMAP][2][2];
#pragma unroll
    for (int m = 0; m < NMAP; ++m) {
      f32x16 S[2];
      const float ninit = -mrun[m];
#pragma unroll
      for (int t2 = 0; t2 < 2; ++t2) {
#pragma unroll
        for (int e = 0; e < 16; ++e) S[t2][e] = ninit;
#pragma unroll
        for (int kk = 0; kk < KK; ++kk) {
          const int c = kk * 2 + hh;
          const int cp = (CPR == 8) ? (c ^ k8) : ((c & 12) | ((c & 3) ^ kq));
          bf16x8 a = *(const bf16x8*)(cur + m * KMAPB + (t2 * 32 + r) * (CPR * 16) + cp * 16);
          S[t2] = MFMA32(a, qf[m][kk], S[t2]);
        }
      }
      float mx = fmaxf(S[0][0], S[1][0]);
#pragma unroll
      for (int e = 1; e < 16; ++e) mx = max3f(mx, S[0][e], S[1][e]);
      mx = fmaxf(mx, __shfl_xor(mx, 32));
      const bool need = (it == 0) || (mx > THR);
      if (__builtin_amdgcn_ballot_w64(need) != 0ull) {
        const float sh = need ? mx : 0.f;
        const float alpha = (it == 0) ? 1.f : __builtin_amdgcn_exp2f(-sh);
        mrun[m] += sh;
        lrun[m] *= alpha;
#pragma unroll
        for (int d = 0; d < 2; ++d)
#pragma unroll
          for (int e = 0; e < 16; ++e) O[m][d][e] *= alpha;
#pragma unroll
        for (int t2 = 0; t2 < 2; ++t2)
#pragma unroll
          for (int e = 0; e < 16; ++e) S[t2][e] -= sh;
      }
      float sum = 0.f;
#pragma unroll
      for (int t2 = 0; t2 < 2; ++t2)
#pragma unroll
        for (int e = 0; e < 16; ++e) {
          float pv = __builtin_amdgcn_exp2f(S[t2][e]);
          S[t2][e] = pv;
          sum += pv;
        }
      lrun[m] += sum;
#pragma unroll
      for (int t2 = 0; t2 < 2; ++t2)
#pragma unroll
        for (int s2 = 0; s2 < 2; ++s2) {
          u32x4 pk;
#pragma unroll
          for (int j = 0; j < 4; ++j) pk[j] = pack2(S[t2][8 * s2 + 2 * j], S[t2][8 * s2 + 2 * j + 1]);
          pb[m][t2][s2] = __builtin_bit_cast(bf16x8, pk);
        }
    }
    const lchar* vs = cur + KBYTES;
#pragma unroll
    for (int d = 0; d < 2; ++d)
#pragma unroll
      for (int t2 = 0; t2 < 2; ++t2)
#pragma unroll
        for (int s2 = 0; s2 < 2; ++s2) {
          const int c = t2 * 4 + s2 * 2 + hh;
          bf16x8 vf = *(const bf16x8*)(vs + (d * 32 + r) * 128 + ((c ^ k8) * 16));
#pragma unroll
          for (int m = 0; m < NMAP; ++m) O[m][d] = MFMA32(vf, pb[m][t2][s2], O[m][d]);
        }
  }
#undef ATT_ISSUE
  asm volatile("s_waitcnt vmcnt(0)" ::: "memory");
#pragma unroll
  for (int m = 0; m < NMAP; ++m) lrun[m] += __shfl_xor(lrun[m], 32);
  bf16_t* orow = outp + (size_t)(w * 32 + r) * DM;
  if (NMAP == 1) {
    const float inv = 1.f / lrun[0];
#pragma unroll
    for (int d = 0; d < 2; ++d)
#pragma unroll
      for (int e4 = 0; e4 < 4; ++e4) {
        u32x2 o;
        o[0] = pack2(O[0][d][e4 * 4 + 0] * inv, O[0][d][e4 * 4 + 1] * inv);
        o[1] = pack2(O[0][d][e4 * 4 + 2] * inv, O[0][d][e4 * 4 + 3] * inv);
        *(u32x2*)(orow + d * 32 + 8 * e4 + 4 * hh) = o;
      }
  } else {
    const float i1 = 1.f / lrun[0], i2 = lam / lrun[NMAP - 1];
    float ss = 0.f;
#pragma unroll
    for (int d = 0; d < 2; ++d)
#pragma unroll
      for (int e = 0; e < 16; ++e) {
        float o = O[0][d][e] * i1 - O[NMAP - 1][d][e] * i2;
        O[0][d][e] = o;
        ss += o * o;
      }
    ss += __shfl_xor(ss, 32);
    const float rstd = rsqrtf(ss * (1.f / 64.f) + EPS) * post_scale;
#pragma unroll
    for (int d = 0; d < 2; ++d)
#pragma unroll
      for (int e4 = 0; e4 < 4; ++e4) {
        const int dv = d * 32 + 8 * e4 + 4 * hh;
        u32x2 o;
        o[0] = pack2(O[0][d][e4 * 4 + 0] * rstd * g_subln[dv + 0], O[0][d][e4 * 4 + 1] * rstd * g_subln[dv + 1]);
        o[1] = pack2(O[0][d][e4 * 4 + 2] * rstd * g_subln[dv + 2], O[0][d][e4 * 4 + 3] * rstd * g_subln[dv + 3]);
        *(u32x2*)(orow + dv) = o;
      }
  }
}

DI void phase_attn(const Params& p, char* smem, int bid, int nblk, int l) {
  const bool lat_only = (l == 1);
  const int nq = lat_only ? 16 : 17;
  const int per = NB * 4 * nq;
  const int total = 3 * per;
  const float lam_init = (l == 0) ? 0.2f : 0.35550906759096927f;
  float lam;
  {
    const float* lv = p.lam_vecs + l * 128;
    float s1 = 0.f, s2 = 0.f;
    for (int i = 0; i < 32; ++i) { s1 += lv[i] * lv[32 + i]; s2 += lv[64 + i] * lv[96 + i]; }
    lam = expf(s1) - expf(s2) + lam_init;
  }
  for (int t = xcd_vb(bid, nblk); t < total; t += nblk) {
    const int mixer = t / per;
    int u = t - mixer * per;
    const int bh = u / nq;
    int qb = u - bh * nq;
    if (lat_only) qb += 1;
    const int b = bh >> 2, hd = bh & 3;
    const int q0 = qb * 256;
    const int nkeys = (qb == 0) ? 256 : NT;
    bf16_t* mixrow = p.h + ((size_t)b * NT + q0) * DM;
    if (mixer == 0) {
      attn_item<32, 2>(p.r2 + QA_OFF + (size_t)(b * 4 + hd) * 2 * NT * 32, p.r2 + KA_OFF + (size_t)(b * 4 + hd) * 2 * NT * 32,
                       p.r2 + VAT_OFF + (size_t)(b * 4 + hd) * 64 * NT, q0, nkeys, mixrow + hd * 64, smem, lam,
                       1.f - lam_init, p.g_subln + l * 64);
    } else if (mixer == 1) {
      attn_item<96, 1>(p.r2 + QD_OFF + (size_t)(b * 4 + hd) * NT * 96, p.r2 + KD_OFF + (size_t)(b * 4 + hd) * NT * 96,
                       p.r2 + VDT_OFF + (size_t)(b * 4 + hd) * 64 * NT, q0, nkeys, mixrow + 768 + hd * 64, smem, 0.f, 0.f,
                       nullptr);
    } else {
      attn_item<64, 1>(p.r2 + QB_OFF + (size_t)(b * 4 + hd) * NT * 64, p.r2 + KB_OFF + (size_t)(b * 2 + (hd >> 1)) * NT * 64,
                       p.r2 + VBT_OFF + (size_t)(b * 2 + (hd >> 1)) * 64 * NT, q0, nkeys, mixrow + 256 + hd * 64, smem, 0.f,
                       0.f, nullptr);
    }
  }
}


#define XB_TMO      128
#define XB_XCNT(j)  (256  + 64 * (j))
#define XB_XSUB(j)  (1280 + 64 * (j))
#define XB_XGEN(j)  (2304 + 64 * (j))
#define XB_TOP      3328
#define XB_TOPGEN   3392
#define XCD_BAR_WORDS 3456
#define XB_SPIN_CAP (1u << 18)
#define LAS __attribute__((address_space(3)))
DI unsigned xb_ld(unsigned* p) { return __hip_atomic_load(p, __ATOMIC_RELAXED, __HIP_MEMORY_SCOPE_AGENT); }
DI unsigned xb_add(unsigned* p, unsigned v) { return __hip_atomic_fetch_add(p, v, __ATOMIC_RELAXED, __HIP_MEMORY_SCOPE_AGENT); }
DI unsigned xb_xcc_id() { return (unsigned)__builtin_amdgcn_s_getreg((3 << 11) | 20) & 0xFu; }
#define XB_SPIN(cond, bar) do { unsigned _sp = 0; while (cond) { __builtin_amdgcn_s_sleep(1); \
    if ((++_sp & 255u) == 0u) { if (xb_ld(&(bar)[XB_TMO])) break; if (_sp > XB_SPIN_CAP) { atomicAdd(&(bar)[XB_TMO], 1u); break; } } } } while (0)
struct XcdBarrier { unsigned* bar; unsigned x; volatile LAS unsigned* st; };
DI XcdBarrier xcd_barrier_post(unsigned* bar, volatile LAS unsigned* st) {
  XcdBarrier b; b.bar = bar; b.x = xb_xcc_id(); b.st = st;
  if (threadIdx.x == 0) (void)xb_add(&bar[XB_XCNT(b.x)], 1u);
  return b;
}
DI void xcd_barrier_complete(unsigned* bar, unsigned x, unsigned& nloc, unsigned& nx) {
  const unsigned G = gridDim.x * gridDim.y * gridDim.z;
  unsigned sum, cnt, mine, sp = 0u;
  for (;;) {
    sum = 0u; cnt = 0u; mine = 0u;
#pragma unroll
    for (unsigned j = 0; j < 16; ++j) { const unsigned c = xb_ld(&bar[XB_XCNT(j)]); sum += c; cnt += (c > 0u) ? 1u : 0u; mine = (j == x) ? c : mine; }
    if (sum == G) break;
    __builtin_amdgcn_s_sleep(1);
    if ((++sp & 255u) == 0u) { if (xb_ld(&bar[XB_TMO])) break; if (sp > XB_SPIN_CAP) { atomicAdd(&bar[XB_TMO], 1u); break; } }
  }
  nloc = mine > 0u ? mine : 1u; nx = cnt > 0u ? cnt : 1u;
}
DI void xcd_barrier(const XcdBarrier& b) {
  asm volatile("s_waitcnt vmcnt(0)" ::: "memory");
  __syncthreads();
  if (threadIdx.x == 0) {
    unsigned* bar = b.bar;
    __builtin_amdgcn_s_waitcnt(0);
    unsigned nloc = b.st[0], nx = b.st[1];
    if (nloc == 0u) { xcd_barrier_complete(bar, b.x, nloc, nx); b.st[0] = nloc; b.st[1] = nx; }
    const unsigned old = xb_add(&bar[XB_XSUB(b.x)], 1u);
    const unsigned gen = old / nloc;
    if (old + 1u == (gen + 1u) * nloc) {
      __builtin_amdgcn_fence(__ATOMIC_RELEASE, "agent");
      asm volatile("s_waitcnt vmcnt(0)" ::: "memory");
      const unsigned og = xb_add(&bar[XB_TOP], 1u);
      const unsigned tg = og / nx;
      if (og + 1u == (tg + 1u) * nx) xb_add(&bar[XB_TOPGEN], 1u);
      else XB_SPIN(xb_ld(&bar[XB_TOPGEN]) == tg, bar);
      __builtin_amdgcn_fence(__ATOMIC_ACQUIRE, "agent");
      xb_add(&bar[XB_XGEN(b.x)], 1u);
      asm volatile("s_waitcnt vmcnt(0)" ::: "memory");
    } else {
      XB_SPIN(xb_ld(&bar[XB_XGEN(b.x)]) == gen, bar);
      __builtin_amdgcn_fence(__ATOMIC_ACQUIRE, "agent");
      asm volatile("s_waitcnt vmcnt(0)" ::: "memory");
    }
  }
  __syncthreads();
}

#ifndef PROG
#define PROG 0xBA9876543210ull
#define NSTEP 12
#endif
constexpr int N_PHASES = 2 + 2 * NSTEP;
#ifndef PMASK
#define PMASK 0xffff
#endif
#define PM(k) ((PMASK >> (k)) & 1)
#ifndef REPMASK
#define REPMASK 0
#endif

__global__ void __launch_bounds__(NTHREADS) trunk_megakernel(Params p) {
  __shared__ __attribute__((aligned(16))) char smem[131072 + 16];
  cg::grid_group grid = cg::this_grid();
  const int bid = blockIdx.x, nblk = gridDim.x;
  if (threadIdx.x == 0) *(uint4*)(smem + 131072) = make_uint4(0u, 0u, 0u, 0u);
  __syncthreads();
  XcdBarrier xb;
  xb.bar = p.bar; xb.x = 0; xb.st = (volatile LAS unsigned*)(smem + 131072);
  if (p.phase_hi - p.phase_lo > 1) xb = xcd_barrier_post(p.bar, (volatile LAS unsigned*)(smem + 131072));
#pragma unroll 1
  for (int ph = p.phase_lo; ph < p.phase_hi; ++ph) {
    if (ph == 0) {
      if (PM(12)) phase_setup(p, smem, bid, nblk);
    } else if (ph == 1) {
      if (PM(13)) phase_rowpass(p, bid, nblk, 0, -1, 0.f, 0, 0, true, false);
    } else {
      const int l = (ph - 2) / NSTEP, s = (int)((PROG >> (4 * ((ph - 2) % NSTEP))) & 15ull);

      const bf16_t* wl = p.wts + (size_t)l * LAYER_W;
      const bool lo = (l == 1);
      switch (s) {
        case 0: if (PM(0)) phase_gemm(p, smem, bid, nblk, EPI_SWIGLU, l, p.h, DM, wl + OFF_W1, DM, 22, false); break;
        case 1: if (PM(1)) phase_gemm(p, smem, bid, nblk, EPI_Y, l, p.r1, DFF, wl + OFF_W2, DFF, 4, false); break;
        case 2: if (PM(2)) phase_rowpass(p, bid, nblk, l, 0, 0.5f, l, 1, l == 0, false); break;
        case 3: if (PM(3)) phase_gemm(p, smem, bid, nblk, EPI_WIN, l, p.h, DM, wl + OFF_WIN, DM, 9, false); break;
        case 4: if (PM(4)) phase_rowprep(p, bid, nblk, l); break;
        case 5: if (PM(5)) phase_dexp_gmlp(p, smem, bid, nblk, l); break;
        case 6: if (PM(6)) phase_attn(p, smem, bid, nblk, l); break;
        case 7: if (PM(7)) phase_gemm(p, smem, bid, nblk, EPI_Y, l, p.h, DM, wl + OFF_WOUT, DM, 4, lo); break;
        case 8: if (PM(8)) phase_rowpass(p, bid, nblk, l, 1, 1.0f, l, 2, false, lo); break;
        case 9: if (PM(9)) phase_gemm(p, smem, bid, nblk, EPI_SWIGLU, l, p.h, DM, wl + OFF_W3, DM, 22, lo); break;
        case 10: if (PM(10)) phase_gemm(p, smem, bid, nblk, EPI_Y, l, p.r1, DFF, wl + OFF_W4, DFF, 4, lo); break;
        default: if (PM(11)) phase_rowpass(p, bid, nblk, l, 2, 0.5f, l + 1, (l == 0) ? 0 : -1, false, lo); break;
      }
    }
    if (ph + 1 < p.phase_hi) { if (ph == 0) grid.sync(); else xcd_barrier(xb); }
  }
}

extern "C" void kernel_launch(void* const* d_in, const int* in_sizes, int n_in, void* d_out, int out_size, void* d_ws,
                              size_t ws_size, hipStream_t stream) {
  static int grid_blocks = 0;
  if (!grid_blocks) {
    int dev = 0, cus = 0, per_cu = 0;
    hipGetDevice(&dev);
    hipDeviceGetAttribute(&cus, hipDeviceAttributeMultiprocessorCount, dev);
    hipOccupancyMaxActiveBlocksPerMultiprocessor(&per_cu, trunk_megakernel, NTHREADS, 0);
    if (per_cu < 1) per_cu = 1;
    if (per_cu > 1) per_cu = 1;
    grid_blocks = cus * per_cu;
  }
  Params p{};
  const float** pf = (const float**)&p;
  for (int i = 0; i < 26; ++i) pf[i] = (const float*)d_in[i];
  p.out = (float*)d_out;
  char* ws = (char*)d_ws;
  size_t off = 0;
  auto take = [&](size_t bytes) { char* q = ws + off; off += (bytes + 255) & ~(size_t)255; return q; };
  p.wts = (bf16_t*)take(2 * LAYER_W * 2);
  p.mods = (float*)take((size_t)2 * 9 * 9216 * 4);
  p.rope = (float*)take(3072 * 4);
  p.xctx = (float*)take((size_t)2048 * 1024 * 4);
  p.h = (bf16_t*)take((size_t)MROWS * DM * 2);
  p.r1 = (bf16_t*)take((size_t)MROWS * DFF * 2);
  p.r2 = (bf16_t*)take((size_t)MROWS * NIN * 2);
  p.bar = (unsigned*)take(XCD_BAR_WORDS * 4);
  hipMemsetAsync(p.bar, 0, XCD_BAR_WORDS * 4, stream);
  if (off > ws_size) fprintf(stderr, "workspace too small: need %zu have %zu\n", off, ws_size);
#if MULTI_LAUNCH
  for (int ph = 0; ph < N_PHASES; ++ph) {
    Params q = p;
    q.phase_lo = ph;
    q.phase_hi = ph + 1;
    void* args[] = {&q};
    hipError_t e = hipLaunchCooperativeKernel((void*)trunk_megakernel, dim3(grid_blocks), dim3(NTHREADS), args, 0, stream);
    if (e != hipSuccess) fprintf(stderr, "launch failed: %s\n", hipGetErrorString(e));
  }
#else
  p.phase_lo = 0;
  p.phase_hi = N_PHASES;
  void* args[] = {&p};
  hipError_t e = hipLaunchCooperativeKernel((void*)trunk_megakernel, dim3(grid_blocks), dim3(NTHREADS), args, 0, stream);
  if (e != hipSuccess) fprintf(stderr, "cooperative launch failed: %s (grid %d)\n", hipGetErrorString(e), grid_blocks);
#endif
}
```

```cpp
#include <hip/hip_runtime.h>
#include <hip/hip_cooperative_groups.h>
#include <stdint.h>
#include <cstdio>
namespace cg = cooperative_groups;

#ifndef MULTI_LAUNCH
#define MULTI_LAUNCH 0
#endif

typedef unsigned short bf16_t;
using bf16x8 = __attribute__((ext_vector_type(8))) short;
using f32x16 = __attribute__((ext_vector_type(16))) float;
using u32x4 = __attribute__((ext_vector_type(4))) unsigned;
using u32x2 = __attribute__((ext_vector_type(2))) unsigned;

#define DI __device__ __forceinline__
#define MFMA32(a, b, c) __builtin_amdgcn_mfma_f32_32x32x16_bf16((a), (b), (c), 0, 0, 0)

constexpr int NT = 4352;
constexpr int NB = 8;
constexpr int MROWS = NB * NT;
constexpr int DM = 1024;
constexpr int DFF = 2816;
constexpr int NIN = 2304;
constexpr int NTHREADS = 512;
constexpr float EPS = 1e-6f;
constexpr float LOG2E = 1.4426950408889634f;

constexpr size_t OFF_W1 = 0;
constexpr size_t OFF_W2 = 5767168;
constexpr size_t OFF_W3 = 8650752;
constexpr size_t OFF_W4 = 14417920;
constexpr size_t OFF_WIN = 17301504;
constexpr size_t OFF_WOUT = 19660800;
constexpr size_t OFF_WUQ = 20709376;
constexpr size_t OFF_WUKV = 20840448;
constexpr size_t OFF_WSP = 20905984;
constexpr size_t LAYER_W = 20971520;

constexpr size_t QA_OFF = 0;
constexpr size_t KA_OFF = 8912896;
constexpr size_t VAT_OFF = 17825792;
constexpr size_t QB_OFF = 26738688;
constexpr size_t KB_OFF = 35651584;
constexpr size_t VBT_OFF = 40108032;
constexpr size_t QD_OFF = 44564480;
constexpr size_t KD_OFF = 57933824;
constexpr size_t VDT_OFF = 71303168;

struct Params {
  const float *x, *c, *ctx, *c_ctx, *w_ada, *b_ada, *g_pre, *g_post, *w_ffn1_in, *w_ffn1_out, *w_ffn2_in,
      *w_ffn2_out, *w_in, *w_out, *lam_vecs, *g_subln, *g_qnorm, *g_knorm, *w_spatial, *b_spatial, *ln_g, *ln_b,
      *g_q_a, *w_uq, *g_kv_a, *w_ukv;
  float* out;
  bf16_t* wts;
  float* mods;
  float* rope;
  float* xctx;
  bf16_t* h;
  bf16_t* r1;
  bf16_t* r2;
  unsigned* bar;
  int phase_lo, phase_hi;
};

DI int otid() { int t = threadIdx.x; asm volatile("" : "+v"(t)); return t; }
DI float bf2f(bf16_t v) { return __uint_as_float(((unsigned)v) << 16); }
DI bf16_t f2bf(float f) { __bf16 b = (__bf16)f; return __builtin_bit_cast(unsigned short, b); }
DI unsigned pack2(float a, float b) {
  unsigned r;
  asm("v_cvt_pk_bf16_f32 %0, %1, %2" : "=v"(r) : "v"(a), "v"(b));
  return r;
}
DI float max3f(float a, float b, float c) {
  float r;
  asm("v_max3_f32 %0, %1, %2, %3" : "=v"(r) : "v"(a), "v"(b), "v"(c));
  return r;
}
DI int crow(int e, int hh) { return (e & 3) + 8 * (e >> 2) + 4 * hh; }
DI float wave_sum(float v) {
#pragma unroll
  for (int o = 32; o >= 1; o >>= 1) v += __shfl_xor(v, o);
  return v;
}
DI float gelu_tanh(float x) {
  float u = 0.7978845608028654f * (x + 0.044715f * x * x * x);
  float t = __builtin_amdgcn_exp2f(u * (2.f * LOG2E));
  float th = 1.f - 2.f * __builtin_amdgcn_rcpf(1.f + t);
  return 0.5f * x * (1.f + th);
}
DI float silu(float x) { return x * __builtin_amdgcn_rcpf(1.f + __builtin_amdgcn_exp2f(-x * LOG2E)); }

DI void convert_tile(const float* __restrict__ src, int K, int N, int mode, bf16_t* __restrict__ dst, int kt, int nt,
                     float* tile) {
  const int tid = otid();
  {
    const int kl = tid >> 6, n4 = (tid & 63) * 4;
    const int np = nt * 256 + n4;
    int sc = np;
    if (mode == 1) {
      int j = (np >> 7) & 1, tl = np >> 8, cc = np & 127;
      sc = j * DFF + tl * 128 + cc;
    }
    const bool valid = (mode == 1) || (np < N);
    float4 v[8];
#pragma unroll
    for (int i = 0; i < 8; ++i) {
      v[i] = make_float4(0.f, 0.f, 0.f, 0.f);
      if (valid) v[i] = *(const float4*)(src + (size_t)(kt * 64 + kl + 8 * i) * N + sc);
    }
#pragma unroll
    for (int i = 0; i < 8; ++i) {
      float* tp = tile + (kl + 8 * i) * 257 + n4;
      tp[0] = v[i].x; tp[1] = v[i].y; tp[2] = v[i].z; tp[3] = v[i].w;
    }
  }
  __syncthreads();
#pragma unroll
  for (int i = 0; i < 4; ++i) {
    const int cid = tid + i * NTHREADS;
    const int nl = cid >> 3, kc = (cid & 7) * 8;
    u32x4 o;
#pragma unroll
    for (int j = 0; j < 4; ++j) o[j] = pack2(tile[(kc + 2 * j) * 257 + nl], tile[(kc + 2 * j + 1) * 257 + nl]);
    *(u32x4*)(dst + (size_t)(nt * 256 + nl) * K + kt * 64 + kc) = o;
  }
  __syncthreads();
}

DI void phase_setup(const Params& p, char* smem, int bid, int nblk) {
  const int tid = otid();
  constexpr int PER_LAYER = 1292;
  constexpr int N_CONV = 2 * PER_LAYER;
  constexpr int N_MOD = 288;
  const int total = N_CONV + N_MOD + 1;
  for (int it = bid; it < total; it += nblk) {
    if (it < N_CONV) {
      const int l = it / PER_LAYER;
      int i = it - l * PER_LAYER;
      bf16_t* wl = p.wts + (size_t)l * LAYER_W;
      float* tile = (float*)smem;
      if (i < 352) { convert_tile(p.w_ffn1_in + (size_t)l * DM * 2 * DFF, DM, 2 * DFF, 1, wl + OFF_W1, i / 22, i % 22, tile); continue; }
      i -= 352;
      if (i < 176) { convert_tile(p.w_ffn1_out + (size_t)l * DFF * DM, DFF, DM, 0, wl + OFF_W2, i / 4, i % 4, tile); continue; }
      i -= 176;
      if (i < 352) { convert_tile(p.w_ffn2_in + (size_t)l * DM * 2 * DFF, DM, 2 * DFF, 1, wl + OFF_W3, i / 22, i % 22, tile); continue; }
      i -= 352;
      if (i < 176) { convert_tile(p.w_ffn2_out + (size_t)l * DFF * DM, DFF, DM, 0, wl + OFF_W4, i / 4, i % 4, tile); continue; }
      i -= 176;
      if (i < 144) { convert_tile(p.w_in + (size_t)l * DM * 2208, DM, 2208, 0, wl + OFF_WIN, i / 9, i % 9, tile); continue; }
      i -= 144;
      if (i < 64) { convert_tile(p.w_out + (size_t)l * DM * DM, DM, DM, 0, wl + OFF_WOUT, i / 4, i % 4, tile); continue; }
      i -= 64;
      if (i < 8) { convert_tile(p.w_uq + (size_t)l * 256 * 384, 256, 384, 0, wl + OFF_WUQ, i / 2, i % 2, tile); continue; }
      i -= 8;
      if (i < 4) { convert_tile(p.w_ukv + (size_t)l * 128 * 512, 128, 512, 0, wl + OFF_WUKV, i / 2, i % 2, tile); continue; }
      i -= 4;
      {
        const float* s = p.w_spatial + (size_t)l * 65536 + (size_t)i * 4096;
        bf16_t* d = wl + OFF_WSP + (size_t)i * 4096;
        for (int e = tid; e < 4096; e += NTHREADS) d[e] = f2bf(s[e]);
      }
    } else if (it < N_CONV + N_MOD) {
      const int m = it - N_CONV;
      const int l = m / 144, cg64 = m % 144;
      float* s = (float*)smem;
      float* red = (float*)(smem + 36864);
      for (int e = tid; e < 9 * 1024; e += NTHREADS) {
        int b = e >> 10, k = e & 1023;
        float v = (b < 8) ? p.c[b * 1024 + k] : p.c_ctx[k];
        s[e] = silu(v);
      }
      __syncthreads();
      const int w = tid >> 6, lane = tid & 63;
      const int col = cg64 * 64 + lane;
      float acc[9];
#pragma unroll
      for (int b = 0; b < 9; ++b) acc[b] = 0.f;
      const float* wp = p.w_ada + (size_t)l * 1024 * 9216 + col;
      for (int k = w * 128; k < w * 128 + 128; ++k) {
        float wv = wp[(size_t)k * 9216];
#pragma unroll
        for (int b = 0; b < 9; ++b) acc[b] += s[b * 1024 + k] * wv;
      }
#pragma unroll
      for (int b = 0; b < 9; ++b) red[(w * 9 + b) * 64 + lane] = acc[b];
      __syncthreads();
      for (int e = tid; e < 9 * 64; e += NTHREADS) {
        int b = e >> 6, ln = e & 63;
        float t = 0.f;
#pragma unroll
        for (int ww = 0; ww < 8; ++ww) t += red[(ww * 9 + b) * 64 + ln];
        int cc = cg64 * 64 + ln;
        p.mods[((size_t)l * 9 + b) * 9216 + cc] = t + p.b_ada[(size_t)l * 9216 + cc];
      }
      __syncthreads();
    } else {
      for (int e = tid; e < 64 * 8; e += NTHREADS) {
        int pos = e >> 3, j = e & 7;
        float inv = __builtin_amdgcn_exp2f(-(float)j * (13.287712379549449f / 8.f));
        float rev = (float)pos * inv * 0.15915494309189535f;
        p.rope[e] = __builtin_amdgcn_cosf(rev);
        p.rope[512 + e] = __builtin_amdgcn_sinf(rev);
      }
      for (int e = tid; e < 64 * 16; e += NTHREADS) {
        int pos = e >> 4, j = e & 15;
        float inv = __builtin_amdgcn_exp2f(-(float)j * (13.287712379549449f / 16.f));
        float rev = (float)pos * inv * 0.15915494309189535f;
        p.rope[1024 + e] = __builtin_amdgcn_cosf(rev);
        p.rope[2048 + e] = __builtin_amdgcn_sinf(rev);
      }
    }
  }
}

DI void phase_rowpass(const Params& p, int bid, int nblk, int l_post, int j_post, float wres, int l_pre,
                              int j_pre, bool src_inputs, bool lat_only) {
  const int tid = otid(); const int lane = tid & 63, w = tid >> 6;
  const int gw = bid * 8 + w, nw = nblk * 8;
  const int nrows = lat_only ? NB * 4096 : MROWS;
  const int rpw = (nrows + nw - 1) / nw;
  const int r_begin = gw * rpw, r_end = (r_begin + rpw < nrows) ? r_begin + rpw : nrows;
  const bf16_t* __restrict__ y = p.r2;
  const bool has_post = j_post >= 0, has_pre = j_pre >= 0;
  float4 gate[4], gpo[4], shf[4], scl[4], gpr[4];
  int cur_mrow = -1;
  const float* __restrict__ gpost_p = p.g_post + ((size_t)l_post * 3 + (has_post ? j_post : 0)) * DM;
  const float* __restrict__ gpre_p = p.g_pre + ((size_t)(has_pre ? l_pre : 0) * 3 + (has_pre ? j_pre : 0)) * DM;
#pragma unroll
  for (int c = 0; c < 4; ++c) {
    gpo[c] = has_post ? *(const float4*)(gpost_p + c * 256 + lane * 4) : make_float4(0.f, 0.f, 0.f, 0.f);
    gpr[c] = has_pre ? *(const float4*)(gpre_p + c * 256 + lane * 4) : make_float4(0.f, 0.f, 0.f, 0.f);
    gate[c] = shf[c] = scl[c] = make_float4(0.f, 0.f, 0.f, 0.f);
  }
  float4 xn[4];
  u32x2 yn[4];
#define RP_ROW(ri, R, bb, tt)                                              \
  const int R = lat_only ? (((ri) >> 12) * NT + 256 + ((ri) & 4095)) : (ri); \
  const int bb = R / NT, tt = R - bb * NT;
#define RP_SRC(bb, tt, ptr)                                                                       \
  const float* ptr;                                                                               \
  if ((tt) < 256) ptr = (src_inputs ? p.ctx : p.xctx) + ((size_t)(bb) * 256 + (tt)) * DM;        \
  else ptr = (src_inputs ? p.x : p.out) + ((size_t)(bb) * 4096 + ((tt) - 256)) * DM;
  if (r_begin < r_end) {
    RP_ROW(r_begin, R0, b0, t0)
    RP_SRC(b0, t0, s0)
#pragma unroll
    for (int c = 0; c < 4; ++c) {
      xn[c] = *(const float4*)(s0 + c * 256 + lane * 4);
      if (has_post) yn[c] = *(const u32x2*)(y + (size_t)R0 * DM + c * 256 + lane * 4);
    }
  }
  for (int ri = r_begin; ri < r_end; ++ri) {
    RP_ROW(ri, R, b, t)
    const bool isctx = t < 256;
    const int mrow = isctx ? 8 : b;
    float* dst = isctx ? p.xctx + ((size_t)b * 256 + t) * DM : p.out + ((size_t)b * 4096 + (t - 256)) * DM;
    float xv[16], yv[16];
#pragma unroll
    for (int c = 0; c < 4; ++c) {
      xv[c * 4 + 0] = xn[c].x; xv[c * 4 + 1] = xn[c].y; xv[c * 4 + 2] = xn[c].z; xv[c * 4 + 3] = xn[c].w;
      yv[c * 4 + 0] = __uint_as_float(yn[c][0] << 16);
      yv[c * 4 + 1] = __uint_as_float(yn[c][0] & 0xffff0000u);
      yv[c * 4 + 2] = __uint_as_float(yn[c][1] << 16);
      yv[c * 4 + 3] = __uint_as_float(yn[c][1] & 0xffff0000u);
    }
    if (ri + 1 < r_end) {
      RP_ROW(ri + 1, Rn, bn, tn)
      RP_SRC(bn, tn, sn)
#pragma unroll
      for (int c = 0; c < 4; ++c) {
        xn[c] = *(const float4*)(sn + c * 256 + lane * 4);
        if (has_post) yn[c] = *(const u32x2*)(y + (size_t)Rn * DM + c * 256 + lane * 4);
      }
    }
    if (mrow != cur_mrow) {
      cur_mrow = mrow;
      const float* mpo = p.mods + ((size_t)l_post * 9 + mrow) * 9216 + (3 * (has_post ? j_post : 0) + 2) * DM;
      const float* mpr = p.mods + ((size_t)(has_pre ? l_pre : 0) * 9 + mrow) * 9216 + (3 * (has_pre ? j_pre : 0)) * DM;
#pragma unroll
      for (int c = 0; c < 4; ++c) {
        if (has_post) gate[c] = *(const float4*)(mpo + c * 256 + lane * 4);
        if (has_pre) {
          shf[c] = *(const float4*)(mpr + c * 256 + lane * 4);
          scl[c] = *(const float4*)(mpr + DM + c * 256 + lane * 4);
        }
      }
    }
    if (has_post) {
      float ss = 0.f;
#pragma unroll
      for (int q = 0; q < 16; ++q) ss += yv[q] * yv[q];
      ss = wave_sum(ss);
      const float rstd = rsqrtf(ss * (1.f / DM) + EPS) * wres;
#pragma unroll
      for (int c = 0; c < 4; ++c) {
        xv[c * 4 + 0] += gate[c].x * yv[c * 4 + 0] * rstd * gpo[c].x;
        xv[c * 4 + 1] += gate[c].y * yv[c * 4 + 1] * rstd * gpo[c].y;
        xv[c * 4 + 2] += gate[c].z * yv[c * 4 + 2] * rstd * gpo[c].z;
        xv[c * 4 + 3] += gate[c].w * yv[c * 4 + 3] * rstd * gpo[c].w;
        *(float4*)(dst + c * 256 + lane * 4) = make_float4(xv[c * 4 + 0], xv[c * 4 + 1], xv[c * 4 + 2], xv[c * 4 + 3]);
      }
    }
    if (has_pre) {
      float ss = 0.f;
#pragma unroll
      for (int q = 0; q < 16; ++q) ss += xv[q] * xv[q];
      ss = wave_sum(ss);
      const float rstd = rsqrtf(ss * (1.f / DM) + EPS);
#pragma unroll
      for (int c = 0; c < 4; ++c) {
        float h0 = xv[c * 4 + 0] * rstd * gpr[c].x * (1.f + scl[c].x) + shf[c].x;
        float h1 = xv[c * 4 + 1] * rstd * gpr[c].y * (1.f + scl[c].y) + shf[c].y;
        float h2 = xv[c * 4 + 2] * rstd * gpr[c].z * (1.f + scl[c].z) + shf[c].z;
        float h3 = xv[c * 4 + 3] * rstd * gpr[c].w * (1.f + scl[c].w) + shf[c].w;
        u32x2 o;
        o[0] = pack2(h0, h1);
        o[1] = pack2(h2, h3);
        *(u32x2*)(p.h + (size_t)R * DM + c * 256 + lane * 4) = o;
      }
    }
  }
#undef RP_ROW
#undef RP_SRC
}

enum { EPI_SWIGLU = 0, EPI_Y = 1, EPI_WIN = 2, EPI_UQ = 3, EPI_UKV = 4 };

DI void gemm_mainloop(const bf16_t* __restrict__ A, int lda, const bf16_t* __restrict__ Bt, int ldb, int K, char* smem,
                      f32x16 (&acc)[4][2]) {
  const int tid = otid(), lane = tid & 63, w = tid >> 6, wm = w >> 2, wn = w & 3, r = lane & 31, hh = lane >> 5;
  const int lc = tid & 7, lr = tid >> 3;
  const bf16_t* ap = A + (size_t)lr * lda + lc * 8;
  const bf16_t* bp = Bt + (size_t)lr * ldb + lc * 8;
  const int st_off = lr * 128 + ((lc ^ ((lr >> 1) & 7)) << 4);
  u32x4 ra[4], rb[4];
#pragma unroll
  for (int i = 0; i < 4; ++i)
#pragma unroll
    for (int j = 0; j < 2; ++j)
#pragma unroll
      for (int e = 0; e < 16; ++e) acc[i][j][e] = 0.f;
  const int nk = K >> 6;
#pragma unroll
  for (int i = 0; i < 4; ++i) {
    ra[i] = *(const u32x4*)(ap + (size_t)i * 64 * lda);
    rb[i] = *(const u32x4*)(bp + (size_t)i * 64 * ldb);
  }
#pragma unroll
  for (int i = 0; i < 4; ++i) {
    *(u32x4*)(smem + st_off + i * 8192) = ra[i];
    *(u32x4*)(smem + 32768 + st_off + i * 8192) = rb[i];
  }
  __syncthreads();
  const int sw = (r >> 1) & 7;
#pragma unroll 1
  for (int kt = 0; kt < nk; ++kt) {
    char* cur = smem + (kt & 1) * 65536;
    const bool more = (kt + 1 < nk);
    if (more) {
      ap += 64;
      bp += 64;
#pragma unroll
      for (int i = 0; i < 4; ++i) {
        ra[i] = *(const u32x4*)(ap + (size_t)i * 64 * lda);
        rb[i] = *(const u32x4*)(bp + (size_t)i * 64 * ldb);
      }
    }
    const char* abase = cur + (wm * 128 + r) * 128;
    const char* bbase = cur + 32768 + (wn * 64 + r) * 128;
#pragma unroll
    for (int ks = 0; ks < 4; ++ks) {
      const int off = (((2 * ks + hh) ^ sw) << 4);
      bf16x8 af[4], bfr[2];
#pragma unroll
      for (int i = 0; i < 4; ++i) af[i] = *(const bf16x8*)(abase + i * 4096 + off);
#pragma unroll
      for (int j = 0; j < 2; ++j) bfr[j] = *(const bf16x8*)(bbase + j * 4096 + off);
#pragma unroll
      for (int i = 0; i < 4; ++i)
#pragma unroll
        for (int j = 0; j < 2; ++j) acc[i][j] = MFMA32(af[i], bfr[j], acc[i][j]);
    }
    if (more) {
      char* nxt = smem + ((kt + 1) & 1) * 65536;
#pragma unroll
      for (int i = 0; i < 4; ++i) {
        *(u32x4*)(nxt + st_off + i * 8192) = ra[i];
        *(u32x4*)(nxt + 32768 + st_off + i * 8192) = rb[i];
      }
    }
    __syncthreads();
  }
}

DI int lat_tile(int i) { return (i >> 4) * 17 + 1 + (i & 15); }

DI void gemm_tile(const Params& p, char* smem, int mode, int layer, const bf16_t* A, int lda, const bf16_t* Bt,
                          int K, int rt, int ct) {
  f32x16 acc[4][2];
  const int row0 = rt * 256, col0 = ct * 256;
  gemm_mainloop(A + (size_t)row0 * lda, lda, Bt + (size_t)col0 * K, K, K, smem, acc);
  const int tid = otid(), lane = tid & 63, w = tid >> 6, wm = w >> 2, wn = w & 3, r = lane & 31, hh = lane >> 5;
  const int rb = row0 + wm * 128, cb = col0 + wn * 64;
  const int b = row0 / NT;
  const int tb = rb - b * NT;
  if (mode == EPI_SWIGLU) {
    bf16_t* act = p.r1;
    const int oc = ct * 128 + wn * 32 + r;
#pragma unroll
    for (int i = 0; i < 4; ++i)
#pragma unroll
      for (int e = 0; e < 16; ++e) {
        float g = acc[i][0][e], u = acc[i][1][e];
        act[(size_t)(rb + i * 32 + crow(e, hh)) * DFF + oc] = f2bf(silu(g) * u);
      }
  } else if (mode == EPI_Y) {
    bf16_t* y = p.r2;
#pragma unroll
    for (int i = 0; i < 4; ++i)
#pragma unroll
      for (int j = 0; j < 2; ++j)
#pragma unroll
        for (int e = 0; e < 16; ++e)
          y[(size_t)(rb + i * 32 + crow(e, hh)) * DM + cb + j * 32 + r] = f2bf(acc[i][j][e]);
  } else if (mode == EPI_WIN) {
    const bool isAv = (cb >= 512 && cb < 768);
    const bool isBv = (cb >= 1152 && cb < 1280);
    if (isAv || isBv) {
      bf16_t* vt;
      if (isAv) vt = p.r2 + VAT_OFF + (size_t)((b * 4 + (cb - 512) / 64) * 64) * NT;
      else vt = p.r2 + VBT_OFF + (size_t)((b * 2 + (cb - 1152) / 64) * 64) * NT;
#pragma unroll
      for (int i = 0; i < 4; ++i)
#pragma unroll
        for (int j = 0; j < 2; ++j)
#pragma unroll
          for (int e4 = 0; e4 < 4; ++e4) {
            u32x2 o;
            o[0] = pack2(acc[i][j][e4 * 4 + 0], acc[i][j][e4 * 4 + 1]);
            o[1] = pack2(acc[i][j][e4 * 4 + 2], acc[i][j][e4 * 4 + 3]);
            int t = tb + i * 32 + 8 * e4 + 4 * hh;
            *(u32x2*)(vt + (size_t)(j * 32 + r) * NT + t) = o;
          }
    } else {
      bf16_t* pp = p.r1;
#pragma unroll
      for (int i = 0; i < 4; ++i)
#pragma unroll
        for (int j = 0; j < 2; ++j)
#pragma unroll
          for (int e = 0; e < 16; ++e)
            pp[(size_t)(rb + i * 32 + crow(e, hh)) * NIN + cb + j * 32 + r] = f2bf(acc[i][j][e]);
    }
  } else if (mode == EPI_UQ) {
    const float scale = 0.10206207261596577f * LOG2E;
    const bool isctx = tb < 256;
#pragma unroll
    for (int j = 0; j < 2; ++j) {
      const int n0 = cb + j * 32;
      if (n0 >= 384) continue;
      const int head = n0 / 96, seg = (n0 % 96) / 32;
      bf16_t* qd = p.r2 + QD_OFF + (size_t)(b * 4 + head) * NT * 96 + seg * 32 + r;
#pragma unroll
      for (int i = 0; i < 4; ++i)
#pragma unroll
        for (int e = 0; e < 16; ++e) {
          float v = acc[i][j][e];
          const int t = tb + i * 32 + crow(e, hh);
          if (seg == 2) {
            float pr = __shfl_xor(v, 8);
            if (!isctx) {
              const int pos = t - 256;
              const int pa = (r & 16) ? (pos & 63) : (pos >> 6);
              const float cs = p.rope[pa * 8 + (r & 7)], sn = p.rope[512 + pa * 8 + (r & 7)];
              v = v * cs + ((r & 8) ? pr : -pr) * sn;
            }
          }
          qd[(size_t)t * 96] = f2bf(v * scale);
        }
    }
  } else {
#pragma unroll
    for (int j = 0; j < 2; ++j) {
      const int n0 = cb + j * 32;
      const int head = n0 >> 7, wseg = n0 & 127;
      if (wseg < 64) {
        bf16_t* kd = p.r2 + KD_OFF + (size_t)(b * 4 + head) * NT * 96 + wseg + r;
#pragma unroll
        for (int i = 0; i < 4; ++i)
#pragma unroll
          for (int e = 0; e < 16; ++e) kd[(size_t)(tb + i * 32 + crow(e, hh)) * 96] = f2bf(acc[i][j][e]);
      } else {
        bf16_t* vt = p.r2 + VDT_OFF + (size_t)((b * 4 + head) * 64 + (wseg - 64) + r) * NT;
#pragma unroll
        for (int i = 0; i < 4; ++i)
#pragma unroll
          for (int e4 = 0; e4 < 4; ++e4) {
            u32x2 o;
            o[0] = pack2(acc[i][j][e4 * 4 + 0], acc[i][j][e4 * 4 + 1]);
            o[1] = pack2(acc[i][j][e4 * 4 + 2], acc[i][j][e4 * 4 + 3]);
            *(u32x2*)(vt + tb + i * 32 + 16 * (e4 >> 1) + 8 * hh + 4 * (e4 & 1)) = o;
          }
      }
    }
  }
}


using f32x4 = __attribute__((ext_vector_type(4))) float;
typedef __attribute__((address_space(3))) unsigned lds_u32;
DI int lds_byte8(int r, int c) {
  int st = (r >> 4) * 2 + (c >> 5), rr = r & 15, cc = c & 31, ob = rr * 64 + cc * 2;
  return st * 1024 + (ob ^ (((ob >> 9) & 1) << 5));
}
DI void stage_rc8(int b, int& R, int& C) {
  int st = b / 1024, sb = b % 1024, swz = sb ^ (((sb >> 9) & 1) << 5);
  R = (st >> 1) * 16 + swz / 64;
  C = (st & 1) * 32 + (swz % 64) / 2;
}
#define G8_HT 16384
#define G8_SA(b, h) (smem + ((b) * 2 + (h)) * G8_HT)
#define G8_SB(b, h) (smem + (4 + (b) * 2 + (h)) * G8_HT)
#define G8_STAGE(P, BASE, goff0, goff1, ld, br, kt)                                                              \
  do {                                                                                                            \
    const bf16_t* _g = (BASE) + (size_t)(br) * (ld) + (size_t)(kt) * 64;                                          \
    __builtin_amdgcn_global_load_lds((const unsigned*)(_g + goff0), (lds_u32*)((P) + tid * 16), 16, 0, 0);        \
    __builtin_amdgcn_global_load_lds((const unsigned*)(_g + goff1), (lds_u32*)((P) + tid * 16 + 8192), 16, 0, 0); \
  } while (0)
#define G8_LDA(dst, b, h)                                                                                 \
  _Pragma("unroll") for (int m = 0; m < 4; ++m) _Pragma("unroll") for (int k = 0; k < 2; ++k) dst[m][k] = \
      *(const bf16x8*)(G8_SA(b, h) + lds_byte8(wr * 64 + m * 16 + fr, k * 32 + fq * 8))
#define G8_LDB(dst, b, h)                                                                                 \
  _Pragma("unroll") for (int n = 0; n < 2; ++n) _Pragma("unroll") for (int k = 0; k < 2; ++k) dst[n][k] = \
      *(const bf16x8*)(G8_SB(b, h) + lds_byte8(wc * 32 + n * 16 + fr, k * 32 + fq * 8))
#define G8_MMA(ai, bj, AT, BX)                                                                         \
  do {                                                                                                 \
    __builtin_amdgcn_s_setprio(1);                                                                     \
    _Pragma("unroll") for (int m = 0; m < 4; ++m) _Pragma("unroll") for (int n = 0; n < 2; ++n)        \
        _Pragma("unroll") for (int k = 0; k < 2; ++k) acc[ai][bj][m][n] =                              \
            __builtin_amdgcn_mfma_f32_16x16x32_bf16(AT[m][k], BX[n][k], acc[ai][bj][m][n], 0, 0, 0);   \
    __builtin_amdgcn_s_setprio(0);                                                                     \
  } while (0)
#define G8_WAIT_V(n) asm volatile("s_waitcnt vmcnt(" #n ")" ::: "memory")
#define G8_WAIT_L(n) asm volatile("s_waitcnt lgkmcnt(" #n ")" ::: "memory")
#define G8_BAR __builtin_amdgcn_s_barrier()
#define G8_SCHED __builtin_amdgcn_sched_barrier(0)

DI void gemm8_mainloop(const bf16_t* __restrict__ A, int lda, const bf16_t* __restrict__ Bt, int ldb, int K,
                       __attribute__((address_space(3))) char* smem, f32x4 (&acc)[2][2][4][2]) {
  const int tid = otid();
  const int wid = tid >> 6, lane = tid & 63, wr = wid >> 2, wc = wid & 3, fr = lane & 15, fq = lane >> 4;
  int r0, c0, r1, c1;
  stage_rc8(tid * 16, r0, c0);
  stage_rc8(tid * 16 + 8192, r1, c1);
  const int ga0 = r0 * lda + c0, ga1 = r1 * lda + c1, gb0 = r0 * ldb + c0, gb1 = r1 * ldb + c1;
#pragma unroll
  for (int a = 0; a < 2; ++a)
#pragma unroll
    for (int b = 0; b < 2; ++b)
#pragma unroll
      for (int m = 0; m < 4; ++m)
#pragma unroll
        for (int n = 0; n < 2; ++n) acc[a][b][m][n] = (f32x4){0.f, 0.f, 0.f, 0.f};
  bf16x8 At[4][2], B0[2][2], B1[2][2];
  const int nt = K >> 6;
  G8_WAIT_V(0);
  G8_STAGE(G8_SB(0, 0), Bt, gb0, gb1, ldb, 0, 0);
  G8_STAGE(G8_SA(0, 0), A, ga0, ga1, lda, 0, 0);
  G8_STAGE(G8_SB(0, 1), Bt, gb0, gb1, ldb, 128, 0);
  G8_STAGE(G8_SA(0, 1), A, ga0, ga1, lda, 128, 0);
  if (wr == 1) G8_BAR;
  G8_WAIT_V(4); G8_BAR;
  G8_STAGE(G8_SB(1, 0), Bt, gb0, gb1, ldb, 0, 1);
  G8_STAGE(G8_SA(1, 0), A, ga0, ga1, lda, 0, 1);
  G8_STAGE(G8_SB(1, 1), Bt, gb0, gb1, ldb, 128, 1);
  G8_WAIT_V(6); G8_BAR;
#pragma unroll 1
  for (int t = 0; t < nt - 2; t += 2) {
    G8_LDB(B0, 0, 0); G8_SCHED; G8_LDA(At, 0, 0); G8_STAGE(G8_SA(1, 1), A, ga0, ga1, lda, 128, t + 1);
    G8_WAIT_L(8); G8_BAR; G8_WAIT_L(0); G8_MMA(0, 0, At, B0); G8_BAR; G8_SCHED;
    G8_LDB(B1, 0, 1); G8_STAGE(G8_SB(0, 0), Bt, gb0, gb1, ldb, 0, t + 2);
    G8_BAR; G8_WAIT_L(0); G8_MMA(0, 1, At, B1); G8_BAR;
    G8_LDA(At, 0, 1); G8_STAGE(G8_SA(0, 0), A, ga0, ga1, lda, 0, t + 2);
    G8_BAR; G8_WAIT_L(0); G8_MMA(1, 0, At, B0); G8_BAR; G8_SCHED;
    G8_STAGE(G8_SB(0, 1), Bt, gb0, gb1, ldb, 128, t + 2);
    G8_WAIT_V(6); G8_BAR; G8_MMA(1, 1, At, B1); G8_BAR;
    G8_LDB(B0, 1, 0); G8_SCHED; G8_LDA(At, 1, 0); G8_STAGE(G8_SA(0, 1), A, ga0, ga1, lda, 128, t + 2);
    G8_WAIT_L(8); G8_BAR; G8_WAIT_L(0); G8_MMA(0, 0, At, B0); G8_BAR; G8_SCHED;
    G8_LDB(B1, 1, 1); G8_STAGE(G8_SB(1, 0), Bt, gb0, gb1, ldb, 0, t + 3);
    G8_BAR; G8_WAIT_L(0); G8_MMA(0, 1, At, B1); G8_BAR;
    G8_LDA(At, 1, 1); G8_STAGE(G8_SA(1, 0), A, ga0, ga1, lda, 0, t + 3);
    G8_BAR; G8_WAIT_L(0); G8_MMA(1, 0, At, B0); G8_BAR; G8_SCHED;
    G8_STAGE(G8_SB(1, 1), Bt, gb0, gb1, ldb, 128, t + 3);
    G8_WAIT_V(6); G8_BAR; G8_MMA(1, 1, At, B1); G8_BAR;
  }
  {
    G8_LDB(B0, 0, 0); G8_LDA(At, 0, 0); G8_STAGE(G8_SA(1, 1), A, ga0, ga1, lda, 128, nt - 1);
    G8_BAR; G8_WAIT_L(0); G8_MMA(0, 0, At, B0); G8_BAR;
    G8_LDB(B1, 0, 1); G8_BAR; G8_WAIT_L(0); G8_MMA(0, 1, At, B1); G8_BAR;
    G8_LDA(At, 0, 1); G8_WAIT_V(4); G8_BAR; G8_WAIT_L(0); G8_MMA(1, 0, At, B0); G8_MMA(1, 1, At, B1); G8_BAR;
  }
  {
    G8_LDB(B0, 1, 0); G8_LDA(At, 1, 0); G8_WAIT_V(2); G8_BAR; G8_WAIT_L(0); G8_MMA(0, 0, At, B0); G8_BAR;
    G8_LDB(B1, 1, 1); G8_WAIT_V(0); G8_BAR; G8_WAIT_L(0); G8_MMA(0, 1, At, B1); G8_BAR;
    G8_LDA(At, 1, 1); G8_BAR; G8_WAIT_L(0); G8_MMA(1, 0, At, B0); G8_MMA(1, 1, At, B1); G8_BAR;
  }
  if (wr == 0) G8_BAR;
}

DI void gemm8_tile(const Params& p, char* smem_g, int mode, const bf16_t* A, int lda, const bf16_t* Bt, int K, int rt,
                   int ct) {
  f32x4 acc[2][2][4][2];
  const int row0 = rt * 256, col0 = ct * 256;
  gemm8_mainloop(A + (size_t)row0 * lda, lda, Bt + (size_t)col0 * K, K, K,
                 (__attribute__((address_space(3))) char*)smem_g, acc);
  const int tid = otid();
  const int wid = tid >> 6, lane = tid & 63, wr = wid >> 2, wc = wid & 3, fr = lane & 15, fq = lane >> 4;
  const int b = row0 / NT;
  const int rw = row0 + wr * 64 + fq * 4;
  if (mode == EPI_SWIGLU) {
    bf16_t* act = p.r1;
#pragma unroll
    for (int ai = 0; ai < 2; ++ai)
#pragma unroll
      for (int m = 0; m < 4; ++m)
#pragma unroll
        for (int n = 0; n < 2; ++n)
#pragma unroll
          for (int j = 0; j < 4; ++j) {
            float g = acc[ai][0][m][n][j], u = acc[ai][1][m][n][j];
            act[(size_t)(rw + ai * 128 + m * 16 + j) * DFF + ct * 128 + wc * 32 + n * 16 + fr] = f2bf(silu(g) * u);
          }
  } else if (mode == EPI_Y) {
    bf16_t* y = p.r2;
#pragma unroll
    for (int ai = 0; ai < 2; ++ai)
#pragma unroll
      for (int bj = 0; bj < 2; ++bj)
#pragma unroll
        for (int m = 0; m < 4; ++m)
#pragma unroll
          for (int n = 0; n < 2; ++n)
#pragma unroll
            for (int j = 0; j < 4; ++j)
              y[(size_t)(rw + ai * 128 + m * 16 + j) * DM + col0 + bj * 128 + wc * 32 + n * 16 + fr] =
                  f2bf(acc[ai][bj][m][n][j]);
  } else {
    const int tw16 = row0 - b * NT + wr * 64 + (((fq & 1) << 1) | (fq >> 1)) * 4;
#pragma unroll
    for (int bj = 0; bj < 2; ++bj) {
      const int cb = col0 + bj * 128 + wc * 32;
      const bool isAv = (cb >= 512 && cb < 768);
      const bool isBv = (cb >= 1152 && cb < 1280);
      if (isAv || isBv) {
        bf16_t* vt;
        if (isAv) vt = p.r2 + VAT_OFF + (size_t)((b * 4 + (cb - 512) / 64) * 64 + (cb & 32)) * NT;
        else vt = p.r2 + VBT_OFF + (size_t)((b * 2 + (cb - 1152) / 64) * 64 + (cb & 32)) * NT;
#pragma unroll
        for (int ai = 0; ai < 2; ++ai)
#pragma unroll
          for (int m = 0; m < 4; ++m)
#pragma unroll
            for (int n = 0; n < 2; ++n) {
              u32x2 o;
              o[0] = pack2(acc[ai][bj][m][n][0], acc[ai][bj][m][n][1]);
              o[1] = pack2(acc[ai][bj][m][n][2], acc[ai][bj][m][n][3]);
              *(u32x2*)(vt + (size_t)(n * 16 + fr) * NT + tw16 + ai * 128 + m * 16) = o;
            }
      } else {
        bf16_t* pp = p.r1;
#pragma unroll
        for (int ai = 0; ai < 2; ++ai)
#pragma unroll
          for (int m = 0; m < 4; ++m)
#pragma unroll
            for (int n = 0; n < 2; ++n)
#pragma unroll
              for (int j = 0; j < 4; ++j)
                pp[(size_t)(rw + ai * 128 + m * 16 + j) * NIN + cb + n * 16 + fr] = f2bf(acc[ai][bj][m][n][j]);
      }
    }
  }
}

DI int xcd_vb(int bid, int nblk) {
  if (nblk & 7) return bid;
  return (bid & 7) * (nblk >> 3) + (bid >> 3);
}

DI void phase_gemm(const Params& p, char* smem, int bid, int nblk, int mode, int layer, const bf16_t* A, int lda,
                           const bf16_t* Bt, int K, int nct, bool lat_only) {
  const int nrt = lat_only ? 128 : 136;
  const int total = nrt * nct;
  for (int t = xcd_vb(bid, nblk); t < total; t += nblk) {
    int rti = t / nct, ct = t - rti * nct;
    int rt = lat_only ? lat_tile(rti) : rti;
    gemm8_tile(p, smem, mode, A, lda, Bt, K, rt, ct);
  }
}

DI void phase_rowprep(const Params& p, int bid, int nblk, int l) {
  const int tid = otid(); const int lane = tid & 63, w = tid >> 6;
  const int gw = bid * 8 + w, nw = nblk * 8;
  const float* __restrict__ ropeAc = p.rope;
  const float* __restrict__ ropeAs = p.rope + 512;
  const float* __restrict__ ropeBc = p.rope + 1024;
  const float* __restrict__ ropeBs = p.rope + 2048;
  const float gqn = p.g_qnorm[l * 64 + lane], gkn = p.g_knorm[l * 64 + lane];
  float lng[4], lnb[4], gqa[4], gkva[2];
#pragma unroll
  for (int i = 0; i < 4; ++i) {
    lng[i] = p.ln_g[l * 256 + i * 64 + lane];
    lnb[i] = p.ln_b[l * 256 + i * 64 + lane];
    gqa[i] = p.g_q_a[l * 256 + i * 64 + lane];
  }
  gkva[0] = p.g_kv_a[l * 128 + lane];
  gkva[1] = p.g_kv_a[l * 128 + 64 + lane];
  const float scaleA = 0.17677669529663687f * LOG2E;
  const float scaleB = 0.125f * LOG2E;
  bf16_t* __restrict__ qkv = p.r2;
  for (int R = gw; R < MROWS; R += nw) {
    const int b = R / NT, t = R - b * NT;
    const bool isctx = t < 256;
    const int pos = t - 256;
    const int prow = pos >> 6, pcol = pos & 63;
    bf16_t* P = p.r1 + (size_t)R * NIN;
    float va[8], vb[6], vc[8], vd[6], vkr;
#pragma unroll
    for (int i = 0; i < 8; ++i) va[i] = bf2f(P[i * 64 + lane]);
#pragma unroll
    for (int i = 0; i < 6; ++i) vb[i] = bf2f(P[768 + i * 64 + lane]);
#pragma unroll
    for (int i = 0; i < 8; ++i) vc[i] = bf2f(P[1280 + i * 64 + lane]);
#pragma unroll
    for (int i = 0; i < 6; ++i) vd[i] = bf2f(P[1792 + i * 64 + lane]);
    vkr = bf2f(P[2176 + (lane & 31)]);
    {
      const int d = lane & 31;
      const int pa = (d & 16) ? pcol : prow;
      float cs = 1.f, sn = 0.f;
      if (!isctx) { cs = ropeAc[pa * 8 + (d & 7)]; sn = ropeAs[pa * 8 + (d & 7)]; }
      const float sg = (d & 8) ? sn : -sn;
#pragma unroll
      for (int i = 0; i < 4; ++i) {
        const int hm = (i * 64 + lane) >> 5;
        float vq = va[i], vk = va[4 + i];
        float pq = __shfl_xor(vq, 8), pk = __shfl_xor(vk, 8);
        vq = vq * cs + sg * pq;
        vk = vk * cs + sg * pk;
        size_t o = ((size_t)(b * 8 + hm) * NT + t) * 32 + d;
        qkv[QA_OFF + o] = f2bf(vq * scaleA);
        qkv[KA_OFF + o] = f2bf(vk);
      }
    }
    {
      const int d = lane;
      const int pa = (d & 32) ? pcol : prow;
      float cs = 1.f, sn = 0.f;
      if (!isctx) { cs = ropeBc[pa * 16 + (d & 15)]; sn = ropeBs[pa * 16 + (d & 15)]; }
      const float sg = (d & 16) ? sn : -sn;
      float ss[6];
#pragma unroll
      for (int i = 0; i < 6; ++i) ss[i] = vb[i] * vb[i];
#pragma unroll
      for (int o = 32; o >= 1; o >>= 1)
#pragma unroll
        for (int i = 0; i < 6; ++i) ss[i] += __shfl_xor(ss[i], o);
#pragma unroll
      for (int i = 0; i < 6; ++i) {
        float v = vb[i] * rsqrtf(ss[i] * (1.f / 64.f) + EPS) * (i < 4 ? gqn : gkn);
        float pr = __shfl_xor(v, 16);
        v = v * cs + sg * pr;
        if (i < 4) qkv[QB_OFF + ((size_t)(b * 4 + i) * NT + t) * 64 + d] = f2bf(v * scaleB);
        else qkv[KB_OFF + ((size_t)(b * 2 + (i - 4)) * NT + t) * 64 + d] = f2bf(v);
      }
    }
    {
      float s1 = 0.f, sq = 0.f, skv = 0.f;
#pragma unroll
      for (int i = 0; i < 4; ++i) {
        vc[i] = gelu_tanh(vc[i]);
        vc[4 + i] = gelu_tanh(vc[4 + i]);
        s1 += vc[4 + i];
        sq += vd[i] * vd[i];
      }
      skv = vd[4] * vd[4] + vd[5] * vd[5];
#pragma unroll
      for (int o = 32; o >= 1; o >>= 1) {
        s1 += __shfl_xor(s1, o);
        sq += __shfl_xor(sq, o);
        skv += __shfl_xor(skv, o);
      }
      const float mu = s1 * (1.f / 256.f);
      float s2 = 0.f;
#pragma unroll
      for (int i = 0; i < 4; ++i) { vc[4 + i] -= mu; s2 += vc[4 + i] * vc[4 + i]; }
      s2 = wave_sum(s2);
      const float rln = rsqrtf(s2 * (1.f / 256.f) + EPS);
      const float rq = rsqrtf(sq * (1.f / 256.f) + EPS);
      const float rkv = rsqrtf(skv * (1.f / 128.f) + EPS);
#pragma unroll
      for (int i = 0; i < 4; ++i) {
        P[1280 + i * 64 + lane] = f2bf(vc[i]);
        P[1536 + i * 64 + lane] = f2bf(vc[4 + i] * rln * lng[i] + lnb[i]);
        P[1792 + i * 64 + lane] = f2bf(vd[i] * rq * gqa[i]);
      }
      P[2048 + lane] = f2bf(vd[4] * rkv * gkva[0]);
      P[2048 + 64 + lane] = f2bf(vd[5] * rkv * gkva[1]);
    }
    {
      const int d = lane & 31;
      float kr = vkr;
      float pr = __shfl_xor(kr, 8);
      if (!isctx) {
        const int pa = (d & 16) ? pcol : prow;
        kr = kr * ropeAc[pa * 8 + (d & 7)] + ((d & 8) ? pr : -pr) * ropeAs[pa * 8 + (d & 7)];
      }
      if (lane < 32) {
        const bf16_t kb = f2bf(kr);
#pragma unroll
        for (int hd = 0; hd < 4; ++hd) qkv[KD_OFF + ((size_t)(b * 4 + hd) * NT + t) * 96 + 64 + d] = kb;
      }
    }
  }
}

DI void gmlp_item(const Params& p, char* smem, int l, int ch, int g) {
  const int tid = otid(), lane = tid & 63, w = tid >> 6, r = lane & 31, hh = lane >> 5;
  const int R0 = ch * 128;
  bf16_t* vT = (bf16_t*)smem;
#pragma unroll
  for (int u = 0; u < 2; ++u) {
    const int cid = tid + u * NTHREADS;
    const int q = cid >> 3, cc = cid & 7;
    u32x4 v = *(const u32x4*)(p.r1 + (size_t)(R0 + q) * NIN + 1536 + g * 64 + cc * 8);
#pragma unroll
    for (int j = 0; j < 4; ++j) {
      vT[(cc * 8 + 2 * j) * 136 + q] = (bf16_t)(v[j] & 0xffffu);
      vT[(cc * 8 + 2 * j + 1) * 136 + q] = (bf16_t)(v[j] >> 16);
    }
  }
  __syncthreads();
  const int wp = w >> 1, wc = w & 1;
  const bf16_t* wsp = p.wts + (size_t)l * LAYER_W + OFF_WSP + (size_t)g * 16384;
  f32x16 acc;
#pragma unroll
  for (int e = 0; e < 16; ++e) acc[e] = 0.f;
#pragma unroll
  for (int ks = 0; ks < 8; ++ks) {
    bf16x8 a = *(const bf16x8*)(wsp + (wp * 32 + r) * 128 + ks * 16 + hh * 8);
    bf16x8 bb = *(const bf16x8*)(vT + (wc * 32 + r) * 136 + ks * 16 + hh * 8);
    acc = MFMA32(a, bb, acc);
  }
  const int c = g * 64 + wc * 32 + r;
#pragma unroll
  for (int e = 0; e < 16; ++e) {
    const int pp = wp * 32 + crow(e, hh);
    const float u = bf2f(p.r1[(size_t)(R0 + pp) * NIN + 1280 + c]);
    const float mixed = acc[e] + p.b_spatial[(size_t)l * 512 + g * 128 + pp];
    p.h[(size_t)(R0 + pp) * DM + 512 + c] = f2bf(u * mixed);
  }
  __syncthreads();
}

DI void phase_dexp_gmlp(const Params& p, char* smem, int bid, int nblk, int l) {
  const bool lat_only = (l == 1);
  const bf16_t* wl = p.wts + (size_t)l * LAYER_W;
  const int nch = lat_only ? 256 : 272;
  const int total = 272 + 272 + nch * 4;
  for (int t = xcd_vb(bid, nblk); t < total; t += nblk) {
    if (t < 272) {
      gemm_tile(p, smem, EPI_UQ, l, p.r1 + 1792, NIN, wl + OFF_WUQ, 256, t >> 1, t & 1);
    } else if (t < 544) {
      int u = t - 272;
      gemm_tile(p, smem, EPI_UKV, l, p.r1 + 2048, NIN, wl + OFF_WUKV, 128, u >> 1, u & 1);
    } else {
      int u = t - 544;
      int ci = u >> 2, g = u & 3;
      int ch = lat_only ? ((ci >> 5) * 34 + 2 + (ci & 31)) : ci;
      gmlp_item(p, smem, l, ch, g);
    }
  }
}

template <int CPR>
DI int kswz(int c, int row) {
  if (CPR == 4) return c ^ ((row >> 2) & 3);
  if (CPR == 8) return c ^ ((row >> 1) & 7);
  return (c & 12) | ((c & 3) ^ ((row >> 2) & 3));
}

template <int DQK, int NMAP>
DI void attn_item(const bf16_t* __restrict__ Qb, const bf16_t* __restrict__ Kb, const bf16_t* __restrict__ Vt,
                  int q0, int nkeys, bf16_t* __restrict__ outp, char* smem_g, float lam, float post_scale,
                  const float* __restrict__ g_subln) {
  typedef __attribute__((address_space(3))) char lchar;
  lchar* smem = (lchar*)smem_g;
  constexpr int CPR = DQK / 8;
  constexpr int KMAPB = 64 * CPR * 16;
  constexpr int KBYTES = NMAP * KMAPB;
  constexpr int STAGE = KBYTES + 8192;
  constexpr int NS = 5;
  constexpr int NKS = KBYTES / 16;
  constexpr int GK = (NKS + NTHREADS - 1) / NTHREADS;
  constexpr int KK = DQK / 16;
  constexpr float THR = 6.0f;
  const int tid = otid();
  const int lane = tid & 63, w = tid >> 6, r = lane & 31, hh = lane >> 5;

  asm volatile("s_waitcnt vmcnt(0)" ::: "memory");
  __builtin_amdgcn_s_barrier();
  asm volatile("" ::: "memory");

  bf16x8 qf[NMAP][KK];
  {
    const int qrow = q0 + w * 32 + r;
#pragma unroll
    for (int m = 0; m < NMAP; ++m)
#pragma unroll
      for (int kk = 0; kk < KK; ++kk)
        qf[m][kk] = *(const bf16x8*)(Qb + (size_t)m * NT * DQK + (size_t)qrow * DQK + kk * 16 + hh * 8);
  }
  const bf16_t* ksrc[GK];
  int kslot[GK];
#pragma unroll
  for (int u = 0; u < GK; ++u) {
    int sl = tid + u * NTHREADS;
    if (sl >= NKS) sl = tid;
    const int m = sl / (64 * CPR), rem = sl % (64 * CPR), row = rem / CPR, cp = rem % CPR;
    const int c = kswz<CPR>(cp, row);
    ksrc[u] = Kb + (size_t)m * NT * DQK + (size_t)row * DQK + c * 8;
    kslot[u] = sl * 16;
  }
  const int vrow = tid >> 3, vcp = tid & 7;
  const bf16_t* vsrc = Vt + (size_t)vrow * NT + ((vcp ^ ((vrow >> 1) & 7)) * 8);
  const int vslot = KBYTES + tid * 16;
  const int nt = nkeys >> 6;

#define ATT_ISSUE(tile, stoff)                                                                                    \
  do {                                                                                                            \
    const int _tl = (tile) < nt ? (tile) : nt - 1;                                                                \
    lchar* _st = smem + (stoff);                                                                                  \
    _Pragma("unroll") for (int u = 0; u < GK; ++u) __builtin_amdgcn_global_load_lds(                              \
        (const unsigned*)(ksrc[u] + (size_t)_tl * 64 * DQK), (lds_u32*)(_st + kslot[u]), 16, 0, 0);                \
    __builtin_amdgcn_global_load_lds((const unsigned*)(vsrc + _tl * 64), (lds_u32*)(_st + vslot), 16, 0, 0);      \
  } while (0)
#define ATT_WAITG()                                                    \
  do {                                                                 \
    if (GK == 1) asm volatile("s_waitcnt vmcnt(2)" ::: "memory");      \
    else asm volatile("s_waitcnt vmcnt(3)" ::: "memory");              \
  } while (0)

  f32x16 O[NMAP][2];
  float mrun[NMAP], lrun[NMAP];
#pragma unroll
  for (int m = 0; m < NMAP; ++m) {
    mrun[m] = 0.f;
    lrun[m] = 0.f;
#pragma unroll
    for (int d = 0; d < 2; ++d)
#pragma unroll
      for (int e = 0; e < 16; ++e) O[m][d][e] = 0.f;
  }
  const int kq = (r >> 2) & 3, k8 = (r >> 1) & 7;
  const int koff = r * (CPR * 16), voff = r * 128;

#define ATT_QK(Sx, so, m, base)                                                                          \
  do {                                                                                                   \
    _Pragma("unroll") for (int t2 = 0; t2 < 2; ++t2) {                                                   \
      _Pragma("unroll") for (int e = 0; e < 16; ++e) Sx[t2][e] = -(base);                                \
      _Pragma("unroll") for (int kk = 0; kk < KK; ++kk) {                                                \
        const int c = kk * 2 + hh;                                                                       \
        const int cp = (CPR == 8) ? (c ^ k8) : ((c & 12) | ((c & 3) ^ kq));                              \
        bf16x8 a = *(const bf16x8*)(smem + (so) + (m) * KMAPB + t2 * 32 * (CPR * 16) + koff + cp * 16);  \
        Sx[t2] = MFMA32(a, qf[m][kk], Sx[t2]);                                                           \
      }                                                                                                  \
    }                                                                                                    \
  } while (0)
#define ATT_PV(Px, so, m)                                                                                \
  do {                                                                                                   \
    _Pragma("unroll") for (int d = 0; d < 2; ++d) _Pragma("unroll") for (int t2 = 0; t2 < 2; ++t2)       \
        _Pragma("unroll") for (int s2 = 0; s2 < 2; ++s2) {                                               \
      const int c = t2 * 4 + s2 * 2 + hh;                                                                \
      bf16x8 vf = *(const bf16x8*)(smem + (so) + KBYTES + d * 32 * 128 + voff + ((c ^ k8) * 16));        \
      O[m][d] = MFMA32(vf, Px[t2][s2], O[m][d]);                                                         \
    }                                                                                                    \
  } while (0)
#define ATT_SOFTMAX(Sx, sbase, Px, m, first)                                                             \
  do {                                                                                                   \
    float mx = fmaxf(Sx[0][0], Sx[1][0]);                                                                \
    _Pragma("unroll") for (int e = 1; e < 16; ++e) mx = max3f(mx, Sx[0][e], Sx[1][e]);                   \
    mx = fmaxf(mx, __shfl_xor(mx, 32));                                                                  \
    const float drift = mrun[m] - (sbase);                                                               \
    const float mxr = mx - drift;                                                                        \
    const bool up = (first) || (mxr > THR);                                                              \
    if (__builtin_amdgcn_ballot_w64(up || (drift != 0.f)) != 0ull) {                                     \
      const float sh = up ? mxr : 0.f;                                                                   \
      const float alpha = (first) ? 1.f : __builtin_amdgcn_exp2f(-sh);                                   \
      mrun[m] += sh;                                                                                     \
      lrun[m] *= alpha;                                                                                  \
      _Pragma("unroll") for (int d = 0; d < 2; ++d) _Pragma("unroll") for (int e = 0; e < 16; ++e)       \
          O[m][d][e] *= alpha;                                                                           \
      const float tot = drift + sh;                                                                      \
      _Pragma("unroll") for (int t2 = 0; t2 < 2; ++t2) _Pragma("unroll") for (int e = 0; e < 16; ++e)    \
          Sx[t2][e] -= tot;                                                                              \
    }                                                                                                    \
    float sum = 0.f;                                                                                     \
    _Pragma("unroll") for (int t2 = 0; t2 < 2; ++t2) _Pragma("unroll") for (int e = 0; e < 16; ++e) {    \
      float pv = __builtin_amdgcn_exp2f(Sx[t2][e]);                                                      \
      Sx[t2][e] = pv;                                                                                    \
      sum += pv;                                                                                         \
    }                                                                                                    \
    lrun[m] += sum;                                                                                      \
    _Pragma("unroll") for (int t2 = 0; t2 < 2; ++t2) _Pragma("unroll") for (int s2 = 0; s2 < 2; ++s2) {  \
      u32x4 pk;                                                                                          \
      _Pragma("unroll") for (int j = 0; j < 4; ++j)                                                      \
          pk[j] = pack2(Sx[t2][8 * s2 + 2 * j], Sx[t2][8 * s2 + 2 * j + 1]);                             \
      Px[t2][s2] = __builtin_bit_cast(bf16x8, pk);                                                       \
    }                                                                                                    \
  } while (0)

  f32x16 Sa[2], Sb[2];
  bf16x8 Pa[2][2], Pb[2][2];
  float basea = 0.f, baseb = 0.f;
#pragma unroll
  for (int t2 = 0; t2 < 2; ++t2)
#pragma unroll
    for (int s2 = 0; s2 < 2; ++s2) {
      u32x4 z = {0u, 0u, 0u, 0u};
      Pa[t2][s2] = __builtin_bit_cast(bf16x8, z);
      Pb[t2][s2] = __builtin_bit_cast(bf16x8, z);
    }
  ATT_ISSUE(0, 0);
  ATT_ISSUE(1, STAGE);
  ATT_ISSUE(2, 2 * STAGE);
  if (GK == 1) asm volatile("s_waitcnt vmcnt(4)" ::: "memory");
  else asm volatile("s_waitcnt vmcnt(6)" ::: "memory");
  __builtin_amdgcn_s_barrier();
  asm volatile("" ::: "memory");
  ATT_QK(Sa, 0, 0, 0.f);
  int sp = 0, sc = 0, sn = STAGE, si = 3 * STAGE;
#define ATT_ADV()                                         \
  do {                                                    \
    sp = sc; sc = sn;                                     \
    sn = (sn + STAGE == NS * STAGE) ? 0 : sn + STAGE;     \
    si = (si + STAGE == NS * STAGE) ? 0 : si + STAGE;     \
  } while (0)
  if (NMAP == 2) {
#pragma unroll 1
    for (int j = 0; j < nt; ++j) {
      ATT_WAITG();
      __builtin_amdgcn_s_barrier();
      asm volatile("" ::: "memory");
      ATT_ISSUE(j + 3, si);
      baseb = mrun[NMAP - 1];
      ATT_QK(Sb, sc, NMAP - 1, baseb);
      ATT_PV(Pb, sp, NMAP - 1);
      ATT_SOFTMAX(Sa, basea, Pa, 0, (j == 0));
      basea = mrun[0];
      ATT_QK(Sa, sn, 0, basea);
      ATT_PV(Pa, sc, 0);
      ATT_SOFTMAX(Sb, baseb, Pb, NMAP - 1, (j == 0));
      ATT_ADV();
    }
    ATT_PV(Pb, sp, NMAP - 1);
  } else {
#pragma unroll 1
    for (int j = 0; j < nt; j += 2) {
      ATT_WAITG();
      __builtin_amdgcn_s_barrier();
      asm volatile("" ::: "memory");
      ATT_ISSUE(j + 3, si);
      baseb = mrun[0];
      ATT_QK(Sb, sn, 0, baseb);
      ATT_PV(Pb, sp, 0);
      ATT_SOFTMAX(Sa, basea, Pa, 0, (j == 0));
      ATT_ADV();
      ATT_WAITG();
      __builtin_amdgcn_s_barrier();
      asm volatile("" ::: "memory");
      ATT_ISSUE(j + 4, si);
      basea = mrun[0];
      ATT_QK(Sa, sn, 0, basea);
      ATT_PV(Pa, sp, 0);
      ATT_SOFTMAX(Sb, baseb, Pb, 0, false);
      ATT_ADV();
    }
    ATT_PV(Pb, sp, 0);
  }
#undef ATT_ISSUE
#undef ATT_WAITG
#undef ATT_QK
#undef ATT_PV
#undef ATT_SOFTMAX
#undef ATT_ADV
  asm volatile("s_waitcnt vmcnt(0)" ::: "memory");
#pragma unroll
  for (int m = 0; m < NMAP; ++m) lrun[m] += __shfl_xor(lrun[m], 32);
  bf16_t* orow = outp + (size_t)(w * 32 + r) * DM;
  if (NMAP == 1) {
    const float inv = 1.f / lrun[0];
#pragma unroll
    for (int d = 0; d < 2; ++d)
#pragma unroll
      for (int e4 = 0; e4 < 4; ++e4) {
        u32x2 o;
        o[0] = pack2(O[0][d][e4 * 4 + 0] * inv, O[0][d][e4 * 4 + 1] * inv);
        o[1] = pack2(O[0][d][e4 * 4 + 2] * inv, O[0][d][e4 * 4 + 3] * inv);
        *(u32x2*)(orow + d * 32 + 8 * e4 + 4 * hh) = o;
      }
  } else {
    const float i1 = 1.f / lrun[0], i2 = lam / lrun[NMAP - 1];
    float ss = 0.f;
#pragma unroll
    for (int d = 0; d < 2; ++d)
#pragma unroll
      for (int e = 0; e < 16; ++e) {
        float o = O[0][d][e] * i1 - O[NMAP - 1][d][e] * i2;
        O[0][d][e] = o;
        ss += o * o;
      }
    ss += __shfl_xor(ss, 32);
    const float rstd = rsqrtf(ss * (1.f / 64.f) + EPS) * post_scale;
#pragma unroll
    for (int d = 0; d < 2; ++d)
#pragma unroll
      for (int e4 = 0; e4 < 4; ++e4) {
        const int dv = d * 32 + 8 * e4 + 4 * hh;
        u32x2 o;
        o[0] = pack2(O[0][d][e4 * 4 + 0] * rstd * g_subln[dv + 0], O[0][d][e4 * 4 + 1] * rstd * g_subln[dv + 1]);
        o[1] = pack2(O[0][d][e4 * 4 + 2] * rstd * g_subln[dv + 2], O[0][d][e4 * 4 + 3] * rstd * g_subln[dv + 3]);
        *(u32x2*)(orow + dv) = o;
      }
  }
}

DI void phase_attn(const Params& p, char* smem, int bid, int nblk, int l) {
  const bool lat_only = (l == 1);
  const int nq = lat_only ? 16 : 17;
  const int per = NB * 4 * nq;
  const int total = 3 * per;
  const float lam_init = (l == 0) ? 0.2f : 0.35550906759096927f;
  float lam;
  {
    const float* lv = p.lam_vecs + l * 128;
    float s1 = 0.f, s2 = 0.f;
    for (int i = 0; i < 32; ++i) { s1 += lv[i] * lv[32 + i]; s2 += lv[64 + i] * lv[96 + i]; }
    lam = __builtin_amdgcn_exp2f(s1 * LOG2E) - __builtin_amdgcn_exp2f(s2 * LOG2E) + lam_init;
  }
  for (int t = xcd_vb(bid, nblk); t < total; t += nblk) {
    const int mixer = t / per;
    int u = t - mixer * per;
    const int bh = u / nq;
    int qb = u - bh * nq;
    if (lat_only) qb += 1;
    const int b = bh >> 2, hd = bh & 3;
    const int q0 = qb * 256;
    const int nkeys = (qb == 0) ? 256 : NT;
    bf16_t* mixrow = p.h + ((size_t)b * NT + q0) * DM;
    if (mixer == 0) {
      attn_item<32, 2>(p.r2 + QA_OFF + (size_t)(b * 4 + hd) * 2 * NT * 32, p.r2 + KA_OFF + (size_t)(b * 4 + hd) * 2 * NT * 32,
                       p.r2 + VAT_OFF + (size_t)(b * 4 + hd) * 64 * NT, q0, nkeys, mixrow + hd * 64, smem, lam,
                       1.f - lam_init, p.g_subln + l * 64);
    } else if (mixer == 1) {
      attn_item<96, 1>(p.r2 + QD_OFF + (size_t)(b * 4 + hd) * NT * 96, p.r2 + KD_OFF + (size_t)(b * 4 + hd) * NT * 96,
                       p.r2 + VDT_OFF + (size_t)(b * 4 + hd) * 64 * NT, q0, nkeys, mixrow + 768 + hd * 64, smem, 0.f, 0.f,
                       nullptr);
    } else {
      attn_item<64, 1>(p.r2 + QB_OFF + (size_t)(b * 4 + hd) * NT * 64, p.r2 + KB_OFF + (size_t)(b * 2 + (hd >> 1)) * NT * 64,
                       p.r2 + VBT_OFF + (size_t)(b * 2 + (hd >> 1)) * 64 * NT, q0, nkeys, mixrow + 256 + hd * 64, smem, 0.f,
                       0.f, nullptr);
    }
  }
}


#define XB_TMO      128
#define XB_XCNT(j)  (256  + 64 * (j))
#define XB_XSUB(j)  (1280 + 64 * (j))
#define XB_XGEN(j)  (2304 + 64 * (j))
#define XB_TOP      3328
#define XB_TOPGEN   3392
#define XCD_BAR_WORDS 3456
#define XB_SPIN_CAP (1u << 18)
#define LAS __attribute__((address_space(3)))
DI unsigned xb_ld(unsigned* p) { return __hip_atomic_load(p, __ATOMIC_RELAXED, __HIP_MEMORY_SCOPE_AGENT); }
DI unsigned xb_add(unsigned* p, unsigned v) { return __hip_atomic_fetch_add(p, v, __ATOMIC_RELAXED, __HIP_MEMORY_SCOPE_AGENT); }
DI unsigned xb_xcc_id() { return (unsigned)__builtin_amdgcn_s_getreg((3 << 11) | 20) & 0xFu; }
#define XB_SPIN(cond, bar) do { unsigned _sp = 0; while (cond) { __builtin_amdgcn_s_sleep(1); \
    if ((++_sp & 255u) == 0u) { if (xb_ld(&(bar)[XB_TMO])) break; if (_sp > XB_SPIN_CAP) { atomicAdd(&(bar)[XB_TMO], 1u); break; } } } } while (0)
struct XcdBarrier { unsigned* bar; unsigned x; volatile LAS unsigned* st; };
DI XcdBarrier xcd_barrier_post(unsigned* bar, volatile LAS unsigned* st) {
  XcdBarrier b; b.bar = bar; b.x = xb_xcc_id(); b.st = st;
  if (threadIdx.x == 0) (void)xb_add(&bar[XB_XCNT(b.x)], 1u);
  return b;
}
DI void xcd_barrier_complete(unsigned* bar, unsigned x, unsigned& nloc, unsigned& nx) {
  const unsigned G = gridDim.x * gridDim.y * gridDim.z;
  unsigned sum, cnt, mine, sp = 0u;
  for (;;) {
    sum = 0u; cnt = 0u; mine = 0u;
#pragma unroll
    for (unsigned j = 0; j < 16; ++j) { const unsigned c = xb_ld(&bar[XB_XCNT(j)]); sum += c; cnt += (c > 0u) ? 1u : 0u; mine = (j == x) ? c : mine; }
    if (sum == G) break;
    __builtin_amdgcn_s_sleep(1);
    if ((++sp & 255u) == 0u) { if (xb_ld(&bar[XB_TMO])) break; if (sp > XB_SPIN_CAP) { atomicAdd(&bar[XB_TMO], 1u); break; } }
  }
  nloc = mine > 0u ? mine : 1u; nx = cnt > 0u ? cnt : 1u;
}
DI void xcd_barrier(const XcdBarrier& b) {
  asm volatile("s_waitcnt vmcnt(0)" ::: "memory");
  __syncthreads();
  if (threadIdx.x == 0) {
    unsigned* bar = b.bar;
    __builtin_amdgcn_s_waitcnt(0);
    unsigned nloc = b.st[0], nx = b.st[1];
    if (nloc == 0u) { xcd_barrier_complete(bar, b.x, nloc, nx); b.st[0] = nloc; b.st[1] = nx; }
    const unsigned old = xb_add(&bar[XB_XSUB(b.x)], 1u);
    const unsigned gen = old / nloc;
    if (old + 1u == (gen + 1u) * nloc) {
      __builtin_amdgcn_fence(__ATOMIC_RELEASE, "agent");
      asm volatile("s_waitcnt vmcnt(0)" ::: "memory");
      const unsigned og = xb_add(&bar[XB_TOP], 1u);
      const unsigned tg = og / nx;
      if (og + 1u == (tg + 1u) * nx) xb_add(&bar[XB_TOPGEN], 1u);
      else XB_SPIN(xb_ld(&bar[XB_TOPGEN]) == tg, bar);
      __builtin_amdgcn_fence(__ATOMIC_ACQUIRE, "agent");
      xb_add(&bar[XB_XGEN(b.x)], 1u);
      asm volatile("s_waitcnt vmcnt(0)" ::: "memory");
    } else {
      XB_SPIN(xb_ld(&bar[XB_XGEN(b.x)]) == gen, bar);
      __builtin_amdgcn_fence(__ATOMIC_ACQUIRE, "agent");
      asm volatile("s_waitcnt vmcnt(0)" ::: "memory");
    }
  }
  __syncthreads();
}

DI const Params& kp() {
  auto k = __builtin_amdgcn_kernarg_segment_ptr();
  asm volatile("" : "+s"(k));
  return *(const Params*)k;
}

#ifndef PROG
#define PROG 0xBA9876543210ull
#define NSTEP 12
#endif
constexpr int N_PHASES = 2 + 2 * NSTEP;
#ifndef PMASK
#define PMASK 0xffff
#endif
#define PM(k) ((PMASK >> (k)) & 1)
#ifndef REPMASK
#define REPMASK 0
#endif

__global__ void __launch_bounds__(NTHREADS) trunk_megakernel(Params p) {
  __shared__ __attribute__((aligned(16))) char smem[131072 + 16];
  cg::grid_group grid = cg::this_grid();
  const int bid = blockIdx.x, nblk = gridDim.x;
  if (threadIdx.x == 0) *(uint4*)(smem + 131072) = make_uint4(0u, 0u, 0u, 0u);
  __syncthreads();
  XcdBarrier xb;
  xb.bar = p.bar; xb.x = 0; xb.st = (volatile LAS unsigned*)(smem + 131072);
  if (p.phase_hi - p.phase_lo > 1) xb = xcd_barrier_post(p.bar, (volatile LAS unsigned*)(smem + 131072));
#pragma unroll 1
  for (int ph = p.phase_lo; ph < p.phase_hi; ++ph) {
    if (ph == 0) {
      if (PM(12)) phase_setup(kp(), smem, bid, nblk);
    } else if (ph == 1) {
      if (PM(13)) phase_rowpass(kp(), bid, nblk, 0, -1, 0.f, 0, 0, true, false);
    } else {
      const int l = (ph - 2) / NSTEP, s = (int)((PROG >> (4 * ((ph - 2) % NSTEP))) & 15ull);


      const bool lo = (l == 1);
      switch (s) {
        case 0: if (PM(0)) phase_gemm(kp(), smem, bid, nblk, EPI_SWIGLU, l, kp().h, DM, kp().wts + (size_t)l * LAYER_W + OFF_W1, DM, 22, false); break;
        case 1: if (PM(1)) phase_gemm(kp(), smem, bid, nblk, EPI_Y, l, kp().r1, DFF, kp().wts + (size_t)l * LAYER_W + OFF_W2, DFF, 4, false); break;
        case 2: if (PM(2)) phase_rowpass(kp(), bid, nblk, l, 0, 0.5f, l, 1, l == 0, false); break;
        case 3: if (PM(3)) phase_gemm(kp(), smem, bid, nblk, EPI_WIN, l, kp().h, DM, kp().wts + (size_t)l * LAYER_W + OFF_WIN, DM, 9, false); break;
        case 4: if (PM(4)) phase_rowprep(kp(), bid, nblk, l); break;
        case 5: if (PM(5)) phase_dexp_gmlp(kp(), smem, bid, nblk, l); break;
        case 6: if (PM(6)) phase_attn(kp(), smem, bid, nblk, l); break;
        case 7: if (PM(7)) phase_gemm(kp(), smem, bid, nblk, EPI_Y, l, kp().h, DM, kp().wts + (size_t)l * LAYER_W + OFF_WOUT, DM, 4, lo); break;
        case 8: if (PM(8)) phase_rowpass(kp(), bid, nblk, l, 1, 1.0f, l, 2, false, lo); break;
        case 9: if (PM(9)) phase_gemm(kp(), smem, bid, nblk, EPI_SWIGLU, l, kp().h, DM, kp().wts + (size_t)l * LAYER_W + OFF_W3, DM, 22, lo); break;
        case 10: if (PM(10)) phase_gemm(kp(), smem, bid, nblk, EPI_Y, l, kp().r1, DFF, kp().wts + (size_t)l * LAYER_W + OFF_W4, DFF, 4, lo); break;
        default: if (PM(11)) phase_rowpass(kp(), bid, nblk, l, 2, 0.5f, l + 1, (l == 0) ? 0 : -1, false, lo); break;
      }
    }
    if (ph + 1 < p.phase_hi) { if (ph == 0) grid.sync(); else xcd_barrier(xb); }
  }
}

extern "C" void kernel_launch(void* const* d_in, const int* in_sizes, int n_in, void* d_out, int out_size, void* d_ws,
                              size_t ws_size, hipStream_t stream) {
  static int grid_blocks = 0;
  if (!grid_blocks) {
    int dev = 0, cus = 0, per_cu = 0;
    hipGetDevice(&dev);
    hipDeviceGetAttribute(&cus, hipDeviceAttributeMultiprocessorCount, dev);
    hipOccupancyMaxActiveBlocksPerMultiprocessor(&per_cu, trunk_megakernel, NTHREADS, 0);
    if (per_cu < 1) per_cu = 1;
    if (per_cu > 1) per_cu = 1;
    grid_blocks = cus * per_cu;
  }
  Params p{};
  const float** pf = (const float**)&p;
  for (int i = 0; i < 26; ++i) pf[i] = (const float*)d_in[i];
  p.out = (float*)d_out;
  char* ws = (char*)d_ws;
  size_t off = 0;
  auto take = [&](size_t bytes) { char* q = ws + off; off += (bytes + 255) & ~(size_t)255; return q; };
  p.wts = (bf16_t*)take(2 * LAYER_W * 2);
  p.mods = (float*)take((size_t)2 * 9 * 9216 * 4);
  p.rope = (float*)take(3072 * 4);
  p.xctx = (float*)take((size_t)2048 * 1024 * 4);
  p.h = (bf16_t*)take((size_t)MROWS * DM * 2);
  p.r1 = (bf16_t*)take((size_t)MROWS * DFF * 2);
  p.r2 = (bf16_t*)take((size_t)MROWS * NIN * 2);
  p.bar = (unsigned*)take(XCD_BAR_WORDS * 4);
  hipMemsetAsync(p.bar, 0, XCD_BAR_WORDS * 4, stream);
  if (off > ws_size) fprintf(stderr, "workspace too small: need %zu have %zu\n", off, ws_size);
#if MULTI_LAUNCH
  for (int ph = 0; ph < N_PHASES; ++ph) {
    Params q = p;
    q.phase_lo = ph;
    q.phase_hi = ph + 1;
    void* args[] = {&q};
    hipError_t e = hipLaunchCooperativeKernel((void*)trunk_megakernel, dim3(grid_blocks), dim3(NTHREADS), args, 0, stream);
    if (e != hipSuccess) fprintf(stderr, "launch failed: %s\n", hipGetErrorString(e));
  }
#else
  p.phase_lo = 0;
  p.phase_hi = N_PHASES;
  void* args[] = {&p};
  hipError_t e = hipLaunchCooperativeKernel((void*)trunk_megakernel, dim3(grid_blocks), dim3(NTHREADS), args, 0, stream);
  if (e != hipSuccess) fprintf(stderr, "cooperative launch failed: %s (grid %d)\n", hipGetErrorString(e), grid_blocks);
#endif
}
```

```cpp
#include <hip/hip_runtime.h>
#include <hip/hip_cooperative_groups.h>
#include <stdint.h>
#include <cstdio>
namespace cg = cooperative_groups;

#ifndef MULTI_LAUNCH
#define MULTI_LAUNCH 0
#endif

typedef unsigned short bf16_t;
using bf16x8 = __attribute__((ext_vector_type(8))) short;
using f32x16 = __attribute__((ext_vector_type(16))) float;
using u32x4 = __attribute__((ext_vector_type(4))) unsigned;
using u32x2 = __attribute__((ext_vector_type(2))) unsigned;

#define DI __device__ __forceinline__
#define MFMA32(a, b, c) __builtin_amdgcn_mfma_f32_32x32x16_bf16((a), (b), (c), 0, 0, 0)

constexpr int NT = 4352;
constexpr int NB = 8;
constexpr int MROWS = NB * NT;
constexpr int DM = 1024;
constexpr int DFF = 2816;
constexpr int NIN = 2304;
constexpr int NTHREADS = 512;
constexpr float EPS = 1e-6f;
constexpr float LOG2E = 1.4426950408889634f;

constexpr size_t OFF_W1 = 0;
constexpr size_t OFF_W2 = 5767168;
constexpr size_t OFF_W3 = 8650752;
constexpr size_t OFF_W4 = 14417920;
constexpr size_t OFF_WIN = 17301504;
constexpr size_t OFF_WOUT = 19660800;
constexpr size_t OFF_WUQ = 20709376;
constexpr size_t OFF_WUKV = 20840448;
constexpr size_t OFF_WSP = 20905984;
constexpr size_t LAYER_W = 20971520;

constexpr size_t QA_OFF = 0;
constexpr size_t KA_OFF = 8912896;
constexpr size_t VAT_OFF = 17825792;
constexpr size_t QB_OFF = 26738688;
constexpr size_t KB_OFF = 35651584;
constexpr size_t VBT_OFF = 40108032;
constexpr size_t QD_OFF = 44564480;
constexpr size_t KD_OFF = 57933824;
constexpr size_t VDT_OFF = 71303168;

struct Params {
  const float *x, *c, *ctx, *c_ctx, *w_ada, *b_ada, *g_pre, *g_post, *w_ffn1_in, *w_ffn1_out, *w_ffn2_in,
      *w_ffn2_out, *w_in, *w_out, *lam_vecs, *g_subln, *g_qnorm, *g_knorm, *w_spatial, *b_spatial, *ln_g, *ln_b,
      *g_q_a, *w_uq, *g_kv_a, *w_ukv;
  float* out;
  bf16_t* wts;
  float* mods;
  float* rope;
  float* xctx;
  bf16_t* h;
  bf16_t* r1;
  bf16_t* r2;
  unsigned* bar;
  int phase_lo, phase_hi;
};

DI int otid() { int t = threadIdx.x; asm volatile("" : "+v"(t)); return t; }
DI float bf2f(bf16_t v) { return __uint_as_float(((unsigned)v) << 16); }
DI bf16_t f2bf(float f) { __bf16 b = (__bf16)f; return __builtin_bit_cast(unsigned short, b); }
DI unsigned pack2(float a, float b) {
  unsigned r;
  asm("v_cvt_pk_bf16_f32 %0, %1, %2" : "=v"(r) : "v"(a), "v"(b));
  return r;
}
DI float max3f(float a, float b, float c) {
  float r;
  asm("v_max3_f32 %0, %1, %2, %3" : "=v"(r) : "v"(a), "v"(b), "v"(c));
  return r;
}
DI int crow(int e, int hh) { return (e & 3) + 8 * (e >> 2) + 4 * hh; }
DI float wave_sum(float v) {
#pragma unroll
  for (int o = 32; o >= 1; o >>= 1) v += __shfl_xor(v, o);
  return v;
}
DI float gelu_tanh(float x) {
  float u = 0.7978845608028654f * (x + 0.044715f * x * x * x);
  float t = __builtin_amdgcn_exp2f(u * (2.f * LOG2E));
  float th = 1.f - 2.f * __builtin_amdgcn_rcpf(1.f + t);
  return 0.5f * x * (1.f + th);
}
DI float silu(float x) { return x * __builtin_amdgcn_rcpf(1.f + __builtin_amdgcn_exp2f(-x * LOG2E)); }

DI void convert_tile(const float* __restrict__ src, int K, int N, int mode, bf16_t* __restrict__ dst, int kt, int nt,
                     float* tile) {
  const int tid = otid();
  {
    const int kl = tid >> 6, n4 = (tid & 63) * 4;
    const int np = nt * 256 + n4;
    int sc = np;
    if (mode == 1) {
      int j = (np >> 7) & 1, tl = np >> 8, cc = np & 127;
      sc = j * DFF + tl * 128 + cc;
    }
    const bool valid = (mode == 1) || (np < N);
    float4 v[8];
#pragma unroll
    for (int i = 0; i < 8; ++i) {
      v[i] = make_float4(0.f, 0.f, 0.f, 0.f);
      if (valid) v[i] = *(const float4*)(src + (size_t)(kt * 64 + kl + 8 * i) * N + sc);
    }
#pragma unroll
    for (int i = 0; i < 8; ++i) {
      float* tp = tile + (kl + 8 * i) * 257 + n4;
      tp[0] = v[i].x; tp[1] = v[i].y; tp[2] = v[i].z; tp[3] = v[i].w;
    }
  }
  __syncthreads();
#pragma unroll
  for (int i = 0; i < 4; ++i) {
    const int cid = tid + i * NTHREADS;
    const int nl = cid >> 3, kc = (cid & 7) * 8;
    u32x4 o;
#pragma unroll
    for (int j = 0; j < 4; ++j) o[j] = pack2(tile[(kc + 2 * j) * 257 + nl], tile[(kc + 2 * j + 1) * 257 + nl]);
    *(u32x4*)(dst + (size_t)(nt * 256 + nl) * K + kt * 64 + kc) = o;
  }
  __syncthreads();
}

DI void phase_setup(const Params& p, char* smem, int bid, int nblk) {
  const int tid = otid();
  constexpr int PER_LAYER = 1292;
  constexpr int N_CONV = 2 * PER_LAYER;
  constexpr int N_MOD = 288;
  const int total = N_CONV + N_MOD + 1;
  for (int it = bid; it < total; it += nblk) {
    if (it < N_CONV) {
      const int l = it / PER_LAYER;
      int i = it - l * PER_LAYER;
      bf16_t* wl = p.wts + (size_t)l * LAYER_W;
      float* tile = (float*)smem;
      if (i < 352) { convert_tile(p.w_ffn1_in + (size_t)l * DM * 2 * DFF, DM, 2 * DFF, 1, wl + OFF_W1, i / 22, i % 22, tile); continue; }
      i -= 352;
      if (i < 176) { convert_tile(p.w_ffn1_out + (size_t)l * DFF * DM, DFF, DM, 0, wl + OFF_W2, i / 4, i % 4, tile); continue; }
      i -= 176;
      if (i < 352) { convert_tile(p.w_ffn2_in + (size_t)l * DM * 2 * DFF, DM, 2 * DFF, 1, wl + OFF_W3, i / 22, i % 22, tile); continue; }
      i -= 352;
      if (i < 176) { convert_tile(p.w_ffn2_out + (size_t)l * DFF * DM, DFF, DM, 0, wl + OFF_W4, i / 4, i % 4, tile); continue; }
      i -= 176;
      if (i < 144) { convert_tile(p.w_in + (size_t)l * DM * 2208, DM, 2208, 0, wl + OFF_WIN, i / 9, i % 9, tile); continue; }
      i -= 144;
      if (i < 64) { convert_tile(p.w_out + (size_t)l * DM * DM, DM, DM, 0, wl + OFF_WOUT, i / 4, i % 4, tile); continue; }
      i -= 64;
      if (i < 8) { convert_tile(p.w_uq + (size_t)l * 256 * 384, 256, 384, 0, wl + OFF_WUQ, i / 2, i % 2, tile); continue; }
      i -= 8;
      if (i < 4) { convert_tile(p.w_ukv + (size_t)l * 128 * 512, 128, 512, 0, wl + OFF_WUKV, i / 2, i % 2, tile); continue; }
      i -= 4;
      {
        const float* s = p.w_spatial + (size_t)l * 65536 + (size_t)i * 4096;
        bf16_t* d = wl + OFF_WSP + (size_t)i * 4096;
        for (int e = tid; e < 4096; e += NTHREADS) d[e] = f2bf(s[e]);
      }
    } else if (it < N_CONV + N_MOD) {
      const int m = it - N_CONV;
      const int l = m / 144, cg64 = m % 144;
      float* s = (float*)smem;
      float* red = (float*)(smem + 36864);
      for (int e = tid; e < 9 * 1024; e += NTHREADS) {
        int b = e >> 10, k = e & 1023;
        float v = (b < 8) ? p.c[b * 1024 + k] : p.c_ctx[k];
        s[e] = silu(v);
      }
      __syncthreads();
      const int w = tid >> 6, lane = tid & 63;
      const int col = cg64 * 64 + lane;
      float acc[9];
#pragma unroll
      for (int b = 0; b < 9; ++b) acc[b] = 0.f;
      const float* wp = p.w_ada + (size_t)l * 1024 * 9216 + col;
      for (int k = w * 128; k < w * 128 + 128; ++k) {
        float wv = wp[(size_t)k * 9216];
#pragma unroll
        for (int b = 0; b < 9; ++b) acc[b] += s[b * 1024 + k] * wv;
      }
#pragma unroll
      for (int b = 0; b < 9; ++b) red[(w * 9 + b) * 64 + lane] = acc[b];
      __syncthreads();
      for (int e = tid; e < 9 * 64; e += NTHREADS) {
        int b = e >> 6, ln = e & 63;
        float t = 0.f;
#pragma unroll
        for (int ww = 0; ww < 8; ++ww) t += red[(ww * 9 + b) * 64 + ln];
        int cc = cg64 * 64 + ln;
        p.mods[((size_t)l * 9 + b) * 9216 + cc] = t + p.b_ada[(size_t)l * 9216 + cc];
      }
      __syncthreads();
    } else {
      for (int e = tid; e < 64 * 8; e += NTHREADS) {
        int pos = e >> 3, j = e & 7;
        float inv = __builtin_amdgcn_exp2f(-(float)j * (13.287712379549449f / 8.f));
        float rev = (float)pos * inv * 0.15915494309189535f;
        p.rope[e] = __builtin_amdgcn_cosf(rev);
        p.rope[512 + e] = __builtin_amdgcn_sinf(rev);
      }
      for (int e = tid; e < 64 * 16; e += NTHREADS) {
        int pos = e >> 4, j = e & 15;
        float inv = __builtin_amdgcn_exp2f(-(float)j * (13.287712379549449f / 16.f));
        float rev = (float)pos * inv * 0.15915494309189535f;
        p.rope[1024 + e] = __builtin_amdgcn_cosf(rev);
        p.rope[2048 + e] = __builtin_amdgcn_sinf(rev);
      }
    }
  }
}

DI void phase_rowpass(const Params& p, int bid, int nblk, int l_post, int j_post, float wres, int l_pre,
                              int j_pre, bool src_inputs, bool lat_only) {
  const int tid = otid(); const int lane = tid & 63, w = tid >> 6;
  const int gw = bid * 8 + w, nw = nblk * 8;
  const int nrows = lat_only ? NB * 4096 : MROWS;
  const int rpw = (nrows + nw - 1) / nw;
  const int r_begin = gw * rpw, r_end = (r_begin + rpw < nrows) ? r_begin + rpw : nrows;
  const bf16_t* __restrict__ y = p.r2;
  const bool has_post = j_post >= 0, has_pre = j_pre >= 0;
  float4 gate[4], gpo[4], shf[4], scl[4], gpr[4];
  int cur_mrow = -1;
  const float* __restrict__ gpost_p = p.g_post + ((size_t)l_post * 3 + (has_post ? j_post : 0)) * DM;
  const float* __restrict__ gpre_p = p.g_pre + ((size_t)(has_pre ? l_pre : 0) * 3 + (has_pre ? j_pre : 0)) * DM;
#pragma unroll
  for (int c = 0; c < 4; ++c) {
    gpo[c] = has_post ? *(const float4*)(gpost_p + c * 256 + lane * 4) : make_float4(0.f, 0.f, 0.f, 0.f);
    gpr[c] = has_pre ? *(const float4*)(gpre_p + c * 256 + lane * 4) : make_float4(0.f, 0.f, 0.f, 0.f);
    gate[c] = shf[c] = scl[c] = make_float4(0.f, 0.f, 0.f, 0.f);
  }
  float4 xn[4];
  u32x2 yn[4];
#define RP_ROW(ri, R, bb, tt)                                              \
  const int R = lat_only ? (((ri) >> 12) * NT + 256 + ((ri) & 4095)) : (ri); \
  const int bb = R / NT, tt = R - bb * NT;
#define RP_SRC(bb, tt, ptr)                                                                       \
  const float* ptr;                                                                               \
  if ((tt) < 256) ptr = (src_inputs ? p.ctx : p.xctx) + ((size_t)(bb) * 256 + (tt)) * DM;        \
  else ptr = (src_inputs ? p.x : p.out) + ((size_t)(bb) * 4096 + ((tt) - 256)) * DM;
  if (r_begin < r_end) {
    RP_ROW(r_begin, R0, b0, t0)
    RP_SRC(b0, t0, s0)
#pragma unroll
    for (int c = 0; c < 4; ++c) {
      xn[c] = *(const float4*)(s0 + c * 256 + lane * 4);
      if (has_post) yn[c] = *(const u32x2*)(y + (size_t)R0 * DM + c * 256 + lane * 4);
    }
  }
  for (int ri = r_begin; ri < r_end; ++ri) {
    RP_ROW(ri, R, b, t)
    const bool isctx = t < 256;
    const int mrow = isctx ? 8 : b;
    float* dst = isctx ? p.xctx + ((size_t)b * 256 + t) * DM : p.out + ((size_t)b * 4096 + (t - 256)) * DM;
    float xv[16], yv[16];
#pragma unroll
    for (int c = 0; c < 4; ++c) {
      xv[c * 4 + 0] = xn[c].x; xv[c * 4 + 1] = xn[c].y; xv[c * 4 + 2] = xn[c].z; xv[c * 4 + 3] = xn[c].w;
      yv[c * 4 + 0] = __uint_as_float(yn[c][0] << 16);
      yv[c * 4 + 1] = __uint_as_float(yn[c][0] & 0xffff0000u);
      yv[c * 4 + 2] = __uint_as_float(yn[c][1] << 16);
      yv[c * 4 + 3] = __uint_as_float(yn[c][1] & 0xffff0000u);
    }
    if (ri + 1 < r_end) {
      RP_ROW(ri + 1, Rn, bn, tn)
      RP_SRC(bn, tn, sn)
#pragma unroll
      for (int c = 0; c < 4; ++c) {
        xn[c] = *(const float4*)(sn + c * 256 + lane * 4);
        if (has_post) yn[c] = *(const u32x2*)(y + (size_t)Rn * DM + c * 256 + lane * 4);
      }
    }
    if (mrow != cur_mrow) {
      cur_mrow = mrow;
      const float* mpo = p.mods + ((size_t)l_post * 9 + mrow) * 9216 + (3 * (has_post ? j_post : 0) + 2) * DM;
      const float* mpr = p.mods + ((size_t)(has_pre ? l_pre : 0) * 9 + mrow) * 9216 + (3 * (has_pre ? j_pre : 0)) * DM;
#pragma unroll
      for (int c = 0; c < 4; ++c) {
        if (has_post) gate[c] = *(const float4*)(mpo + c * 256 + lane * 4);
        if (has_pre) {
          shf[c] = *(const float4*)(mpr + c * 256 + lane * 4);
          scl[c] = *(const float4*)(mpr + DM + c * 256 + lane * 4);
        }
      }
    }
    if (has_post) {
      float ss = 0.f;
#pragma unroll
      for (int q = 0; q < 16; ++q) ss += yv[q] * yv[q];
      ss = wave_sum(ss);
      const float rstd = rsqrtf(ss * (1.f / DM) + EPS) * wres;
#pragma unroll
      for (int c = 0; c < 4; ++c) {
        xv[c * 4 + 0] += gate[c].x * yv[c * 4 + 0] * rstd * gpo[c].x;
        xv[c * 4 + 1] += gate[c].y * yv[c * 4 + 1] * rstd * gpo[c].y;
        xv[c * 4 + 2] += gate[c].z * yv[c * 4 + 2] * rstd * gpo[c].z;
        xv[c * 4 + 3] += gate[c].w * yv[c * 4 + 3] * rstd * gpo[c].w;
        *(float4*)(dst + c * 256 + lane * 4) = make_float4(xv[c * 4 + 0], xv[c * 4 + 1], xv[c * 4 + 2], xv[c * 4 + 3]);
      }
    }
    if (has_pre) {
      float ss = 0.f;
#pragma unroll
      for (int q = 0; q < 16; ++q) ss += xv[q] * xv[q];
      ss = wave_sum(ss);
      const float rstd = rsqrtf(ss * (1.f / DM) + EPS);
#pragma unroll
      for (int c = 0; c < 4; ++c) {
        float h0 = xv[c * 4 + 0] * rstd * gpr[c].x * (1.f + scl[c].x) + shf[c].x;
        float h1 = xv[c * 4 + 1] * rstd * gpr[c].y * (1.f + scl[c].y) + shf[c].y;
        float h2 = xv[c * 4 + 2] * rstd * gpr[c].z * (1.f + scl[c].z) + shf[c].z;
        float h3 = xv[c * 4 + 3] * rstd * gpr[c].w * (1.f + scl[c].w) + shf[c].w;
        u32x2 o;
        o[0] = pack2(h0, h1);
        o[1] = pack2(h2, h3);
        *(u32x2*)(p.h + (size_t)R * DM + c * 256 + lane * 4) = o;
      }
    }
  }
#undef RP_ROW
#undef RP_SRC
}

enum { EPI_SWIGLU = 0, EPI_Y = 1, EPI_WIN = 2, EPI_UQ = 3, EPI_UKV = 4 };

DI void gemm_mainloop(const bf16_t* __restrict__ A, int lda, const bf16_t* __restrict__ Bt, int ldb, int K, char* smem,
                      f32x16 (&acc)[4][2]) {
  const int tid = otid(), lane = tid & 63, w = tid >> 6, wm = w >> 2, wn = w & 3, r = lane & 31, hh = lane >> 5;
  const int lc = tid & 7, lr = tid >> 3;
  const bf16_t* ap = A + (size_t)lr * lda + lc * 8;
  const bf16_t* bp = Bt + (size_t)lr * ldb + lc * 8;
  const int st_off = lr * 128 + ((lc ^ ((lr >> 1) & 7)) << 4);
  u32x4 ra[4], rb[4];
#pragma unroll
  for (int i = 0; i < 4; ++i)
#pragma unroll
    for (int j = 0; j < 2; ++j)
#pragma unroll
      for (int e = 0; e < 16; ++e) acc[i][j][e] = 0.f;
  const int nk = K >> 6;
#pragma unroll
  for (int i = 0; i < 4; ++i) {
    ra[i] = *(const u32x4*)(ap + (size_t)i * 64 * lda);
    rb[i] = *(const u32x4*)(bp + (size_t)i * 64 * ldb);
  }
#pragma unroll
  for (int i = 0; i < 4; ++i) {
    *(u32x4*)(smem + st_off + i * 8192) = ra[i];
    *(u32x4*)(smem + 32768 + st_off + i * 8192) = rb[i];
  }
  __syncthreads();
  const int sw = (r >> 1) & 7;
#pragma unroll 1
  for (int kt = 0; kt < nk; ++kt) {
    char* cur = smem + (kt & 1) * 65536;
    const bool more = (kt + 1 < nk);
    if (more) {
      ap += 64;
      bp += 64;
#pragma unroll
      for (int i = 0; i < 4; ++i) {
        ra[i] = *(const u32x4*)(ap + (size_t)i * 64 * lda);
        rb[i] = *(const u32x4*)(bp + (size_t)i * 64 * ldb);
      }
    }
    const char* abase = cur + (wm * 128 + r) * 128;
    const char* bbase = cur + 32768 + (wn * 64 + r) * 128;
#pragma unroll
    for (int ks = 0; ks < 4; ++ks) {
      const int off = (((2 * ks + hh) ^ sw) << 4);
      bf16x8 af[4], bfr[2];
#pragma unroll
      for (int i = 0; i < 4; ++i) af[i] = *(const bf16x8*)(abase + i * 4096 + off);
#pragma unroll
      for (int j = 0; j < 2; ++j) bfr[j] = *(const bf16x8*)(bbase + j * 4096 + off);
#pragma unroll
      for (int i = 0; i < 4; ++i)
#pragma unroll
        for (int j = 0; j < 2; ++j) acc[i][j] = MFMA32(af[i], bfr[j], acc[i][j]);
    }
    if (more) {
      char* nxt = smem + ((kt + 1) & 1) * 65536;
#pragma unroll
      for (int i = 0; i < 4; ++i) {
        *(u32x4*)(nxt + st_off + i * 8192) = ra[i];
        *(u32x4*)(nxt + 32768 + st_off + i * 8192) = rb[i];
      }
    }
    __syncthreads();
  }
}

DI int lat_tile(int i) { return (i >> 4) * 17 + 1 + (i & 15); }

DI void gemm_tile(const Params& p, char* smem, int mode, int layer, const bf16_t* A, int lda, const bf16_t* Bt,
                          int K, int rt, int ct) {
  f32x16 acc[4][2];
  const int row0 = rt * 256, col0 = ct * 256;
  gemm_mainloop(A + (size_t)row0 * lda, lda, Bt + (size_t)col0 * K, K, K, smem, acc);
  const int tid = otid(), lane = tid & 63, w = tid >> 6, wm = w >> 2, wn = w & 3, r = lane & 31, hh = lane >> 5;
  const int rb = row0 + wm * 128, cb = col0 + wn * 64;
  const int b = row0 / NT;
  const int tb = rb - b * NT;
  if (mode == EPI_SWIGLU) {
    bf16_t* act = p.r1;
    const int oc = ct * 128 + wn * 32 + r;
#pragma unroll
    for (int i = 0; i < 4; ++i)
#pragma unroll
      for (int e = 0; e < 16; ++e) {
        float g = acc[i][0][e], u = acc[i][1][e];
        act[(size_t)(rb + i * 32 + crow(e, hh)) * DFF + oc] = f2bf(silu(g) * u);
      }
  } else if (mode == EPI_Y) {
    bf16_t* y = p.r2;
#pragma unroll
    for (int i = 0; i < 4; ++i)
#pragma unroll
      for (int j = 0; j < 2; ++j)
#pragma unroll
        for (int e = 0; e < 16; ++e)
          y[(size_t)(rb + i * 32 + crow(e, hh)) * DM + cb + j * 32 + r] = f2bf(acc[i][j][e]);
  } else if (mode == EPI_WIN) {
    const bool isAv = (cb >= 512 && cb < 768);
    const bool isBv = (cb >= 1152 && cb < 1280);
    if (isAv || isBv) {
      bf16_t* vt;
      if (isAv) vt = p.r2 + VAT_OFF + (size_t)((b * 4 + (cb - 512) / 64) * 64) * NT;
      else vt = p.r2 + VBT_OFF + (size_t)((b * 2 + (cb - 1152) / 64) * 64) * NT;
#pragma unroll
      for (int i = 0; i < 4; ++i)
#pragma unroll
        for (int j = 0; j < 2; ++j)
#pragma unroll
          for (int e4 = 0; e4 < 4; ++e4) {
            u32x2 o;
            o[0] = pack2(acc[i][j][e4 * 4 + 0], acc[i][j][e4 * 4 + 1]);
            o[1] = pack2(acc[i][j][e4 * 4 + 2], acc[i][j][e4 * 4 + 3]);
            int t = tb + i * 32 + 8 * e4 + 4 * hh;
            *(u32x2*)(vt + (size_t)(j * 32 + r) * NT + t) = o;
          }
    } else {
      bf16_t* pp = p.r1;
#pragma unroll
      for (int i = 0; i < 4; ++i)
#pragma unroll
        for (int j = 0; j < 2; ++j)
#pragma unroll
          for (int e = 0; e < 16; ++e)
            pp[(size_t)(rb + i * 32 + crow(e, hh)) * NIN + cb + j * 32 + r] = f2bf(acc[i][j][e]);
    }
  } else if (mode == EPI_UQ) {
    const float scale = 0.10206207261596577f * LOG2E;
    const bool isctx = tb < 256;
#pragma unroll
    for (int j = 0; j < 2; ++j) {
      const int n0 = cb + j * 32;
      if (n0 >= 384) continue;
      const int head = n0 / 96, seg = (n0 % 96) / 32;
      bf16_t* qd = p.r2 + QD_OFF + (size_t)(b * 4 + head) * NT * 96 + seg * 32 + r;
#pragma unroll
      for (int i = 0; i < 4; ++i)
#pragma unroll
        for (int e = 0; e < 16; ++e) {
          float v = acc[i][j][e];
          const int t = tb + i * 32 + crow(e, hh);
          if (seg == 2) {
            float pr = __shfl_xor(v, 8);
            if (!isctx) {
              const int pos = t - 256;
              const int pa = (r & 16) ? (pos & 63) : (pos >> 6);
              const float cs = p.rope[pa * 8 + (r & 7)], sn = p.rope[512 + pa * 8 + (r & 7)];
              v = v * cs + ((r & 8) ? pr : -pr) * sn;
            }
          }
          qd[(size_t)t * 96] = f2bf(v * scale);
        }
    }
  } else {
#pragma unroll
    for (int j = 0; j < 2; ++j) {
      const int n0 = cb + j * 32;
      const int head = n0 >> 7, wseg = n0 & 127;
      if (wseg < 64) {
        bf16_t* kd = p.r2 + KD_OFF + (size_t)(b * 4 + head) * NT * 96 + wseg + r;
#pragma unroll
        for (int i = 0; i < 4; ++i)
#pragma unroll
          for (int e = 0; e < 16; ++e) kd[(size_t)(tb + i * 32 + crow(e, hh)) * 96] = f2bf(acc[i][j][e]);
      } else {
        bf16_t* vt = p.r2 + VDT_OFF + (size_t)((b * 4 + head) * 64 + (wseg - 64) + r) * NT;
#pragma unroll
        for (int i = 0; i < 4; ++i)
#pragma unroll
          for (int e4 = 0; e4 < 4; ++e4) {
            u32x2 o;
            o[0] = pack2(acc[i][j][e4 * 4 + 0], acc[i][j][e4 * 4 + 1]);
            o[1] = pack2(acc[i][j][e4 * 4 + 2], acc[i][j][e4 * 4 + 3]);
            *(u32x2*)(vt + tb + i * 32 + 16 * (e4 >> 1) + 8 * hh + 4 * (e4 & 1)) = o;
          }
      }
    }
  }
}


using f32x4 = __attribute__((ext_vector_type(4))) float;
typedef __attribute__((address_space(3))) unsigned lds_u32;
DI int lds_byte8(int r, int c) {
  int st = (r >> 4) * 2 + (c >> 5), rr = r & 15, cc = c & 31, ob = rr * 64 + cc * 2;
  return st * 1024 + (ob ^ (((ob >> 9) & 1) << 5));
}
DI void stage_rc8(int b, int& R, int& C) {
  int st = b / 1024, sb = b % 1024, swz = sb ^ (((sb >> 9) & 1) << 5);
  R = (st >> 1) * 16 + swz / 64;
  C = (st & 1) * 32 + (swz % 64) / 2;
}
#define G8_HT 16384
#define G8_SA(b, h) (smem + ((b) * 2 + (h)) * G8_HT)
#define G8_SB(b, h) (smem + (4 + (b) * 2 + (h)) * G8_HT)
#define G8_STAGE(P, BASE, goff0, goff1, ld, br, kt)                                                              \
  do {                                                                                                            \
    const bf16_t* _g = (BASE) + (size_t)(br) * (ld) + (size_t)(kt) * 64;                                          \
    __builtin_amdgcn_global_load_lds((const unsigned*)(_g + goff0), (lds_u32*)((P) + tid * 16), 16, 0, 0);        \
    __builtin_amdgcn_global_load_lds((const unsigned*)(_g + goff1), (lds_u32*)((P) + tid * 16 + 8192), 16, 0, 0); \
  } while (0)
#define G8_LDA(dst, b, h)                                                                                 \
  _Pragma("unroll") for (int m = 0; m < 4; ++m) _Pragma("unroll") for (int k = 0; k < 2; ++k) dst[m][k] = \
      *(const bf16x8*)(G8_SA(b, h) + lds_byte8(wr * 64 + m * 16 + fr, k * 32 + fq * 8))
#define G8_LDB(dst, b, h)                                                                                 \
  _Pragma("unroll") for (int n = 0; n < 2; ++n) _Pragma("unroll") for (int k = 0; k < 2; ++k) dst[n][k] = \
      *(const bf16x8*)(G8_SB(b, h) + lds_byte8(wc * 32 + n * 16 + fr, k * 32 + fq * 8))
#define G8_MMA(ai, bj, AT, BX)                                                                         \
  do {                                                                                                 \
    __builtin_amdgcn_s_setprio(1);                                                                     \
    _Pragma("unroll") for (int m = 0; m < 4; ++m) _Pragma("unroll") for (int n = 0; n < 2; ++n)        \
        _Pragma("unroll") for (int k = 0; k < 2; ++k) acc[ai][bj][m][n] =                              \
            __builtin_amdgcn_mfma_f32_16x16x32_bf16(AT[m][k], BX[n][k], acc[ai][bj][m][n], 0, 0, 0);   \
    __builtin_amdgcn_s_setprio(0);                                                                     \
  } while (0)
#define G8_WAIT_V(n) asm volatile("s_waitcnt vmcnt(" #n ")" ::: "memory")
#define G8_WAIT_L(n) asm volatile("s_waitcnt lgkmcnt(" #n ")" ::: "memory")
#define G8_BAR __builtin_amdgcn_s_barrier()
#define G8_SCHED __builtin_amdgcn_sched_barrier(0)

DI void gemm8_mainloop(const bf16_t* __restrict__ A, int lda, const bf16_t* __restrict__ Bt, int ldb, int K,
                       __attribute__((address_space(3))) char* smem, f32x4 (&acc)[2][2][4][2]) {
  const int tid = otid();
  const int wid = tid >> 6, lane = tid & 63, wr = wid >> 2, wc = wid & 3, fr = lane & 15, fq = lane >> 4;
  int r0, c0, r1, c1;
  stage_rc8(tid * 16, r0, c0);
  stage_rc8(tid * 16 + 8192, r1, c1);
  const int ga0 = r0 * lda + c0, ga1 = r1 * lda + c1, gb0 = r0 * ldb + c0, gb1 = r1 * ldb + c1;
#pragma unroll
  for (int a = 0; a < 2; ++a)
#pragma unroll
    for (int b = 0; b < 2; ++b)
#pragma unroll
      for (int m = 0; m < 4; ++m)
#pragma unroll
        for (int n = 0; n < 2; ++n) acc[a][b][m][n] = (f32x4){0.f, 0.f, 0.f, 0.f};
  bf16x8 At[4][2], B0[2][2], B1[2][2];
  const int nt = K >> 6;
  G8_WAIT_V(0);
  G8_STAGE(G8_SB(0, 0), Bt, gb0, gb1, ldb, 0, 0);
  G8_STAGE(G8_SA(0, 0), A, ga0, ga1, lda, 0, 0);
  G8_STAGE(G8_SB(0, 1), Bt, gb0, gb1, ldb, 128, 0);
  G8_STAGE(G8_SA(0, 1), A, ga0, ga1, lda, 128, 0);
  if (wr == 1) G8_BAR;
  G8_WAIT_V(4); G8_BAR;
  G8_STAGE(G8_SB(1, 0), Bt, gb0, gb1, ldb, 0, 1);
  G8_STAGE(G8_SA(1, 0), A, ga0, ga1, lda, 0, 1);
  G8_STAGE(G8_SB(1, 1), Bt, gb0, gb1, ldb, 128, 1);
  G8_WAIT_V(6); G8_BAR;
#pragma unroll 1
  for (int t = 0; t < nt - 2; t += 2) {
    G8_LDB(B0, 0, 0); G8_SCHED; G8_LDA(At, 0, 0); G8_STAGE(G8_SA(1, 1), A, ga0, ga1, lda, 128, t + 1);
    G8_WAIT_L(8); G8_BAR; G8_WAIT_L(0); G8_MMA(0, 0, At, B0); G8_BAR; G8_SCHED;
    G8_LDB(B1, 0, 1); G8_STAGE(G8_SB(0, 0), Bt, gb0, gb1, ldb, 0, t + 2);
    G8_BAR; G8_WAIT_L(0); G8_MMA(0, 1, At, B1); G8_BAR;
    G8_LDA(At, 0, 1); G8_STAGE(G8_SA(0, 0), A, ga0, ga1, lda, 0, t + 2);
    G8_BAR; G8_WAIT_L(0); G8_MMA(1, 0, At, B0); G8_BAR; G8_SCHED;
    G8_STAGE(G8_SB(0, 1), Bt, gb0, gb1, ldb, 128, t + 2);
    G8_WAIT_V(6); G8_BAR; G8_MMA(1, 1, At, B1); G8_BAR;
    G8_LDB(B0, 1, 0); G8_SCHED; G8_LDA(At, 1, 0); G8_STAGE(G8_SA(0, 1), A, ga0, ga1, lda, 128, t + 2);
    G8_WAIT_L(8); G8_BAR; G8_WAIT_L(0); G8_MMA(0, 0, At, B0); G8_BAR; G8_SCHED;
    G8_LDB(B1, 1, 1); G8_STAGE(G8_SB(1, 0), Bt, gb0, gb1, ldb, 0, t + 3);
    G8_BAR; G8_WAIT_L(0); G8_MMA(0, 1, At, B1); G8_BAR;
    G8_LDA(At, 1, 1); G8_STAGE(G8_SA(1, 0), A, ga0, ga1, lda, 0, t + 3);
    G8_BAR; G8_WAIT_L(0); G8_MMA(1, 0, At, B0); G8_BAR; G8_SCHED;
    G8_STAGE(G8_SB(1, 1), Bt, gb0, gb1, ldb, 128, t + 3);
    G8_WAIT_V(6); G8_BAR; G8_MMA(1, 1, At, B1); G8_BAR;
  }
  {
    G8_LDB(B0, 0, 0); G8_LDA(At, 0, 0); G8_STAGE(G8_SA(1, 1), A, ga0, ga1, lda, 128, nt - 1);
    G8_BAR; G8_WAIT_L(0); G8_MMA(0, 0, At, B0); G8_BAR;
    G8_LDB(B1, 0, 1); G8_BAR; G8_WAIT_L(0); G8_MMA(0, 1, At, B1); G8_BAR;
    G8_LDA(At, 0, 1); G8_WAIT_V(4); G8_BAR; G8_WAIT_L(0); G8_MMA(1, 0, At, B0); G8_MMA(1, 1, At, B1); G8_BAR;
  }
  {
    G8_LDB(B0, 1, 0); G8_LDA(At, 1, 0); G8_WAIT_V(2); G8_BAR; G8_WAIT_L(0); G8_MMA(0, 0, At, B0); G8_BAR;
    G8_LDB(B1, 1, 1); G8_WAIT_V(0); G8_BAR; G8_WAIT_L(0); G8_MMA(0, 1, At, B1); G8_BAR;
    G8_LDA(At, 1, 1); G8_BAR; G8_WAIT_L(0); G8_MMA(1, 0, At, B0); G8_MMA(1, 1, At, B1); G8_BAR;
  }
  if (wr == 0) G8_BAR;
}

DI void gemm8_tile(const Params& p, char* smem_g, int mode, const bf16_t* A, int lda, const bf16_t* Bt, int K, int rt,
                   int ct) {
  f32x4 acc[2][2][4][2];
  const int row0 = rt * 256, col0 = ct * 256;
  gemm8_mainloop(A + (size_t)row0 * lda, lda, Bt + (size_t)col0 * K, K, K,
                 (__attribute__((address_space(3))) char*)smem_g, acc);
  const int tid = otid();
  const int wid = tid >> 6, lane = tid & 63, wr = wid >> 2, wc = wid & 3, fr = lane & 15, fq = lane >> 4;
  const int b = row0 / NT;
  const int rw = row0 + wr * 64 + fq * 4;
  if (mode == EPI_SWIGLU) {
    bf16_t* act = p.r1;
#pragma unroll
    for (int ai = 0; ai < 2; ++ai)
#pragma unroll
      for (int m = 0; m < 4; ++m)
#pragma unroll
        for (int n = 0; n < 2; ++n)
#pragma unroll
          for (int j = 0; j < 4; ++j) {
            float g = acc[ai][0][m][n][j], u = acc[ai][1][m][n][j];
            act[(size_t)(rw + ai * 128 + m * 16 + j) * DFF + ct * 128 + wc * 32 + n * 16 + fr] = f2bf(silu(g) * u);
          }
  } else if (mode == EPI_Y) {
    bf16_t* y = p.r2;
#pragma unroll
    for (int ai = 0; ai < 2; ++ai)
#pragma unroll
      for (int bj = 0; bj < 2; ++bj)
#pragma unroll
        for (int m = 0; m < 4; ++m)
#pragma unroll
          for (int n = 0; n < 2; ++n)
#pragma unroll
            for (int j = 0; j < 4; ++j)
              y[(size_t)(rw + ai * 128 + m * 16 + j) * DM + col0 + bj * 128 + wc * 32 + n * 16 + fr] =
                  f2bf(acc[ai][bj][m][n][j]);
  } else {
    const int tw16 = row0 - b * NT + wr * 64 + (((fq & 1) << 1) | (fq >> 1)) * 4;
#pragma unroll
    for (int bj = 0; bj < 2; ++bj) {
      const int cb = col0 + bj * 128 + wc * 32;
      const bool isAv = (cb >= 512 && cb < 768);
      const bool isBv = (cb >= 1152 && cb < 1280);
      if (isAv || isBv) {
        bf16_t* vt;
        if (isAv) vt = p.r2 + VAT_OFF + (size_t)((b * 4 + (cb - 512) / 64) * 64 + (cb & 32)) * NT;
        else vt = p.r2 + VBT_OFF + (size_t)((b * 2 + (cb - 1152) / 64) * 64 + (cb & 32)) * NT;
#pragma unroll
        for (int ai = 0; ai < 2; ++ai)
#pragma unroll
          for (int m = 0; m < 4; ++m)
#pragma unroll
            for (int n = 0; n < 2; ++n) {
              u32x2 o;
              o[0] = pack2(acc[ai][bj][m][n][0], acc[ai][bj][m][n][1]);
              o[1] = pack2(acc[ai][bj][m][n][2], acc[ai][bj][m][n][3]);
              *(u32x2*)(vt + (size_t)(n * 16 + fr) * NT + tw16 + ai * 128 + m * 16) = o;
            }
      } else {
        bf16_t* pp = p.r1;
#pragma unroll
        for (int ai = 0; ai < 2; ++ai)
#pragma unroll
          for (int m = 0; m < 4; ++m)
#pragma unroll
            for (int n = 0; n < 2; ++n)
#pragma unroll
              for (int j = 0; j < 4; ++j)
                pp[(size_t)(rw + ai * 128 + m * 16 + j) * NIN + cb + n * 16 + fr] = f2bf(acc[ai][bj][m][n][j]);
      }
    }
  }
}

DI int xcd_vb(int bid, int nblk) {
  if (nblk & 7) return bid;
  return (bid & 7) * (nblk >> 3) + (bid >> 3);
}

DI void phase_gemm(const Params& p, char* smem, int bid, int nblk, int mode, int layer, const bf16_t* A, int lda,
                           const bf16_t* Bt, int K, int nct, bool lat_only) {
  const int nrt = lat_only ? 128 : 136;
  const int total = nrt * nct;
  for (int t = xcd_vb(bid, nblk); t < total; t += nblk) {
    int rti = t / nct, ct = t - rti * nct;
    int rt = lat_only ? lat_tile(rti) : rti;
    gemm8_tile(p, smem, mode, A, lda, Bt, K, rt, ct);
  }
}

DI void phase_rowprep(const Params& p, int bid, int nblk, int l) {
  const int tid = otid(); const int lane = tid & 63, w = tid >> 6;
  const int gw = bid * 8 + w, nw = nblk * 8;
  const float* __restrict__ ropeAc = p.rope;
  const float* __restrict__ ropeAs = p.rope + 512;
  const float* __restrict__ ropeBc = p.rope + 1024;
  const float* __restrict__ ropeBs = p.rope + 2048;
  const float gqn = p.g_qnorm[l * 64 + lane], gkn = p.g_knorm[l * 64 + lane];
  float lng[4], lnb[4], gqa[4], gkva[2];
#pragma unroll
  for (int i = 0; i < 4; ++i) {
    lng[i] = p.ln_g[l * 256 + i * 64 + lane];
    lnb[i] = p.ln_b[l * 256 + i * 64 + lane];
    gqa[i] = p.g_q_a[l * 256 + i * 64 + lane];
  }
  gkva[0] = p.g_kv_a[l * 128 + lane];
  gkva[1] = p.g_kv_a[l * 128 + 64 + lane];
  const float scaleA = 0.17677669529663687f * LOG2E;
  const float scaleB = 0.125f * LOG2E;
  bf16_t* __restrict__ qkv = p.r2;
  const int rpw = (MROWS + nw - 1) / nw;
  const int r_begin = gw * rpw, r_end = (r_begin + rpw < MROWS) ? r_begin + rpw : MROWS;
  float na[8], nb_[6], nc[8], nd[6], nkr = 0.f;
#define RPREP_LOAD(Rr)                                                                   \
  do {                                                                                   \
    const bf16_t* _P = p.r1 + (size_t)(Rr) * NIN;                                        \
    _Pragma("unroll") for (int i = 0; i < 8; ++i) na[i] = bf2f(_P[i * 64 + lane]);       \
    _Pragma("unroll") for (int i = 0; i < 6; ++i) nb_[i] = bf2f(_P[768 + i * 64 + lane]); \
    _Pragma("unroll") for (int i = 0; i < 8; ++i) nc[i] = bf2f(_P[1280 + i * 64 + lane]); \
    _Pragma("unroll") for (int i = 0; i < 6; ++i) nd[i] = bf2f(_P[1792 + i * 64 + lane]); \
    nkr = bf2f(_P[2176 + (lane & 31)]);                                                  \
  } while (0)
  if (r_begin < r_end) RPREP_LOAD(r_begin);
  for (int R = r_begin; R < r_end; ++R) {
    const int b = R / NT, t = R - b * NT;
    const bool isctx = t < 256;
    const int pos = t - 256;
    const int prow = pos >> 6, pcol = pos & 63;
    bf16_t* P = p.r1 + (size_t)R * NIN;
    float va[8], vb[6], vc[8], vd[6], vkr;
#pragma unroll
    for (int i = 0; i < 8; ++i) { va[i] = na[i]; vc[i] = nc[i]; }
#pragma unroll
    for (int i = 0; i < 6; ++i) { vb[i] = nb_[i]; vd[i] = nd[i]; }
    vkr = nkr;
    if (R + 1 < r_end) RPREP_LOAD(R + 1);
    {
      const int d = lane & 31;
      const int pa = (d & 16) ? pcol : prow;
      float cs = 1.f, sn = 0.f;
      if (!isctx) { cs = ropeAc[pa * 8 + (d & 7)]; sn = ropeAs[pa * 8 + (d & 7)]; }
      const float sg = (d & 8) ? sn : -sn;
#pragma unroll
      for (int i = 0; i < 4; ++i) {
        const int hm = (i * 64 + lane) >> 5;
        float vq = va[i], vk = va[4 + i];
        float pq = __shfl_xor(vq, 8), pk = __shfl_xor(vk, 8);
        vq = vq * cs + sg * pq;
        vk = vk * cs + sg * pk;
        size_t o = ((size_t)(b * 8 + hm) * NT + t) * 32 + d;
        qkv[QA_OFF + o] = f2bf(vq * scaleA);
        qkv[KA_OFF + o] = f2bf(vk);
      }
    }
    {
      const int d = lane;
      const int pa = (d & 32) ? pcol : prow;
      float cs = 1.f, sn = 0.f;
      if (!isctx) { cs = ropeBc[pa * 16 + (d & 15)]; sn = ropeBs[pa * 16 + (d & 15)]; }
      const float sg = (d & 16) ? sn : -sn;
      float ss[6];
#pragma unroll
      for (int i = 0; i < 6; ++i) ss[i] = vb[i] * vb[i];
#pragma unroll
      for (int o = 32; o >= 1; o >>= 1)
#pragma unroll
        for (int i = 0; i < 6; ++i) ss[i] += __shfl_xor(ss[i], o);
#pragma unroll
      for (int i = 0; i < 6; ++i) {
        float v = vb[i] * rsqrtf(ss[i] * (1.f / 64.f) + EPS) * (i < 4 ? gqn : gkn);
        float pr = __shfl_xor(v, 16);
        v = v * cs + sg * pr;
        if (i < 4) qkv[QB_OFF + ((size_t)(b * 4 + i) * NT + t) * 64 + d] = f2bf(v * scaleB);
        else qkv[KB_OFF + ((size_t)(b * 2 + (i - 4)) * NT + t) * 64 + d] = f2bf(v);
      }
    }
    {
      float s1 = 0.f, sq = 0.f, skv = 0.f;
#pragma unroll
      for (int i = 0; i < 4; ++i) {
        vc[i] = gelu_tanh(vc[i]);
        vc[4 + i] = gelu_tanh(vc[4 + i]);
        s1 += vc[4 + i];
        sq += vd[i] * vd[i];
      }
      skv = vd[4] * vd[4] + vd[5] * vd[5];
#pragma unroll
      for (int o = 32; o >= 1; o >>= 1) {
        s1 += __shfl_xor(s1, o);
        sq += __shfl_xor(sq, o);
        skv += __shfl_xor(skv, o);
      }
      const float mu = s1 * (1.f / 256.f);
      float s2 = 0.f;
#pragma unroll
      for (int i = 0; i < 4; ++i) { vc[4 + i] -= mu; s2 += vc[4 + i] * vc[4 + i]; }
      s2 = wave_sum(s2);
      const float rln = rsqrtf(s2 * (1.f / 256.f) + EPS);
      const float rq = rsqrtf(sq * (1.f / 256.f) + EPS);
      const float rkv = rsqrtf(skv * (1.f / 128.f) + EPS);
#pragma unroll
      for (int i = 0; i < 4; ++i) {
        P[1280 + i * 64 + lane] = f2bf(vc[i]);
        P[1536 + i * 64 + lane] = f2bf(vc[4 + i] * rln * lng[i] + lnb[i]);
        P[1792 + i * 64 + lane] = f2bf(vd[i] * rq * gqa[i]);
      }
      P[2048 + lane] = f2bf(vd[4] * rkv * gkva[0]);
      P[2048 + 64 + lane] = f2bf(vd[5] * rkv * gkva[1]);
    }
    {
      const int d = lane & 31;
      float kr = vkr;
      float pr = __shfl_xor(kr, 8);
      if (!isctx) {
        const int pa = (d & 16) ? pcol : prow;
        kr = kr * ropeAc[pa * 8 + (d & 7)] + ((d & 8) ? pr : -pr) * ropeAs[pa * 8 + (d & 7)];
      }
      if (lane < 32) {
        const bf16_t kb = f2bf(kr);
#pragma unroll
        for (int hd = 0; hd < 4; ++hd) qkv[KD_OFF + ((size_t)(b * 4 + hd) * NT + t) * 96 + 64 + d] = kb;
      }
    }
  }
}

#undef RPREP_LOAD
DI void gmlp_item(const Params& p, char* smem, int l, int ch, int g) {
  const int tid = otid(), lane = tid & 63, w = tid >> 6, r = lane & 31, hh = lane >> 5;
  const int R0 = ch * 128;
  bf16_t* vT = (bf16_t*)smem;
#pragma unroll
  for (int u = 0; u < 2; ++u) {
    const int cid = tid + u * NTHREADS;
    const int q = cid >> 3, cc = cid & 7;
    u32x4 v = *(const u32x4*)(p.r1 + (size_t)(R0 + q) * NIN + 1536 + g * 64 + cc * 8);
#pragma unroll
    for (int j = 0; j < 4; ++j) {
      vT[(cc * 8 + 2 * j) * 136 + q] = (bf16_t)(v[j] & 0xffffu);
      vT[(cc * 8 + 2 * j + 1) * 136 + q] = (bf16_t)(v[j] >> 16);
    }
  }
  __syncthreads();
  const int wp = w >> 1, wc = w & 1;
  const bf16_t* wsp = p.wts + (size_t)l * LAYER_W + OFF_WSP + (size_t)g * 16384;
  f32x16 acc;
#pragma unroll
  for (int e = 0; e < 16; ++e) acc[e] = 0.f;
#pragma unroll
  for (int ks = 0; ks < 8; ++ks) {
    bf16x8 a = *(const bf16x8*)(wsp + (wp * 32 + r) * 128 + ks * 16 + hh * 8);
    bf16x8 bb = *(const bf16x8*)(vT + (wc * 32 + r) * 136 + ks * 16 + hh * 8);
    acc = MFMA32(a, bb, acc);
  }
  const int c = g * 64 + wc * 32 + r;
#pragma unroll
  for (int e = 0; e < 16; ++e) {
    const int pp = wp * 32 + crow(e, hh);
    const float u = bf2f(p.r1[(size_t)(R0 + pp) * NIN + 1280 + c]);
    const float mixed = acc[e] + p.b_spatial[(size_t)l * 512 + g * 128 + pp];
    p.h[(size_t)(R0 + pp) * DM + 512 + c] = f2bf(u * mixed);
  }
  __syncthreads();
}

DI void phase_dexp_gmlp(const Params& p, char* smem, int bid, int nblk, int l) {
  const bool lat_only = (l == 1);
  const bf16_t* wl = p.wts + (size_t)l * LAYER_W;
  const int nch = lat_only ? 256 : 272;
  const int total = 272 + 272 + nch * 4;
  for (int t = xcd_vb(bid, nblk); t < total; t += nblk) {
    if (t < 272) {
      gemm_tile(p, smem, EPI_UQ, l, p.r1 + 1792, NIN, wl + OFF_WUQ, 256, t >> 1, t & 1);
    } else if (t < 544) {
      int u = t - 272;
      gemm_tile(p, smem, EPI_UKV, l, p.r1 + 2048, NIN, wl + OFF_WUKV, 128, u >> 1, u & 1);
    } else {
      int u = t - 544;
      int ci = u >> 2, g = u & 3;
      int ch = lat_only ? ((ci >> 5) * 34 + 2 + (ci & 31)) : ci;
      gmlp_item(p, smem, l, ch, g);
    }
  }
}

template <int CPR>
DI int kswz(int c, int row) {
  if (CPR == 4) return c ^ ((row >> 2) & 3);
  if (CPR == 8) return c ^ ((row >> 1) & 7);
  return (c & 12) | ((c & 3) ^ ((row >> 2) & 3));
}

template <int DQK, int NMAP>
DI void attn_item(const bf16_t* __restrict__ Qb, const bf16_t* __restrict__ Kb, const bf16_t* __restrict__ Vt,
                  int q0, int nkeys, bf16_t* __restrict__ outp, char* smem_g, float lam, float post_scale,
                  const float* __restrict__ g_subln) {
  typedef __attribute__((address_space(3))) char lchar;
  lchar* smem = (lchar*)smem_g;
  constexpr int CPR = DQK / 8;
  constexpr int KMAPB = 64 * CPR * 16;
  constexpr int KBYTES = NMAP * KMAPB;
  constexpr int STAGE = KBYTES + 8192;
  constexpr int NS = 5;
  constexpr int NKS = KBYTES / 16;
  constexpr int GK = (NKS + NTHREADS - 1) / NTHREADS;
  constexpr int KK = DQK / 16;
  constexpr float THR = 6.0f;
  const int tid = otid();
  const int lane = tid & 63, w = tid >> 6, r = lane & 31, hh = lane >> 5;

  asm volatile("s_waitcnt vmcnt(0)" ::: "memory");
  __builtin_amdgcn_s_barrier();
  asm volatile("" ::: "memory");

  bf16x8 qf[NMAP][KK];
  {
    const int qrow = q0 + w * 32 + r;
#pragma unroll
    for (int m = 0; m < NMAP; ++m)
#pragma unroll
      for (int kk = 0; kk < KK; ++kk)
        qf[m][kk] = *(const bf16x8*)(Qb + (size_t)m * NT * DQK + (size_t)qrow * DQK + kk * 16 + hh * 8);
  }
  const bf16_t* ksrc[GK];
  int kslot[GK];
#pragma unroll
  for (int u = 0; u < GK; ++u) {
    int sl = tid + u * NTHREADS;
    if (sl >= NKS) sl = tid;
    const int m = sl / (64 * CPR), rem = sl % (64 * CPR), row = rem / CPR, cp = rem % CPR;
    const int c = kswz<CPR>(cp, row);
    ksrc[u] = Kb + (size_t)m * NT * DQK + (size_t)row * DQK + c * 8;
    kslot[u] = sl * 16;
  }
  const int vrow = tid >> 3, vcp = tid & 7;
  const bf16_t* vsrc = Vt + (size_t)vrow * NT + ((vcp ^ ((vrow >> 1) & 7)) * 8);
  const int vslot = KBYTES + tid * 16;
  const int nt = nkeys >> 6;

#define ATT_ISSUE(tile, stoff)                                                                                    \
  do {                                                                                                            \
    const int _tl = (tile) < nt ? (tile) : nt - 1;                                                                \
    lchar* _st = smem + (stoff);                                                                                  \
    _Pragma("unroll") for (int u = 0; u < GK; ++u) __builtin_amdgcn_global_load_lds(                              \
        (const unsigned*)(ksrc[u] + (size_t)_tl * 64 * DQK), (lds_u32*)(_st + kslot[u]), 16, 0, 0);                \
    __builtin_amdgcn_global_load_lds((const unsigned*)(vsrc + _tl * 64), (lds_u32*)(_st + vslot), 16, 0, 0);      \
  } while (0)
#define ATT_WAITG()                                                    \
  do {                                                                 \
    if (GK == 1) asm volatile("s_waitcnt vmcnt(2)" ::: "memory");      \
    else asm volatile("s_waitcnt vmcnt(3)" ::: "memory");              \
  } while (0)

  f32x16 O[NMAP][2];
  float mrun[NMAP], lrun[NMAP];
#pragma unroll
  for (int m = 0; m < NMAP; ++m) {
    mrun[m] = 0.f;
    lrun[m] = 0.f;
#pragma unroll
    for (int d = 0; d < 2; ++d)
#pragma unroll
      for (int e = 0; e < 16; ++e) O[m][d][e] = 0.f;
  }
  const int kq = (r >> 2) & 3, k8 = (r >> 1) & 7;
  const int koff = r * (CPR * 16), voff = r * 128;

#define ATT_QK(Sx, so, m, base)                                                                          \
  do {                                                                                                   \
    _Pragma("unroll") for (int t2 = 0; t2 < 2; ++t2) {                                                   \
      _Pragma("unroll") for (int e = 0; e < 16; ++e) Sx[t2][e] = -(base);                                \
      _Pragma("unroll") for (int kk = 0; kk < KK; ++kk) {                                                \
        const int c = kk * 2 + hh;                                                                       \
        const int cp = (CPR == 8) ? (c ^ k8) : ((c & 12) | ((c & 3) ^ kq));                              \
        bf16x8 a = *(const bf16x8*)(smem + (so) + (m) * KMAPB + t2 * 32 * (CPR * 16) + koff + cp * 16);  \
        Sx[t2] = MFMA32(a, qf[m][kk], Sx[t2]);                                                           \
      }                                                                                                  \
    }                                                                                                    \
  } while (0)
#define ATT_PV(Px, so, m)                                                                                \
  do {                                                                                                   \
    _Pragma("unroll") for (int d = 0; d < 2; ++d) _Pragma("unroll") for (int t2 = 0; t2 < 2; ++t2)       \
        _Pragma("unroll") for (int s2 = 0; s2 < 2; ++s2) {                                               \
      const int c = t2 * 4 + s2 * 2 + hh;                                                                \
      bf16x8 vf = *(const bf16x8*)(smem + (so) + KBYTES + d * 32 * 128 + voff + ((c ^ k8) * 16));        \
      O[m][d] = MFMA32(vf, Px[t2][s2], O[m][d]);                                                         \
    }                                                                                                    \
  } while (0)
#define ATT_SOFTMAX(Sx, sbase, Px, m, first)                                                             \
  do {                                                                                                   \
    float mx = fmaxf(Sx[0][0], Sx[1][0]);                                                                \
    _Pragma("unroll") for (int e = 1; e < 16; ++e) mx = max3f(mx, Sx[0][e], Sx[1][e]);                   \
    mx = fmaxf(mx, __shfl_xor(mx, 32));                                                                  \
    const float drift = mrun[m] - (sbase);                                                               \
    const float mxr = mx - drift;                                                                        \
    const bool up = (first) || (mxr > THR);                                                              \
    if (__builtin_amdgcn_ballot_w64(up || (drift != 0.f)) != 0ull) {                                     \
      const float sh = up ? mxr : 0.f;                                                                   \
      const float alpha = (first) ? 1.f : __builtin_amdgcn_exp2f(-sh);                                   \
      mrun[m] += sh;                                                                                     \
      lrun[m] *= alpha;                                                                                  \
      _Pragma("unroll") for (int d = 0; d < 2; ++d) _Pragma("unroll") for (int e = 0; e < 16; ++e)       \
          O[m][d][e] *= alpha;                                                                           \
      const float tot = drift + sh;                                                                      \
      _Pragma("unroll") for (int t2 = 0; t2 < 2; ++t2) _Pragma("unroll") for (int e = 0; e < 16; ++e)    \
          Sx[t2][e] -= tot;                                                                              \
    }                                                                                                    \
    float sum = 0.f;                                                                                     \
    _Pragma("unroll") for (int t2 = 0; t2 < 2; ++t2) _Pragma("unroll") for (int e = 0; e < 16; ++e) {    \
      float pv = __builtin_amdgcn_exp2f(Sx[t2][e]);                                                      \
      Sx[t2][e] = pv;                                                                                    \
      sum += pv;                                                                                         \
    }                                                                                                    \
    lrun[m] += sum;                                                                                      \
    _Pragma("unroll") for (int t2 = 0; t2 < 2; ++t2) _Pragma("unroll") for (int s2 = 0; s2 < 2; ++s2) {  \
      u32x4 pk;                                                                                          \
      _Pragma("unroll") for (int j = 0; j < 4; ++j)                                                      \
          pk[j] = pack2(Sx[t2][8 * s2 + 2 * j], Sx[t2][8 * s2 + 2 * j + 1]);                             \
      Px[t2][s2] = __builtin_bit_cast(bf16x8, pk);                                                       \
    }                                                                                                    \
  } while (0)

  f32x16 Sa[2], Sb[2];
  bf16x8 Pa[2][2], Pb[2][2];
  float basea = 0.f, baseb = 0.f;
#pragma unroll
  for (int t2 = 0; t2 < 2; ++t2)
#pragma unroll
    for (int s2 = 0; s2 < 2; ++s2) {
      u32x4 z = {0u, 0u, 0u, 0u};
      Pa[t2][s2] = __builtin_bit_cast(bf16x8, z);
      Pb[t2][s2] = __builtin_bit_cast(bf16x8, z);
    }
  ATT_ISSUE(0, 0);
  ATT_ISSUE(1, STAGE);
  ATT_ISSUE(2, 2 * STAGE);
  if (GK == 1) asm volatile("s_waitcnt vmcnt(4)" ::: "memory");
  else asm volatile("s_waitcnt vmcnt(6)" ::: "memory");
  __builtin_amdgcn_s_barrier();
  asm volatile("" ::: "memory");
  ATT_QK(Sa, 0, 0, 0.f);
  int sp = 0, sc = 0, sn = STAGE, si = 3 * STAGE;
#define ATT_ADV()                                         \
  do {                                                    \
    sp = sc; sc = sn;                                     \
    sn = (sn + STAGE == NS * STAGE) ? 0 : sn + STAGE;     \
    si = (si + STAGE == NS * STAGE) ? 0 : si + STAGE;     \
  } while (0)
  if (NMAP == 2) {
#pragma unroll 1
    for (int j = 0; j < nt; ++j) {
      ATT_WAITG();
      __builtin_amdgcn_s_barrier();
      asm volatile("" ::: "memory");
      ATT_ISSUE(j + 3, si);
      baseb = mrun[NMAP - 1];
      ATT_QK(Sb, sc, NMAP - 1, baseb);
      ATT_PV(Pb, sp, NMAP - 1);
      ATT_SOFTMAX(Sa, basea, Pa, 0, (j == 0));
      basea = mrun[0];
      ATT_QK(Sa, sn, 0, basea);
      ATT_PV(Pa, sc, 0);
      ATT_SOFTMAX(Sb, baseb, Pb, NMAP - 1, (j == 0));
      ATT_ADV();
    }
    ATT_PV(Pb, sp, NMAP - 1);
  } else {
#pragma unroll 1
    for (int j = 0; j < nt; j += 2) {
      ATT_WAITG();
      __builtin_amdgcn_s_barrier();
      asm volatile("" ::: "memory");
      ATT_ISSUE(j + 3, si);
      baseb = mrun[0];
      ATT_QK(Sb, sn, 0, baseb);
      ATT_PV(Pb, sp, 0);
      ATT_SOFTMAX(Sa, basea, Pa, 0, (j == 0));
      ATT_ADV();
      ATT_WAITG();
      __builtin_amdgcn_s_barrier();
      asm volatile("" ::: "memory");
      ATT_ISSUE(j + 4, si);
      basea = mrun[0];
      ATT_QK(Sa, sn, 0, basea);
      ATT_PV(Pa, sp, 0);
      ATT_SOFTMAX(Sb, baseb, Pb, 0, false);
      ATT_ADV();
    }
    ATT_PV(Pb, sp, 0);
  }
#undef ATT_ISSUE
#undef ATT_WAITG
#undef ATT_QK
#undef ATT_PV
#undef ATT_SOFTMAX
#undef ATT_ADV
  asm volatile("s_waitcnt vmcnt(0)" ::: "memory");
#pragma unroll
  for (int m = 0; m < NMAP; ++m) lrun[m] += __shfl_xor(lrun[m], 32);
  bf16_t* orow = outp + (size_t)(w * 32 + r) * DM;
  if (NMAP == 1) {
    const float inv = 1.f / lrun[0];
#pragma unroll
    for (int d = 0; d < 2; ++d)
#pragma unroll
      for (int e4 = 0; e4 < 4; ++e4) {
        u32x2 o;
        o[0] = pack2(O[0][d][e4 * 4 + 0] * inv, O[0][d][e4 * 4 + 1] * inv);
        o[1] = pack2(O[0][d][e4 * 4 + 2] * inv, O[0][d][e4 * 4 + 3] * inv);
        *(u32x2*)(orow + d * 32 + 8 * e4 + 4 * hh) = o;
      }
  } else {
    const float i1 = 1.f / lrun[0], i2 = lam / lrun[NMAP - 1];
    float ss = 0.f;
#pragma unroll
    for (int d = 0; d < 2; ++d)
#pragma unroll
      for (int e = 0; e < 16; ++e) {
        float o = O[0][d][e] * i1 - O[NMAP - 1][d][e] * i2;
        O[0][d][e] = o;
        ss += o * o;
      }
    ss += __shfl_xor(ss, 32);
    const float rstd = rsqrtf(ss * (1.f / 64.f) + EPS) * post_scale;
#pragma unroll
    for (int d = 0; d < 2; ++d)
#pragma unroll
      for (int e4 = 0; e4 < 4; ++e4) {
        const int dv = d * 32 + 8 * e4 + 4 * hh;
        u32x2 o;
        o[0] = pack2(O[0][d][e4 * 4 + 0] * rstd * g_subln[dv + 0], O[0][d][e4 * 4 + 1] * rstd * g_subln[dv + 1]);
        o[1] = pack2(O[0][d][e4 * 4 + 2] * rstd * g_subln[dv + 2], O[0][d][e4 * 4 + 3] * rstd * g_subln[dv + 3]);
        *(u32x2*)(orow + dv) = o;
      }
  }
}


template <int DQK>
DI void attn_item_w64(const bf16_t* __restrict__ Qb, const bf16_t* __restrict__ Kb, const bf16_t* __restrict__ Vt,
                      int q0, int nkeys, bf16_t* __restrict__ outp, char* smem_g) {
  typedef __attribute__((address_space(3))) char lchar;
  lchar* smem = (lchar*)smem_g;
  constexpr int CPR = DQK / 8;
  constexpr int KBYTES = 64 * CPR * 16;
  constexpr int STAGE = KBYTES + 8192;
  constexpr int NS = 4;
  constexpr int NKS = KBYTES / 16;
  constexpr int GK = (NKS + NTHREADS - 1) / NTHREADS;
  constexpr int KK = DQK / 16;
  constexpr float THR = 6.0f;
  const int tid = otid();
  const int lane = tid & 63, w = tid >> 6, r = lane & 31, hh = lane >> 5;

  asm volatile("s_waitcnt vmcnt(0)" ::: "memory");
  __builtin_amdgcn_s_barrier();
  asm volatile("" ::: "memory");

  bf16x8 qf[2][KK];
#pragma unroll
  for (int g = 0; g < 2; ++g) {
    const int qrow = q0 + w * 64 + g * 32 + r;
#pragma unroll
    for (int kk = 0; kk < KK; ++kk) qf[g][kk] = *(const bf16x8*)(Qb + (size_t)qrow * DQK + kk * 16 + hh * 8);
  }
  const bf16_t* ksrc[GK];
  int kslot[GK];
#pragma unroll
  for (int u = 0; u < GK; ++u) {
    int sl = tid + u * NTHREADS;
    if (sl >= NKS) sl = tid;
    const int row = sl / CPR, cp = sl % CPR;
    const int c = kswz<CPR>(cp, row);
    ksrc[u] = Kb + (size_t)row * DQK + c * 8;
    kslot[u] = sl * 16;
  }
  const int vrow = tid >> 3, vcp = tid & 7;
  const bf16_t* vsrc = Vt + (size_t)vrow * NT + ((vcp ^ ((vrow >> 1) & 7)) * 8);
  const int vslot = KBYTES + tid * 16;
  const int nt = nkeys >> 6;
#define ATT_ISSUE(tile)                                                                                           \
  do {                                                                                                            \
    const int _tl = (tile) < nt ? (tile) : nt - 1;                                                                \
    lchar* _st = smem + ((tile) & (NS - 1)) * STAGE;                                                              \
    _Pragma("unroll") for (int u = 0; u < GK; ++u) __builtin_amdgcn_global_load_lds(                              \
        (const unsigned*)(ksrc[u] + (size_t)_tl * 64 * DQK), (lds_u32*)(_st + kslot[u]), 16, 0, 0);                \
    __builtin_amdgcn_global_load_lds((const unsigned*)(vsrc + _tl * 64), (lds_u32*)(_st + vslot), 16, 0, 0);      \
  } while (0)
  f32x16 O[2][2];
  float mrun[2], lrun[2];
#pragma unroll
  for (int g = 0; g < 2; ++g) {
    mrun[g] = 0.f;
    lrun[g] = 0.f;
#pragma unroll
    for (int d = 0; d < 2; ++d)
#pragma unroll
      for (int e = 0; e < 16; ++e) O[g][d][e] = 0.f;
  }
  ATT_ISSUE(0);
  ATT_ISSUE(1);
  ATT_ISSUE(2);
  const int kq = (r >> 2) & 3, k8 = (r >> 1) & 7;
#pragma unroll 1
  for (int it = 0; it < nt; ++it) {
    if (GK == 1) asm volatile("s_waitcnt vmcnt(4)" ::: "memory");
    else asm volatile("s_waitcnt vmcnt(6)" ::: "memory");
    __builtin_amdgcn_s_barrier();
    asm volatile("" ::: "memory");
    ATT_ISSUE(it + 3);
    const lchar* cur = smem + (it & (NS - 1)) * STAGE;
    f32x16 S[2][2];
#pragma unroll
    for (int g = 0; g < 2; ++g)
#pragma unroll
      for (int t2 = 0; t2 < 2; ++t2)
#pragma unroll
        for (int e = 0; e < 16; ++e) S[g][t2][e] = -mrun[g];
#pragma unroll
    for (int kk = 0; kk < KK; ++kk)
#pragma unroll
      for (int t2 = 0; t2 < 2; ++t2) {
        const int c = kk * 2 + hh;
        const int cp = (CPR == 8) ? (c ^ k8) : ((c & 12) | ((c & 3) ^ kq));
        bf16x8 a = *(const bf16x8*)(cur + (t2 * 32 + r) * (CPR * 16) + cp * 16);
#pragma unroll
        for (int g = 0; g < 2; ++g) S[g][t2] = MFMA32(a, qf[g][kk], S[g][t2]);
      }
    bf16x8 pb[2][2][2];
#pragma unroll
    for (int g = 0; g < 2; ++g) {
      float mx = fmaxf(S[g][0][0], S[g][1][0]);
#pragma unroll
      for (int e = 1; e < 16; ++e) mx = max3f(mx, S[g][0][e], S[g][1][e]);
      mx = fmaxf(mx, __shfl_xor(mx, 32));
      const bool need = (it == 0) || (mx > THR);
      if (__builtin_amdgcn_ballot_w64(need) != 0ull) {
        const float sh = need ? mx : 0.f;
        const float alpha = (it == 0) ? 1.f : __builtin_amdgcn_exp2f(-sh);
        mrun[g] += sh;
        lrun[g] *= alpha;
#pragma unroll
        for (int d = 0; d < 2; ++d)
#pragma unroll
          for (int e = 0; e < 16; ++e) O[g][d][e] *= alpha;
#pragma unroll
        for (int t2 = 0; t2 < 2; ++t2)
#pragma unroll
          for (int e = 0; e < 16; ++e) S[g][t2][e] -= sh;
      }
      float sum = 0.f;
#pragma unroll
      for (int t2 = 0; t2 < 2; ++t2)
#pragma unroll
        for (int e = 0; e < 16; ++e) {
          float pv = __builtin_amdgcn_exp2f(S[g][t2][e]);
          S[g][t2][e] = pv;
          sum += pv;
        }
      lrun[g] += sum;
#pragma unroll
      for (int t2 = 0; t2 < 2; ++t2)
#pragma unroll
        for (int s2 = 0; s2 < 2; ++s2) {
          u32x4 pk;
#pragma unroll
          for (int j = 0; j < 4; ++j) pk[j] = pack2(S[g][t2][8 * s2 + 2 * j], S[g][t2][8 * s2 + 2 * j + 1]);
          pb[g][t2][s2] = __builtin_bit_cast(bf16x8, pk);
        }
    }
    const lchar* vs = cur + KBYTES;
#pragma unroll
    for (int d = 0; d < 2; ++d)
#pragma unroll
      for (int t2 = 0; t2 < 2; ++t2)
#pragma unroll
        for (int s2 = 0; s2 < 2; ++s2) {
          const int c = t2 * 4 + s2 * 2 + hh;
          bf16x8 vf = *(const bf16x8*)(vs + (d * 32 + r) * 128 + ((c ^ k8) * 16));
#pragma unroll
          for (int g = 0; g < 2; ++g) O[g][d] = MFMA32(vf, pb[g][t2][s2], O[g][d]);
        }
  }
#undef ATT_ISSUE
  asm volatile("s_waitcnt vmcnt(0)" ::: "memory");
#pragma unroll
  for (int g = 0; g < 2; ++g) {
    const float l = lrun[g] + __shfl_xor(lrun[g], 32);
    const float inv = 1.f / l;
    bf16_t* orow = outp + (size_t)(w * 64 + g * 32 + r) * DM;
#pragma unroll
    for (int d = 0; d < 2; ++d)
#pragma unroll
      for (int e4 = 0; e4 < 4; ++e4) {
        u32x2 o;
        o[0] = pack2(O[g][d][e4 * 4 + 0] * inv, O[g][d][e4 * 4 + 1] * inv);
        o[1] = pack2(O[g][d][e4 * 4 + 2] * inv, O[g][d][e4 * 4 + 3] * inv);
        *(u32x2*)(orow + d * 32 + 8 * e4 + 4 * hh) = o;
      }
  }
}

DI void phase_attn(const Params& p, char* smem, int bid, int nblk, int l) {
  const bool lat_only = (l == 1);
  const int nq = lat_only ? 16 : 17;
  const int per = NB * 4 * nq;
  const int total = 3 * per;
  const float lam_init = (l == 0) ? 0.2f : 0.35550906759096927f;
  float lam;
  {
    const float* lv = p.lam_vecs + l * 128;
    float s1 = 0.f, s2 = 0.f;
    for (int i = 0; i < 32; ++i) { s1 += lv[i] * lv[32 + i]; s2 += lv[64 + i] * lv[96 + i]; }
    lam = __builtin_amdgcn_exp2f(s1 * LOG2E) - __builtin_amdgcn_exp2f(s2 * LOG2E) + lam_init;
  }
  const int nA = NB * 4 * 16, nW = NB * 4 * 8;
  const int nlat = nA + 2 * nW;
  const int total_items = nlat + (lat_only ? 0 : 3 * NB * 4);
  for (int t = xcd_vb(bid, nblk); t < total_items; t += nblk) {
    int mixer, bh, q0, nkeys = NT;
    bool wide = false;
    if (t < nA) { mixer = 0; bh = t >> 4; q0 = ((t & 15) + 1) * 256; }
    else if (t < nlat) { const int u = t - nA; mixer = 1 + u / nW; const int v = u % nW; bh = v >> 3; q0 = 256 + (v & 7) * 512; wide = true; }
    else { const int u = t - nlat; mixer = u / (NB * 4); bh = u % (NB * 4); q0 = 0; nkeys = 256; }
    const int b = bh >> 2, hd = bh & 3;
    bf16_t* mixrow = p.h + ((size_t)b * NT + q0) * DM;
    if (mixer == 0) {
      attn_item<32, 2>(p.r2 + QA_OFF + (size_t)(b * 4 + hd) * 2 * NT * 32, p.r2 + KA_OFF + (size_t)(b * 4 + hd) * 2 * NT * 32,
                       p.r2 + VAT_OFF + (size_t)(b * 4 + hd) * 64 * NT, q0, nkeys, mixrow + hd * 64, smem, lam,
                       1.f - lam_init, p.g_subln + l * 64);
    } else if (mixer == 1) {
      const bf16_t* Q = p.r2 + QD_OFF + (size_t)(b * 4 + hd) * NT * 96;
      const bf16_t* K = p.r2 + KD_OFF + (size_t)(b * 4 + hd) * NT * 96;
      const bf16_t* V = p.r2 + VDT_OFF + (size_t)(b * 4 + hd) * 64 * NT;
      if (wide) attn_item_w64<96>(Q, K, V, q0, nkeys, mixrow + 768 + hd * 64, smem);
      else attn_item<96, 1>(Q, K, V, q0, nkeys, mixrow + 768 + hd * 64, smem, 0.f, 0.f, nullptr);
    } else {
      const bf16_t* Q = p.r2 + QB_OFF + (size_t)(b * 4 + hd) * NT * 64;
      const bf16_t* K = p.r2 + KB_OFF + (size_t)(b * 2 + (hd >> 1)) * NT * 64;
      const bf16_t* V = p.r2 + VBT_OFF + (size_t)(b * 2 + (hd >> 1)) * 64 * NT;
      if (wide) attn_item_w64<64>(Q, K, V, q0, nkeys, mixrow + 256 + hd * 64, smem);
      else attn_item<64, 1>(Q, K, V, q0, nkeys, mixrow + 256 + hd * 64, smem, 0.f, 0.f, nullptr);
    }
  }
}


#define XB_TMO      128
#define XB_XCNT(j)  (256  + 64 * (j))
#define XB_XSUB(j)  (1280 + 64 * (j))
#define XB_XGEN(j)  (2304 + 64 * (j))
#define XB_TOP      3328
#define XB_TOPGEN   3392
#define XCD_BAR_WORDS 3456
#define XB_SPIN_CAP (1u << 18)
#define LAS __attribute__((address_space(3)))
DI unsigned xb_ld(unsigned* p) { return __hip_atomic_load(p, __ATOMIC_RELAXED, __HIP_MEMORY_SCOPE_AGENT); }
DI unsigned xb_add(unsigned* p, unsigned v) { return __hip_atomic_fetch_add(p, v, __ATOMIC_RELAXED, __HIP_MEMORY_SCOPE_AGENT); }
DI unsigned xb_xcc_id() { return (unsigned)__builtin_amdgcn_s_getreg((3 << 11) | 20) & 0xFu; }
#define XB_SPIN(cond, bar) do { unsigned _sp = 0; while (cond) { __builtin_amdgcn_s_sleep(1); \
    if ((++_sp & 255u) == 0u) { if (xb_ld(&(bar)[XB_TMO])) break; if (_sp > XB_SPIN_CAP) { atomicAdd(&(bar)[XB_TMO], 1u); break; } } } } while (0)
struct XcdBarrier { unsigned* bar; unsigned x; volatile LAS unsigned* st; };
DI XcdBarrier xcd_barrier_post(unsigned* bar, volatile LAS unsigned* st) {
  XcdBarrier b; b.bar = bar; b.x = xb_xcc_id(); b.st = st;
  if (threadIdx.x == 0) (void)xb_add(&bar[XB_XCNT(b.x)], 1u);
  return b;
}
DI void xcd_barrier_complete(unsigned* bar, unsigned x, unsigned& nloc, unsigned& nx) {
  const unsigned G = gridDim.x * gridDim.y * gridDim.z;
  unsigned sum, cnt, mine, sp = 0u;
  for (;;) {
    sum = 0u; cnt = 0u; mine = 0u;
#pragma unroll
    for (unsigned j = 0; j < 16; ++j) { const unsigned c = xb_ld(&bar[XB_XCNT(j)]); sum += c; cnt += (c > 0u) ? 1u : 0u; mine = (j == x) ? c : mine; }
    if (sum == G) break;
    __builtin_amdgcn_s_sleep(1);
    if ((++sp & 255u) == 0u) { if (xb_ld(&bar[XB_TMO])) break; if (sp > XB_SPIN_CAP) { atomicAdd(&bar[XB_TMO], 1u); break; } }
  }
  nloc = mine > 0u ? mine : 1u; nx = cnt > 0u ? cnt : 1u;
}
DI void xcd_barrier(const XcdBarrier& b) {
  asm volatile("s_waitcnt vmcnt(0)" ::: "memory");
  __syncthreads();
  if (threadIdx.x == 0) {
    unsigned* bar = b.bar;
    __builtin_amdgcn_s_waitcnt(0);
    unsigned nloc = b.st[0], nx = b.st[1];
    if (nloc == 0u) { xcd_barrier_complete(bar, b.x, nloc, nx); b.st[0] = nloc; b.st[1] = nx; }
    const unsigned old = xb_add(&bar[XB_XSUB(b.x)], 1u);
    const unsigned gen = old / nloc;
    if (old + 1u == (gen + 1u) * nloc) {
      __builtin_amdgcn_fence(__ATOMIC_RELEASE, "agent");
      asm volatile("s_waitcnt vmcnt(0)" ::: "memory");
      const unsigned og = xb_add(&bar[XB_TOP], 1u);
      const unsigned tg = og / nx;
      if (og + 1u == (tg + 1u) * nx) xb_add(&bar[XB_TOPGEN], 1u);
      else XB_SPIN(xb_ld(&bar[XB_TOPGEN]) == tg, bar);
      __builtin_amdgcn_fence(__ATOMIC_ACQUIRE, "agent");
      xb_add(&bar[XB_XGEN(b.x)], 1u);
      asm volatile("s_waitcnt vmcnt(0)" ::: "memory");
    } else {
      XB_SPIN(xb_ld(&bar[XB_XGEN(b.x)]) == gen, bar);
      __builtin_amdgcn_fence(__ATOMIC_ACQUIRE, "agent");
      asm volatile("s_waitcnt vmcnt(0)" ::: "memory");
    }
  }
  __syncthreads();
}

DI const Params& kp() {
  auto k = __builtin_amdgcn_kernarg_segment_ptr();
  asm volatile("" : "+s"(k));
  return *(const Params*)k;
}

#ifndef PROG
#define PROG 0xBA9876543210ull
#define NSTEP 12
#endif
constexpr int N_PHASES = 2 + 2 * NSTEP;
#ifndef PMASK
#define PMASK 0xffff
#endif
#define PM(k) ((PMASK >> (k)) & 1)
#ifndef REPMASK
#define REPMASK 0
#endif

__global__ void __launch_bounds__(NTHREADS) trunk_megakernel(Params p) {
  __shared__ __attribute__((aligned(16))) char smem[131072 + 16];
  cg::grid_group grid = cg::this_grid();
  const int bid = blockIdx.x, nblk = gridDim.x;
  if (threadIdx.x == 0) *(uint4*)(smem + 131072) = make_uint4(0u, 0u, 0u, 0u);
  __syncthreads();
  XcdBarrier xb;
  xb.bar = p.bar; xb.x = 0; xb.st = (volatile LAS unsigned*)(smem + 131072);
  if (p.phase_hi - p.phase_lo > 1) xb = xcd_barrier_post(p.bar, (volatile LAS unsigned*)(smem + 131072));
#pragma unroll 1
  for (int ph = p.phase_lo; ph < p.phase_hi; ++ph) {
    if (ph == 0) {
      if (PM(12)) phase_setup(kp(), smem, bid, nblk);
    } else if (ph == 1) {
      if (PM(13)) phase_rowpass(kp(), bid, nblk, 0, -1, 0.f, 0, 0, true, false);
    } else {
      const int l = (ph - 2) / NSTEP, s = (int)((PROG >> (4 * ((ph - 2) % NSTEP))) & 15ull);


      const bool lo = (l == 1);
      switch (s) {
        case 0: if (PM(0)) phase_gemm(kp(), smem, bid, nblk, EPI_SWIGLU, l, kp().h, DM, kp().wts + (size_t)l * LAYER_W + OFF_W1, DM, 22, false); break;
        case 1: if (PM(1)) phase_gemm(kp(), smem, bid, nblk, EPI_Y, l, kp().r1, DFF, kp().wts + (size_t)l * LAYER_W + OFF_W2, DFF, 4, false); break;
        case 2: if (PM(2)) phase_rowpass(kp(), bid, nblk, l, 0, 0.5f, l, 1, l == 0, false); break;
        case 3: if (PM(3)) phase_gemm(kp(), smem, bid, nblk, EPI_WIN, l, kp().h, DM, kp().wts + (size_t)l * LAYER_W + OFF_WIN, DM, 9, false); break;
        case 4: if (PM(4)) phase_rowprep(kp(), bid, nblk, l); break;
        case 5: if (PM(5)) phase_dexp_gmlp(kp(), smem, bid, nblk, l); break;
        case 6: if (PM(6)) phase_attn(kp(), smem, bid, nblk, l); break;
        case 7: if (PM(7)) phase_gemm(kp(), smem, bid, nblk, EPI_Y, l, kp().h, DM, kp().wts + (size_t)l * LAYER_W + OFF_WOUT, DM, 4, lo); break;
        case 8: if (PM(8)) phase_rowpass(kp(), bid, nblk, l, 1, 1.0f, l, 2, false, lo); break;
        case 9: if (PM(9)) phase_gemm(kp(), smem, bid, nblk, EPI_SWIGLU, l, kp().h, DM, kp().wts + (size_t)l * LAYER_W + OFF_W3, DM, 22, lo); break;
        case 10: if (PM(10)) phase_gemm(kp(), smem, bid, nblk, EPI_Y, l, kp().r1, DFF, kp().wts + (size_t)l * LAYER_W + OFF_W4, DFF, 4, lo); break;
        default: if (PM(11)) phase_rowpass(kp(), bid, nblk, l, 2, 0.5f, l + 1, (l == 0) ? 0 : -1, false, lo); break;
      }
    }
    if (ph + 1 < p.phase_hi) { if (ph == 0) grid.sync(); else xcd_barrier(xb); }
  }
}

extern "C" void kernel_launch(void* const* d_in, const int* in_sizes, int n_in, void* d_out, int out_size, void* d_ws,
                              size_t ws_size, hipStream_t stream) {
  static int grid_blocks = 0;
  if (!grid_blocks) {
    int dev = 0, cus = 0, per_cu = 0;
    hipGetDevice(&dev);
    hipDeviceGetAttribute(&cus, hipDeviceAttributeMultiprocessorCount, dev);
    hipOccupancyMaxActiveBlocksPerMultiprocessor(&per_cu, trunk_megakernel, NTHREADS, 0);
    if (per_cu < 1) per_cu = 1;
    if (per_cu > 1) per_cu = 1;
    grid_blocks = cus * per_cu;
  }
  Params p{};
  const float** pf = (const float**)&p;
  for (int i = 0; i < 26; ++i) pf[i] = (const float*)d_in[i];
  p.out = (float*)d_out;
  char* ws = (char*)d_ws;
  size_t off = 0;
  auto take = [&](size_t bytes) { char* q = ws + off; off += (bytes + 255) & ~(size_t)255; return q; };
  p.wts = (bf16_t*)take(2 * LAYER_W * 2);
  p.mods = (float*)take((size_t)2 * 9 * 9216 * 4);
  p.rope = (float*)take(3072 * 4);
  p.xctx = (float*)take((size_t)2048 * 1024 * 4);
  p.h = (bf16_t*)take((size_t)MROWS * DM * 2);
  p.r1 = (bf16_t*)take((size_t)MROWS * DFF * 2);
  p.r2 = (bf16_t*)take((size_t)MROWS * NIN * 2);
  p.bar = (unsigned*)take(XCD_BAR_WORDS * 4);
  hipMemsetAsync(p.bar, 0, XCD_BAR_WORDS * 4, stream);
  if (off > ws_size) fprintf(stderr, "workspace too small: need %zu have %zu\n", off, ws_size);
#if MULTI_LAUNCH
  for (int ph = 0; ph < N_PHASES; ++ph) {
    Params q = p;
    q.phase_lo = ph;
    q.phase_hi = ph + 1;
    void* args[] = {&q};
    hipError_t e = hipLaunchCooperativeKernel((void*)trunk_megakernel, dim3(grid_blocks), dim3(NTHREADS), args, 0, stream);
    if (e != hipSuccess) fprintf(stderr, "launch failed: %s\n", hipGetErrorString(e));
  }
#else
  p.phase_lo = 0;
  p.phase_hi = N_PHASES;
  void* args[] = {&p};
  hipError_t e = hipLaunchCooperativeKernel((void*)trunk_megakernel, dim3(grid_blocks), dim3(NTHREADS), args, 0, stream);
  if (e != hipSuccess) fprintf(stderr, "cooperative launch failed: %s (grid %d)\n", hipGetErrorString(e), grid_blocks);
#endif
}
```

```cpp
#include <hip/hip_runtime.h>
#include <hip/hip_cooperative_groups.h>
#include <stdint.h>
#include <cstdio>
namespace cg = cooperative_groups;

#ifndef MULTI_LAUNCH
#define MULTI_LAUNCH 0
#endif

typedef unsigned short bf16_t;
using bf16x8 = __attribute__((ext_vector_type(8))) short;
using f32x16 = __attribute__((ext_vector_type(16))) float;
using u32x4 = __attribute__((ext_vector_type(4))) unsigned;
using u32x2 = __attribute__((ext_vector_type(2))) unsigned;

#define DI __device__ __forceinline__
#define MFMA32(a, b, c) __builtin_amdgcn_mfma_f32_32x32x16_bf16((a), (b), (c), 0, 0, 0)

constexpr int NT = 4352;
constexpr int NB = 8;
constexpr int MROWS = NB * NT;
constexpr int DM = 1024;
constexpr int DFF = 2816;
constexpr int NIN = 2304;
constexpr int NTHREADS = 512;
constexpr float EPS = 1e-6f;
constexpr float LOG2E = 1.4426950408889634f;

constexpr size_t OFF_W1 = 0;
constexpr size_t OFF_W2 = 5767168;
constexpr size_t OFF_W3 = 8650752;
constexpr size_t OFF_W4 = 14417920;
constexpr size_t OFF_WIN = 17301504;
constexpr size_t OFF_WOUT = 19660800;
constexpr size_t OFF_WUQ = 20709376;
constexpr size_t OFF_WUKV = 20840448;
constexpr size_t OFF_WSP = 20905984;
constexpr size_t LAYER_W = 20971520;

constexpr size_t QA_OFF = 0;
constexpr size_t KA_OFF = 8912896;
constexpr size_t VAT_OFF = 17825792;
constexpr size_t QB_OFF = 26738688;
constexpr size_t KB_OFF = 35651584;
constexpr size_t VBT_OFF = 40108032;
constexpr size_t QD_OFF = 44564480;
constexpr size_t KD_OFF = 57933824;
constexpr size_t VDT_OFF = 71303168;

struct Params {
  const float *x, *c, *ctx, *c_ctx, *w_ada, *b_ada, *g_pre, *g_post, *w_ffn1_in, *w_ffn1_out, *w_ffn2_in,
      *w_ffn2_out, *w_in, *w_out, *lam_vecs, *g_subln, *g_qnorm, *g_knorm, *w_spatial, *b_spatial, *ln_g, *ln_b,
      *g_q_a, *w_uq, *g_kv_a, *w_ukv;
  float* out;
  bf16_t* wts;
  float* mods;
  float* rope;
  float* xctx;
  bf16_t* h;
  bf16_t* r1;
  bf16_t* r2;
  unsigned* bar;
  int phase_lo, phase_hi;
};

DI int otid() { int t = threadIdx.x; asm volatile("" : "+v"(t)); return t; }
DI float bf2f(bf16_t v) { return __uint_as_float(((unsigned)v) << 16); }
DI bf16_t f2bf(float f) { __bf16 b = (__bf16)f; return __builtin_bit_cast(unsigned short, b); }
DI unsigned pack2(float a, float b) {
  unsigned r;
  asm("v_cvt_pk_bf16_f32 %0, %1, %2" : "=v"(r) : "v"(a), "v"(b));
  return r;
}
DI float max3f(float a, float b, float c) {
  float r;
  asm("v_max3_f32 %0, %1, %2, %3" : "=v"(r) : "v"(a), "v"(b), "v"(c));
  return r;
}
DI int crow(int e, int hh) { return (e & 3) + 8 * (e >> 2) + 4 * hh; }
DI float wave_sum(float v) {
#pragma unroll
  for (int o = 32; o >= 1; o >>= 1) v += __shfl_xor(v, o);
  return v;
}
DI float gelu_tanh(float x) {
  float u = 0.7978845608028654f * (x + 0.044715f * x * x * x);
  float t = __builtin_amdgcn_exp2f(u * (2.f * LOG2E));
  float th = 1.f - 2.f * __builtin_amdgcn_rcpf(1.f + t);
  return 0.5f * x * (1.f + th);
}
DI float silu(float x) { return x * __builtin_amdgcn_rcpf(1.f + __builtin_amdgcn_exp2f(-x * LOG2E)); }

DI void convert_tile(const float* __restrict__ src, int K, int N, int mode, bf16_t* __restrict__ dst, int kt, int nt,
                     float* tile) {
  const int tid = otid();
  {
    const int kl = tid >> 6, n4 = (tid & 63) * 4;
    const int np = nt * 256 + n4;
    int sc = np;
    if (mode == 1) {
      int j = (np >> 7) & 1, tl = np >> 8, cc = np & 127;
      sc = j * DFF + tl * 128 + cc;
    }
    const bool valid = (mode == 1) || (np < N);
    float4 v[8];
#pragma unroll
    for (int i = 0; i < 8; ++i) {
      v[i] = make_float4(0.f, 0.f, 0.f, 0.f);
      if (valid) v[i] = *(const float4*)(src + (size_t)(kt * 64 + kl + 8 * i) * N + sc);
    }
#pragma unroll
    for (int i = 0; i < 8; ++i) {
      float* tp = tile + (kl + 8 * i) * 257 + n4;
      tp[0] = v[i].x; tp[1] = v[i].y; tp[2] = v[i].z; tp[3] = v[i].w;
    }
  }
  __syncthreads();
#pragma unroll
  for (int i = 0; i < 4; ++i) {
    const int cid = tid + i * NTHREADS;
    const int nl = cid >> 3, kc = (cid & 7) * 8;
    u32x4 o;
#pragma unroll
    for (int j = 0; j < 4; ++j) o[j] = pack2(tile[(kc + 2 * j) * 257 + nl], tile[(kc + 2 * j + 1) * 257 + nl]);
    *(u32x4*)(dst + (size_t)(nt * 256 + nl) * K + kt * 64 + kc) = o;
  }
  __syncthreads();
}

DI void phase_setup(const Params& p, char* smem, int bid, int nblk) {
  const int tid = otid();
  constexpr int PER_LAYER = 1292;
  constexpr int N_CONV = 2 * PER_LAYER;
  constexpr int N_MOD = 288;
  const int total = N_CONV + N_MOD + 1;
  for (int it = bid; it < total; it += nblk) {
    if (it < N_CONV) {
      const int l = it / PER_LAYER;
      int i = it - l * PER_LAYER;
      bf16_t* wl = p.wts + (size_t)l * LAYER_W;
      float* tile = (float*)smem;
      if (i < 352) { convert_tile(p.w_ffn1_in + (size_t)l * DM * 2 * DFF, DM, 2 * DFF, 1, wl + OFF_W1, i / 22, i % 22, tile); continue; }
      i -= 352;
      if (i < 176) { convert_tile(p.w_ffn1_out + (size_t)l * DFF * DM, DFF, DM, 0, wl + OFF_W2, i / 4, i % 4, tile); continue; }
      i -= 176;
      if (i < 352) { convert_tile(p.w_ffn2_in + (size_t)l * DM * 2 * DFF, DM, 2 * DFF, 1, wl + OFF_W3, i / 22, i % 22, tile); continue; }
      i -= 352;
      if (i < 176) { convert_tile(p.w_ffn2_out + (size_t)l * DFF * DM, DFF, DM, 0, wl + OFF_W4, i / 4, i % 4, tile); continue; }
      i -= 176;
      if (i < 144) { convert_tile(p.w_in + (size_t)l * DM * 2208, DM, 2208, 0, wl + OFF_WIN, i / 9, i % 9, tile); continue; }
      i -= 144;
      if (i < 64) { convert_tile(p.w_out + (size_t)l * DM * DM, DM, DM, 0, wl + OFF_WOUT, i / 4, i % 4, tile); continue; }
      i -= 64;
      if (i < 8) { convert_tile(p.w_uq + (size_t)l * 256 * 384, 256, 384, 0, wl + OFF_WUQ, i / 2, i % 2, tile); continue; }
      i -= 8;
      if (i < 4) { convert_tile(p.w_ukv + (size_t)l * 128 * 512, 128, 512, 0, wl + OFF_WUKV, i / 2, i % 2, tile); continue; }
      i -= 4;
      {
        const float* s = p.w_spatial + (size_t)l * 65536 + (size_t)i * 4096;
        bf16_t* d = wl + OFF_WSP + (size_t)i * 4096;
        for (int e = tid; e < 4096; e += NTHREADS) d[e] = f2bf(s[e]);
      }
    } else if (it < N_CONV + N_MOD) {
      const int m = it - N_CONV;
      const int l = m / 144, cg64 = m % 144;
      float* s = (float*)smem;
      float* red = (float*)(smem + 36864);
      for (int e = tid; e < 9 * 1024; e += NTHREADS) {
        int b = e >> 10, k = e & 1023;
        float v = (b < 8) ? p.c[b * 1024 + k] : p.c_ctx[k];
        s[e] = silu(v);
      }
      __syncthreads();
      const int w = tid >> 6, lane = tid & 63;
      const int col = cg64 * 64 + lane;
      float acc[9];
#pragma unroll
      for (int b = 0; b < 9; ++b) acc[b] = 0.f;
      const float* wp = p.w_ada + (size_t)l * 1024 * 9216 + col;
      for (int k = w * 128; k < w * 128 + 128; ++k) {
        float wv = wp[(size_t)k * 9216];
#pragma unroll
        for (int b = 0; b < 9; ++b) acc[b] += s[b * 1024 + k] * wv;
      }
#pragma unroll
      for (int b = 0; b < 9; ++b) red[(w * 9 + b) * 64 + lane] = acc[b];
      __syncthreads();
      for (int e = tid; e < 9 * 64; e += NTHREADS) {
        int b = e >> 6, ln = e & 63;
        float t = 0.f;
#pragma unroll
        for (int ww = 0; ww < 8; ++ww) t += red[(ww * 9 + b) * 64 + ln];
        int cc = cg64 * 64 + ln;
        p.mods[((size_t)l * 9 + b) * 9216 + cc] = t + p.b_ada[(size_t)l * 9216 + cc];
      }
      __syncthreads();
    } else {
      for (int e = tid; e < 64 * 8; e += NTHREADS) {
        int pos = e >> 3, j = e & 7;
        float inv = __builtin_amdgcn_exp2f(-(float)j * (13.287712379549449f / 8.f));
        float rev = (float)pos * inv * 0.15915494309189535f;
        p.rope[e] = __builtin_amdgcn_cosf(rev);
        p.rope[512 + e] = __builtin_amdgcn_sinf(rev);
      }
      for (int e = tid; e < 64 * 16; e += NTHREADS) {
        int pos = e >> 4, j = e & 15;
        float inv = __builtin_amdgcn_exp2f(-(float)j * (13.287712379549449f / 16.f));
        float rev = (float)pos * inv * 0.15915494309189535f;
        p.rope[1024 + e] = __builtin_amdgcn_cosf(rev);
        p.rope[2048 + e] = __builtin_amdgcn_sinf(rev);
      }
    }
  }
}

DI void phase_rowpass(const Params& p, int bid, int nblk, int l_post, int j_post, float wres, int l_pre,
                              int j_pre, bool src_inputs, bool lat_only) {
  const int tid = otid(); const int lane = tid & 63, w = tid >> 6;
  const int gw = bid * 8 + w, nw = nblk * 8;
  const int nrows = lat_only ? NB * 4096 : MROWS;
  const int rpw = (nrows + nw - 1) / nw;
  const int r_begin = gw * rpw, r_end = (r_begin + rpw < nrows) ? r_begin + rpw : nrows;
  const bf16_t* __restrict__ y = p.r2;
  const bool has_post = j_post >= 0, has_pre = j_pre >= 0;
  float4 gate[4], gpo[4], shf[4], scl[4], gpr[4];
  int cur_mrow = -1;
  const float* __restrict__ gpost_p = p.g_post + ((size_t)l_post * 3 + (has_post ? j_post : 0)) * DM;
  const float* __restrict__ gpre_p = p.g_pre + ((size_t)(has_pre ? l_pre : 0) * 3 + (has_pre ? j_pre : 0)) * DM;
#pragma unroll
  for (int c = 0; c < 4; ++c) {
    gpo[c] = has_post ? *(const float4*)(gpost_p + c * 256 + lane * 4) : make_float4(0.f, 0.f, 0.f, 0.f);
    gpr[c] = has_pre ? *(const float4*)(gpre_p + c * 256 + lane * 4) : make_float4(0.f, 0.f, 0.f, 0.f);
    gate[c] = shf[c] = scl[c] = make_float4(0.f, 0.f, 0.f, 0.f);
  }
  float4 xn[4];
  u32x2 yn[4];
#define RP_ROW(ri, R, bb, tt)                                              \
  const int R = lat_only ? (((ri) >> 12) * NT + 256 + ((ri) & 4095)) : (ri); \
  const int bb = R / NT, tt = R - bb * NT;
#define RP_SRC(bb, tt, ptr)                                                                       \
  const float* ptr;                                                                               \
  if ((tt) < 256) ptr = (src_inputs ? p.ctx : p.xctx) + ((size_t)(bb) * 256 + (tt)) * DM;        \
  else ptr = (src_inputs ? p.x : p.out) + ((size_t)(bb) * 4096 + ((tt) - 256)) * DM;
  if (r_begin < r_end) {
    RP_ROW(r_begin, R0, b0, t0)
    RP_SRC(b0, t0, s0)
#pragma unroll
    for (int c = 0; c < 4; ++c) {
      xn[c] = *(const float4*)(s0 + c * 256 + lane * 4);
      if (has_post) yn[c] = *(const u32x2*)(y + (size_t)R0 * DM + c * 256 + lane * 4);
    }
  }
  for (int ri = r_begin; ri < r_end; ++ri) {
    RP_ROW(ri, R, b, t)
    const bool isctx = t < 256;
    const int mrow = isctx ? 8 : b;
    float* dst = isctx ? p.xctx + ((size_t)b * 256 + t) * DM : p.out + ((size_t)b * 4096 + (t - 256)) * DM;
    float xv[16], yv[16];
#pragma unroll
    for (int c = 0; c < 4; ++c) {
      xv[c * 4 + 0] = xn[c].x; xv[c * 4 + 1] = xn[c].y; xv[c * 4 + 2] = xn[c].z; xv[c * 4 + 3] = xn[c].w;
      yv[c * 4 + 0] = __uint_as_float(yn[c][0] << 16);
      yv[c * 4 + 1] = __uint_as_float(yn[c][0] & 0xffff0000u);
      yv[c * 4 + 2] = __uint_as_float(yn[c][1] << 16);
      yv[c * 4 + 3] = __uint_as_float(yn[c][1] & 0xffff0000u);
    }
    if (ri + 1 < r_end) {
      RP_ROW(ri + 1, Rn, bn, tn)
      RP_SRC(bn, tn, sn)
#pragma unroll
      for (int c = 0; c < 4; ++c) {
        xn[c] = *(const float4*)(sn + c * 256 + lane * 4);
        if (has_post) yn[c] = *(const u32x2*)(y + (size_t)Rn * DM + c * 256 + lane * 4);
      }
    }
    if (mrow != cur_mrow) {
      cur_mrow = mrow;
      const float* mpo = p.mods + ((size_t)l_post * 9 + mrow) * 9216 + (3 * (has_post ? j_post : 0) + 2) * DM;
      const float* mpr = p.mods + ((size_t)(has_pre ? l_pre : 0) * 9 + mrow) * 9216 + (3 * (has_pre ? j_pre : 0)) * DM;
#pragma unroll
      for (int c = 0; c < 4; ++c) {
        if (has_post) gate[c] = *(const float4*)(mpo + c * 256 + lane * 4);
        if (has_pre) {
          shf[c] = *(const float4*)(mpr + c * 256 + lane * 4);
          scl[c] = *(const float4*)(mpr + DM + c * 256 + lane * 4);
        }
      }
    }
    if (has_post) {
      float ss = 0.f;
#pragma unroll
      for (int q = 0; q < 16; ++q) ss += yv[q] * yv[q];
      ss = wave_sum(ss);
      const float rstd = rsqrtf(ss * (1.f / DM) + EPS) * wres;
#pragma unroll
      for (int c = 0; c < 4; ++c) {
        xv[c * 4 + 0] += gate[c].x * yv[c * 4 + 0] * rstd * gpo[c].x;
        xv[c * 4 + 1] += gate[c].y * yv[c * 4 + 1] * rstd * gpo[c].y;
        xv[c * 4 + 2] += gate[c].z * yv[c * 4 + 2] * rstd * gpo[c].z;
        xv[c * 4 + 3] += gate[c].w * yv[c * 4 + 3] * rstd * gpo[c].w;
        *(float4*)(dst + c * 256 + lane * 4) = make_float4(xv[c * 4 + 0], xv[c * 4 + 1], xv[c * 4 + 2], xv[c * 4 + 3]);
      }
    }
    if (has_pre) {
      float ss = 0.f;
#pragma unroll
      for (int q = 0; q < 16; ++q) ss += xv[q] * xv[q];
      ss = wave_sum(ss);
      const float rstd = rsqrtf(ss * (1.f / DM) + EPS);
#pragma unroll
      for (int c = 0; c < 4; ++c) {
        float h0 = xv[c * 4 + 0] * rstd * gpr[c].x * (1.f + scl[c].x) + shf[c].x;
        float h1 = xv[c * 4 + 1] * rstd * gpr[c].y * (1.f + scl[c].y) + shf[c].y;
        float h2 = xv[c * 4 + 2] * rstd * gpr[c].z * (1.f + scl[c].z) + shf[c].z;
        float h3 = xv[c * 4 + 3] * rstd * gpr[c].w * (1.f + scl[c].w) + shf[c].w;
        u32x2 o;
        o[0] = pack2(h0, h1);
        o[1] = pack2(h2, h3);
        *(u32x2*)(p.h + (size_t)R * DM + c * 256 + lane * 4) = o;
      }
    }
  }
#undef RP_ROW
#undef RP_SRC
}

enum { EPI_SWIGLU = 0, EPI_Y = 1, EPI_WIN = 2, EPI_UQ = 3, EPI_UKV = 4 };

DI void gemm_mainloop(const bf16_t* __restrict__ A, int lda, const bf16_t* __restrict__ Bt, int ldb, int K, char* smem,
                      f32x16 (&acc)[4][2]) {
  const int tid = otid(), lane = tid & 63, w = tid >> 6, wm = w >> 2, wn = w & 3, r = lane & 31, hh = lane >> 5;
  const int lc = tid & 7, lr = tid >> 3;
  const bf16_t* ap = A + (size_t)lr * lda + lc * 8;
  const bf16_t* bp = Bt + (size_t)lr * ldb + lc * 8;
  const int st_off = lr * 128 + ((lc ^ ((lr >> 1) & 7)) << 4);
  u32x4 ra[4], rb[4];
#pragma unroll
  for (int i = 0; i < 4; ++i)
#pragma unroll
    for (int j = 0; j < 2; ++j)
#pragma unroll
      for (int e = 0; e < 16; ++e) acc[i][j][e] = 0.f;
  const int nk = K >> 6;
#pragma unroll
  for (int i = 0; i < 4; ++i) {
    ra[i] = *(const u32x4*)(ap + (size_t)i * 64 * lda);
    rb[i] = *(const u32x4*)(bp + (size_t)i * 64 * ldb);
  }
#pragma unroll
  for (int i = 0; i < 4; ++i) {
    *(u32x4*)(smem + st_off + i * 8192) = ra[i];
    *(u32x4*)(smem + 32768 + st_off + i * 8192) = rb[i];
  }
  __syncthreads();
  const int sw = (r >> 1) & 7;
#pragma unroll 1
  for (int kt = 0; kt < nk; ++kt) {
    char* cur = smem + (kt & 1) * 65536;
    const bool more = (kt + 1 < nk);
    if (more) {
      ap += 64;
      bp += 64;
#pragma unroll
      for (int i = 0; i < 4; ++i) {
        ra[i] = *(const u32x4*)(ap + (size_t)i * 64 * lda);
        rb[i] = *(const u32x4*)(bp + (size_t)i * 64 * ldb);
      }
    }
    const char* abase = cur + (wm * 128 + r) * 128;
    const char* bbase = cur + 32768 + (wn * 64 + r) * 128;
#pragma unroll
    for (int ks = 0; ks < 4; ++ks) {
      const int off = (((2 * ks + hh) ^ sw) << 4);
      bf16x8 af[4], bfr[2];
#pragma unroll
      for (int i = 0; i < 4; ++i) af[i] = *(const bf16x8*)(abase + i * 4096 + off);
#pragma unroll
      for (int j = 0; j < 2; ++j) bfr[j] = *(const bf16x8*)(bbase + j * 4096 + off);
#pragma unroll
      for (int i = 0; i < 4; ++i)
#pragma unroll
        for (int j = 0; j < 2; ++j) acc[i][j] = MFMA32(af[i], bfr[j], acc[i][j]);
    }
    if (more) {
      char* nxt = smem + ((kt + 1) & 1) * 65536;
#pragma unroll
      for (int i = 0; i < 4; ++i) {
        *(u32x4*)(nxt + st_off + i * 8192) = ra[i];
        *(u32x4*)(nxt + 32768 + st_off + i * 8192) = rb[i];
      }
    }
    __syncthreads();
  }
}

DI int lat_tile(int i) { return (i >> 4) * 17 + 1 + (i & 15); }

DI void gemm_tile(const Params& p, char* smem, int mode, int layer, const bf16_t* A, int lda, const bf16_t* Bt,
                          int K, int rt, int ct) {
  f32x16 acc[4][2];
  const int row0 = rt * 256, col0 = ct * 256;
  gemm_mainloop(A + (size_t)row0 * lda, lda, Bt + (size_t)col0 * K, K, K, smem, acc);
  const int tid = otid(), lane = tid & 63, w = tid >> 6, wm = w >> 2, wn = w & 3, r = lane & 31, hh = lane >> 5;
  const int rb = row0 + wm * 128, cb = col0 + wn * 64;
  const int b = row0 / NT;
  const int tb = rb - b * NT;
  if (mode == EPI_SWIGLU) {
    bf16_t* act = p.r1;
    const int oc = ct * 128 + wn * 32 + r;
#pragma unroll
    for (int i = 0; i < 4; ++i)
#pragma unroll
      for (int e = 0; e < 16; ++e) {
        float g = acc[i][0][e], u = acc[i][1][e];
        act[(size_t)(rb + i * 32 + crow(e, hh)) * DFF + oc] = f2bf(silu(g) * u);
      }
  } else if (mode == EPI_Y) {
    bf16_t* y = p.r2;
#pragma unroll
    for (int i = 0; i < 4; ++i)
#pragma unroll
      for (int j = 0; j < 2; ++j)
#pragma unroll
        for (int e = 0; e < 16; ++e)
          y[(size_t)(rb + i * 32 + crow(e, hh)) * DM + cb + j * 32 + r] = f2bf(acc[i][j][e]);
  } else if (mode == EPI_WIN) {
    const bool isAv = (cb >= 512 && cb < 768);
    const bool isBv = (cb >= 1152 && cb < 1280);
    if (isAv || isBv) {
      bf16_t* vt;
      if (isAv) vt = p.r2 + VAT_OFF + (size_t)((b * 4 + (cb - 512) / 64) * 64) * NT;
      else vt = p.r2 + VBT_OFF + (size_t)((b * 2 + (cb - 1152) / 64) * 64) * NT;
#pragma unroll
      for (int i = 0; i < 4; ++i)
#pragma unroll
        for (int j = 0; j < 2; ++j)
#pragma unroll
          for (int e4 = 0; e4 < 4; ++e4) {
            u32x2 o;
            o[0] = pack2(acc[i][j][e4 * 4 + 0], acc[i][j][e4 * 4 + 1]);
            o[1] = pack2(acc[i][j][e4 * 4 + 2], acc[i][j][e4 * 4 + 3]);
            int t = tb + i * 32 + 8 * e4 + 4 * hh;
            *(u32x2*)(vt + (size_t)(j * 32 + r) * NT + t) = o;
          }
    } else {
      bf16_t* pp = p.r1;
#pragma unroll
      for (int i = 0; i < 4; ++i)
#pragma unroll
        for (int j = 0; j < 2; ++j)
#pragma unroll
          for (int e = 0; e < 16; ++e)
            pp[(size_t)(rb + i * 32 + crow(e, hh)) * NIN + cb + j * 32 + r] = f2bf(acc[i][j][e]);
    }
  } else if (mode == EPI_UQ) {
    const float scale = 0.10206207261596577f * LOG2E;
    const bool isctx = tb < 256;
#pragma unroll
    for (int j = 0; j < 2; ++j) {
      const int n0 = cb + j * 32;
      if (n0 >= 384) continue;
      const int head = n0 / 96, seg = (n0 % 96) / 32;
      bf16_t* qd = p.r2 + QD_OFF + (size_t)(b * 4 + head) * NT * 96 + seg * 32 + r;
#pragma unroll
      for (int i = 0; i < 4; ++i)
#pragma unroll
        for (int e = 0; e < 16; ++e) {
          float v = acc[i][j][e];
          const int t = tb + i * 32 + crow(e, hh);
          if (seg == 2) {
            float pr = __shfl_xor(v, 8);
            if (!isctx) {
              const int pos = t - 256;
              const int pa = (r & 16) ? (pos & 63) : (pos >> 6);
              const float cs = p.rope[pa * 8 + (r & 7)], sn = p.rope[512 + pa * 8 + (r & 7)];
              v = v * cs + ((r & 8) ? pr : -pr) * sn;
            }
          }
          qd[(size_t)t * 96] = f2bf(v * scale);
        }
    }
  } else {
#pragma unroll
    for (int j = 0; j < 2; ++j) {
      const int n0 = cb + j * 32;
      const int head = n0 >> 7, wseg = n0 & 127;
      if (wseg < 64) {
        bf16_t* kd = p.r2 + KD_OFF + (size_t)(b * 4 + head) * NT * 96 + wseg + r;
#pragma unroll
        for (int i = 0; i < 4; ++i)
#pragma unroll
          for (int e = 0; e < 16; ++e) kd[(size_t)(tb + i * 32 + crow(e, hh)) * 96] = f2bf(acc[i][j][e]);
      } else {
        bf16_t* vt = p.r2 + VDT_OFF + (size_t)((b * 4 + head) * 64 + (wseg - 64) + r) * NT;
#pragma unroll
        for (int i = 0; i < 4; ++i)
#pragma unroll
          for (int e4 = 0; e4 < 4; ++e4) {
            u32x2 o;
            o[0] = pack2(acc[i][j][e4 * 4 + 0], acc[i][j][e4 * 4 + 1]);
            o[1] = pack2(acc[i][j][e4 * 4 + 2], acc[i][j][e4 * 4 + 3]);
            *(u32x2*)(vt + tb + i * 32 + 16 * (e4 >> 1) + 8 * hh + 4 * (e4 & 1)) = o;
          }
      }
    }
  }
}


using f32x4 = __attribute__((ext_vector_type(4))) float;
typedef __attribute__((address_space(3))) unsigned lds_u32;
DI int lds_byte8(int r, int c) {
  int st = (r >> 4) * 2 + (c >> 5), rr = r & 15, cc = c & 31, ob = rr * 64 + cc * 2;
  return st * 1024 + (ob ^ (((ob >> 9) & 1) << 5));
}
DI void stage_rc8(int b, int& R, int& C) {
  int st = b / 1024, sb = b % 1024, swz = sb ^ (((sb >> 9) & 1) << 5);
  R = (st >> 1) * 16 + swz / 64;
  C = (st & 1) * 32 + (swz % 64) / 2;
}
#define G8_HT 16384
#define G8_SA(b, h) (smem + ((b) * 2 + (h)) * G8_HT)
#define G8_SB(b, h) (smem + (4 + (b) * 2 + (h)) * G8_HT)
#define G8_STAGE(P, BASE, goff0, goff1, ld, br, kt)                                                              \
  do {                                                                                                            \
    const bf16_t* _g = (BASE) + (size_t)(br) * (ld) + (size_t)(kt) * 64;                                          \
    __builtin_amdgcn_global_load_lds((const unsigned*)(_g + goff0), (lds_u32*)((P) + tid * 16), 16, 0, 0);        \
    __builtin_amdgcn_global_load_lds((const unsigned*)(_g + goff1), (lds_u32*)((P) + tid * 16 + 8192), 16, 0, 0); \
  } while (0)
#define G8_LDA(dst, b, h)                                                                                 \
  _Pragma("unroll") for (int m = 0; m < 4; ++m) _Pragma("unroll") for (int k = 0; k < 2; ++k) dst[m][k] = \
      *(const bf16x8*)(G8_SA(b, h) + lds_byte8(wr * 64 + m * 16 + fr, k * 32 + fq * 8))
#define G8_LDB(dst, b, h)                                                                                 \
  _Pragma("unroll") for (int n = 0; n < 2; ++n) _Pragma("unroll") for (int k = 0; k < 2; ++k) dst[n][k] = \
      *(const bf16x8*)(G8_SB(b, h) + lds_byte8(wc * 32 + n * 16 + fr, k * 32 + fq * 8))
#define G8_MMA(ai, bj, AT, BX)                                                                         \
  do {                                                                                                 \
    __builtin_amdgcn_s_setprio(1);                                                                     \
    _Pragma("unroll") for (int m = 0; m < 4; ++m) _Pragma("unroll") for (int n = 0; n < 2; ++n)        \
        _Pragma("unroll") for (int k = 0; k < 2; ++k) acc[ai][bj][m][n] =                              \
            __builtin_amdgcn_mfma_f32_16x16x32_bf16(AT[m][k], BX[n][k], acc[ai][bj][m][n], 0, 0, 0);   \
    __builtin_amdgcn_s_setprio(0);                                                                     \
  } while (0)
#define G8_WAIT_V(n) asm volatile("s_waitcnt vmcnt(" #n ")" ::: "memory")
#define G8_WAIT_L(n) asm volatile("s_waitcnt lgkmcnt(" #n ")" ::: "memory")
#define G8_BAR __builtin_amdgcn_s_barrier()
#define G8_SCHED __builtin_amdgcn_sched_barrier(0)

DI void gemm8_mainloop(const bf16_t* __restrict__ A, int lda, const bf16_t* __restrict__ Bt, int ldb, int K,
                       __attribute__((address_space(3))) char* smem, f32x4 (&acc)[2][2][4][2]) {
  const int tid = otid();
  const int wid = tid >> 6, lane = tid & 63, wr = wid >> 2, wc = wid & 3, fr = lane & 15, fq = lane >> 4;
  int r0, c0, r1, c1;
  stage_rc8(tid * 16, r0, c0);
  stage_rc8(tid * 16 + 8192, r1, c1);
  const int ga0 = r0 * lda + c0, ga1 = r1 * lda + c1, gb0 = r0 * ldb + c0, gb1 = r1 * ldb + c1;
#pragma unroll
  for (int a = 0; a < 2; ++a)
#pragma unroll
    for (int b = 0; b < 2; ++b)
#pragma unroll
      for (int m = 0; m < 4; ++m)
#pragma unroll
        for (int n = 0; n < 2; ++n) acc[a][b][m][n] = (f32x4){0.f, 0.f, 0.f, 0.f};
  bf16x8 At[4][2], B0[2][2], B1[2][2];
  const int nt = K >> 6;
  G8_WAIT_V(0);
  G8_STAGE(G8_SB(0, 0), Bt, gb0, gb1, ldb, 0, 0);
  G8_STAGE(G8_SA(0, 0), A, ga0, ga1, lda, 0, 0);
  G8_STAGE(G8_SB(0, 1), Bt, gb0, gb1, ldb, 128, 0);
  G8_STAGE(G8_SA(0, 1), A, ga0, ga1, lda, 128, 0);
  if (wr == 1) G8_BAR;
  G8_WAIT_V(4); G8_BAR;
  G8_STAGE(G8_SB(1, 0), Bt, gb0, gb1, ldb, 0, 1);
  G8_STAGE(G8_SA(1, 0), A, ga0, ga1, lda, 0, 1);
  G8_STAGE(G8_SB(1, 1), Bt, gb0, gb1, ldb, 128, 1);
  G8_WAIT_V(6); G8_BAR;
#pragma unroll 1
  for (int t = 0; t < nt - 2; t += 2) {
    G8_LDB(B0, 0, 0); G8_SCHED; G8_LDA(At, 0, 0); G8_STAGE(G8_SA(1, 1), A, ga0, ga1, lda, 128, t + 1);
    G8_WAIT_L(8); G8_BAR; G8_WAIT_L(0); G8_MMA(0, 0, At, B0); G8_BAR; G8_SCHED;
    G8_LDB(B1, 0, 1); G8_STAGE(G8_SB(0, 0), Bt, gb0, gb1, ldb, 0, t + 2);
    G8_BAR; G8_WAIT_L(0); G8_MMA(0, 1, At, B1); G8_BAR;
    G8_LDA(At, 0, 1); G8_STAGE(G8_SA(0, 0), A, ga0, ga1, lda, 0, t + 2);
    G8_BAR; G8_WAIT_L(0); G8_MMA(1, 0, At, B0); G8_BAR; G8_SCHED;
    G8_STAGE(G8_SB(0, 1), Bt, gb0, gb1, ldb, 128, t + 2);
    G8_WAIT_V(6); G8_BAR; G8_MMA(1, 1, At, B1); G8_BAR;
    G8_LDB(B0, 1, 0); G8_SCHED; G8_LDA(At, 1, 0); G8_STAGE(G8_SA(0, 1), A, ga0, ga1, lda, 128, t + 2);
    G8_WAIT_L(8); G8_BAR; G8_WAIT_L(0); G8_MMA(0, 0, At, B0); G8_BAR; G8_SCHED;
    G8_LDB(B1, 1, 1); G8_STAGE(G8_SB(1, 0), Bt, gb0, gb1, ldb, 0, t + 3);
    G8_BAR; G8_WAIT_L(0); G8_MMA(0, 1, At, B1); G8_BAR;
    G8_LDA(At, 1, 1); G8_STAGE(G8_SA(1, 0), A, ga0, ga1, lda, 0, t + 3);
    G8_BAR; G8_WAIT_L(0); G8_MMA(1, 0, At, B0); G8_BAR; G8_SCHED;
    G8_STAGE(G8_SB(1, 1), Bt, gb0, gb1, ldb, 128, t + 3);
    G8_WAIT_V(6); G8_BAR; G8_MMA(1, 1, At, B1); G8_BAR;
  }
  {
    G8_LDB(B0, 0, 0); G8_LDA(At, 0, 0); G8_STAGE(G8_SA(1, 1), A, ga0, ga1, lda, 128, nt - 1);
    G8_BAR; G8_WAIT_L(0); G8_MMA(0, 0, At, B0); G8_BAR;
    G8_LDB(B1, 0, 1); G8_BAR; G8_WAIT_L(0); G8_MMA(0, 1, At, B1); G8_BAR;
    G8_LDA(At, 0, 1); G8_WAIT_V(4); G8_BAR; G8_WAIT_L(0); G8_MMA(1, 0, At, B0); G8_MMA(1, 1, At, B1); G8_BAR;
  }
  {
    G8_LDB(B0, 1, 0); G8_LDA(At, 1, 0); G8_WAIT_V(2); G8_BAR; G8_WAIT_L(0); G8_MMA(0, 0, At, B0); G8_BAR;
    G8_LDB(B1, 1, 1); G8_WAIT_V(0); G8_BAR; G8_WAIT_L(0); G8_MMA(0, 1, At, B1); G8_BAR;
    G8_LDA(At, 1, 1); G8_BAR; G8_WAIT_L(0); G8_MMA(1, 0, At, B0); G8_MMA(1, 1, At, B1); G8_BAR;
  }
  if (wr == 0) G8_BAR;
}

DI void gemm8_tile(const Params& p, char* smem_g, int mode, const bf16_t* A, int lda, const bf16_t* Bt, int K, int rt,
                   int ct) {
  f32x4 acc[2][2][4][2];
  const int row0 = rt * 256, col0 = ct * 256;
  gemm8_mainloop(A + (size_t)row0 * lda, lda, Bt + (size_t)col0 * K, K, K,
                 (__attribute__((address_space(3))) char*)smem_g, acc);
  const int tid = otid();
  const int wid = tid >> 6, lane = tid & 63, wr = wid >> 2, wc = wid & 3, fr = lane & 15, fq = lane >> 4;
  const int b = row0 / NT;
  const int rw = row0 + wr * 64 + fq * 4;
  if (mode == EPI_SWIGLU) {
    bf16_t* act = p.r1;
#pragma unroll
    for (int ai = 0; ai < 2; ++ai)
#pragma unroll
      for (int m = 0; m < 4; ++m)
#pragma unroll
        for (int n = 0; n < 2; ++n)
#pragma unroll
          for (int j = 0; j < 4; ++j) {
            float g = acc[ai][0][m][n][j], u = acc[ai][1][m][n][j];
            act[(size_t)(rw + ai * 128 + m * 16 + j) * DFF + ct * 128 + wc * 32 + n * 16 + fr] = f2bf(silu(g) * u);
          }
  } else if (mode == EPI_Y) {
    bf16_t* y = p.r2;
#pragma unroll
    for (int ai = 0; ai < 2; ++ai)
#pragma unroll
      for (int bj = 0; bj < 2; ++bj)
#pragma unroll
        for (int m = 0; m < 4; ++m)
#pragma unroll
          for (int n = 0; n < 2; ++n)
#pragma unroll
            for (int j = 0; j < 4; ++j)
              y[(size_t)(rw + ai * 128 + m * 16 + j) * DM + col0 + bj * 128 + wc * 32 + n * 16 + fr] =
                  f2bf(acc[ai][bj][m][n][j]);
  } else {
    const int tw16 = row0 - b * NT + wr * 64 + (((fq & 1) << 1) | (fq >> 1)) * 4;
#pragma unroll
    for (int bj = 0; bj < 2; ++bj) {
      const int cb = col0 + bj * 128 + wc * 32;
      const bool isAv = (cb >= 512 && cb < 768);
      const bool isBv = (cb >= 1152 && cb < 1280);
      if (isAv || isBv) {
        bf16_t* vt;
        if (isAv) vt = p.r2 + VAT_OFF + (size_t)((b * 4 + (cb - 512) / 64) * 64 + (cb & 32)) * NT;
        else vt = p.r2 + VBT_OFF + (size_t)((b * 2 + (cb - 1152) / 64) * 64 + (cb & 32)) * NT;
#pragma unroll
        for (int ai = 0; ai < 2; ++ai)
#pragma unroll
          for (int m = 0; m < 4; ++m)
#pragma unroll
            for (int n = 0; n < 2; ++n) {
              u32x2 o;
              o[0] = pack2(acc[ai][bj][m][n][0], acc[ai][bj][m][n][1]);
              o[1] = pack2(acc[ai][bj][m][n][2], acc[ai][bj][m][n][3]);
              *(u32x2*)(vt + (size_t)(n * 16 + fr) * NT + tw16 + ai * 128 + m * 16) = o;
            }
      } else {
        bf16_t* pp = p.r1;
#pragma unroll
        for (int ai = 0; ai < 2; ++ai)
#pragma unroll
          for (int m = 0; m < 4; ++m)
#pragma unroll
            for (int n = 0; n < 2; ++n)
#pragma unroll
              for (int j = 0; j < 4; ++j)
                pp[(size_t)(rw + ai * 128 + m * 16 + j) * NIN + cb + n * 16 + fr] = f2bf(acc[ai][bj][m][n][j]);
      }
    }
  }
}

DI int xcd_vb(int bid, int nblk) {
  if (nblk & 7) return bid;
  return (bid & 7) * (nblk >> 3) + (bid >> 3);
}

DI void phase_gemm(const Params& p, char* smem, int bid, int nblk, int mode, int layer, const bf16_t* A, int lda,
                           const bf16_t* Bt, int K, int nct, bool lat_only) {
  const int nrt = lat_only ? 128 : 136;
  const int total = nrt * nct;
  const int nig = 8 * nct;
  for (int t = xcd_vb(bid, nblk); t < total; t += nblk) {
    const int gid = t / nig, fm = gid * 8;
    const int gsz = (nrt - fm) < 8 ? (nrt - fm) : 8;
    const int rem = t - gid * nig;
    int rti = fm + rem % gsz, ct = rem / gsz;
    int rt = lat_only ? lat_tile(rti) : rti;
    gemm8_tile(p, smem, mode, A, lda, Bt, K, rt, ct);
  }
}

DI void phase_rowprep(const Params& p, int bid, int nblk, int l) {
  const int tid = otid(); const int lane = tid & 63, w = tid >> 6;
  const int gw = bid * 8 + w, nw = nblk * 8;
  const float* __restrict__ ropeAc = p.rope;
  const float* __restrict__ ropeAs = p.rope + 512;
  const float* __restrict__ ropeBc = p.rope + 1024;
  const float* __restrict__ ropeBs = p.rope + 2048;
  const float gqn = p.g_qnorm[l * 64 + lane], gkn = p.g_knorm[l * 64 + lane];
  float lng[4], lnb[4], gqa[4], gkva[2];
#pragma unroll
  for (int i = 0; i < 4; ++i) {
    lng[i] = p.ln_g[l * 256 + i * 64 + lane];
    lnb[i] = p.ln_b[l * 256 + i * 64 + lane];
    gqa[i] = p.g_q_a[l * 256 + i * 64 + lane];
  }
  gkva[0] = p.g_kv_a[l * 128 + lane];
  gkva[1] = p.g_kv_a[l * 128 + 64 + lane];
  const float scaleA = 0.17677669529663687f * LOG2E;
  const float scaleB = 0.125f * LOG2E;
  bf16_t* __restrict__ qkv = p.r2;
  const int rpw = (MROWS + nw - 1) / nw;
  const int r_begin = gw * rpw, r_end = (r_begin + rpw < MROWS) ? r_begin + rpw : MROWS;
  float na[8], nb_[6], nc[8], nd[6], nkr = 0.f;
#define RPREP_LOAD(Rr)                                                                   \
  do {                                                                                   \
    const bf16_t* _P = p.r1 + (size_t)(Rr) * NIN;                                        \
    _Pragma("unroll") for (int i = 0; i < 8; ++i) na[i] = bf2f(_P[i * 64 + lane]);       \
    _Pragma("unroll") for (int i = 0; i < 6; ++i) nb_[i] = bf2f(_P[768 + i * 64 + lane]); \
    _Pragma("unroll") for (int i = 0; i < 8; ++i) nc[i] = bf2f(_P[1280 + i * 64 + lane]); \
    _Pragma("unroll") for (int i = 0; i < 6; ++i) nd[i] = bf2f(_P[1792 + i * 64 + lane]); \
    nkr = bf2f(_P[2176 + (lane & 31)]);                                                  \
  } while (0)
  if (r_begin < r_end) RPREP_LOAD(r_begin);
  for (int R = r_begin; R < r_end; ++R) {
    const int b = R / NT, t = R - b * NT;
    const bool isctx = t < 256;
    const int pos = t - 256;
    const int prow = pos >> 6, pcol = pos & 63;
    bf16_t* P = p.r1 + (size_t)R * NIN;
    float va[8], vb[6], vc[8], vd[6], vkr;
#pragma unroll
    for (int i = 0; i < 8; ++i) { va[i] = na[i]; vc[i] = nc[i]; }
#pragma unroll
    for (int i = 0; i < 6; ++i) { vb[i] = nb_[i]; vd[i] = nd[i]; }
    vkr = nkr;
    if (R + 1 < r_end) RPREP_LOAD(R + 1);
    {
      const int d = lane & 31;
      const int pa = (d & 16) ? pcol : prow;
      float cs = 1.f, sn = 0.f;
      if (!isctx) { cs = ropeAc[pa * 8 + (d & 7)]; sn = ropeAs[pa * 8 + (d & 7)]; }
      const float sg = (d & 8) ? sn : -sn;
#pragma unroll
      for (int i = 0; i < 4; ++i) {
        const int hm = (i * 64 + lane) >> 5;
        float vq = va[i], vk = va[4 + i];
        float pq = __shfl_xor(vq, 8), pk = __shfl_xor(vk, 8);
        vq = vq * cs + sg * pq;
        vk = vk * cs + sg * pk;
        size_t o = ((size_t)(b * 8 + hm) * NT + t) * 32 + d;
        qkv[QA_OFF + o] = f2bf(vq * scaleA);
        qkv[KA_OFF + o] = f2bf(vk);
      }
    }
    {
      const int d = lane;
      const int pa = (d & 32) ? pcol : prow;
      float cs = 1.f, sn = 0.f;
      if (!isctx) { cs = ropeBc[pa * 16 + (d & 15)]; sn = ropeBs[pa * 16 + (d & 15)]; }
      const float sg = (d & 16) ? sn : -sn;
      float ss[6];
#pragma unroll
      for (int i = 0; i < 6; ++i) ss[i] = vb[i] * vb[i];
#pragma unroll
      for (int o = 32; o >= 1; o >>= 1)
#pragma unroll
        for (int i = 0; i < 6; ++i) ss[i] += __shfl_xor(ss[i], o);
#pragma unroll
      for (int i = 0; i < 6; ++i) {
        float v = vb[i] * rsqrtf(ss[i] * (1.f / 64.f) + EPS) * (i < 4 ? gqn : gkn);
        float pr = __shfl_xor(v, 16);
        v = v * cs + sg * pr;
        if (i < 4) qkv[QB_OFF + ((size_t)(b * 4 + i) * NT + t) * 64 + d] = f2bf(v * scaleB);
        else qkv[KB_OFF + ((size_t)(b * 2 + (i - 4)) * NT + t) * 64 + d] = f2bf(v);
      }
    }
    {
      float s1 = 0.f, sq = 0.f, skv = 0.f;
#pragma unroll
      for (int i = 0; i < 4; ++i) {
        vc[i] = gelu_tanh(vc[i]);
        vc[4 + i] = gelu_tanh(vc[4 + i]);
        s1 += vc[4 + i];
        sq += vd[i] * vd[i];
      }
      skv = vd[4] * vd[4] + vd[5] * vd[5];
#pragma unroll
      for (int o = 32; o >= 1; o >>= 1) {
        s1 += __shfl_xor(s1, o);
        sq += __shfl_xor(sq, o);
        skv += __shfl_xor(skv, o);
      }
      const float mu = s1 * (1.f / 256.f);
      float s2 = 0.f;
#pragma unroll
      for (int i = 0; i < 4; ++i) { vc[4 + i] -= mu; s2 += vc[4 + i] * vc[4 + i]; }
      s2 = wave_sum(s2);
      const float rln = rsqrtf(s2 * (1.f / 256.f) + EPS);
      const float rq = rsqrtf(sq * (1.f / 256.f) + EPS);
      const float rkv = rsqrtf(skv * (1.f / 128.f) + EPS);
#pragma unroll
      for (int i = 0; i < 4; ++i) {
        P[1280 + i * 64 + lane] = f2bf(vc[i]);
        P[1536 + i * 64 + lane] = f2bf(vc[4 + i] * rln * lng[i] + lnb[i]);
        P[1792 + i * 64 + lane] = f2bf(vd[i] * rq * gqa[i]);
      }
      P[2048 + lane] = f2bf(vd[4] * rkv * gkva[0]);
      P[2048 + 64 + lane] = f2bf(vd[5] * rkv * gkva[1]);
    }
    {
      const int d = lane & 31;
      float kr = vkr;
      float pr = __shfl_xor(kr, 8);
      if (!isctx) {
        const int pa = (d & 16) ? pcol : prow;
        kr = kr * ropeAc[pa * 8 + (d & 7)] + ((d & 8) ? pr : -pr) * ropeAs[pa * 8 + (d & 7)];
      }
      if (lane < 32) {
        const bf16_t kb = f2bf(kr);
#pragma unroll
        for (int hd = 0; hd < 4; ++hd) qkv[KD_OFF + ((size_t)(b * 4 + hd) * NT + t) * 96 + 64 + d] = kb;
      }
    }
  }
}

#undef RPREP_LOAD
DI void gmlp_item(const Params& p, char* smem, int l, int ch, int g) {
  const int tid = otid(), lane = tid & 63, w = tid >> 6, r = lane & 31, hh = lane >> 5;
  const int R0 = ch * 128;
  bf16_t* vT = (bf16_t*)smem;
#pragma unroll
  for (int u = 0; u < 2; ++u) {
    const int cid = tid + u * NTHREADS;
    const int q = cid >> 3, cc = cid & 7;
    u32x4 v = *(const u32x4*)(p.r1 + (size_t)(R0 + q) * NIN + 1536 + g * 64 + cc * 8);
#pragma unroll
    for (int j = 0; j < 4; ++j) {
      vT[(cc * 8 + 2 * j) * 136 + q] = (bf16_t)(v[j] & 0xffffu);
      vT[(cc * 8 + 2 * j + 1) * 136 + q] = (bf16_t)(v[j] >> 16);
    }
  }
  __syncthreads();
  const int wp = w >> 1, wc = w & 1;
  const bf16_t* wsp = p.wts + (size_t)l * LAYER_W + OFF_WSP + (size_t)g * 16384;
  f32x16 acc;
#pragma unroll
  for (int e = 0; e < 16; ++e) acc[e] = 0.f;
#pragma unroll
  for (int ks = 0; ks < 8; ++ks) {
    bf16x8 a = *(const bf16x8*)(wsp + (wp * 32 + r) * 128 + ks * 16 + hh * 8);
    bf16x8 bb = *(const bf16x8*)(vT + (wc * 32 + r) * 136 + ks * 16 + hh * 8);
    acc = MFMA32(a, bb, acc);
  }
  const int c = g * 64 + wc * 32 + r;
#pragma unroll
  for (int e = 0; e < 16; ++e) {
    const int pp = wp * 32 + crow(e, hh);
    const float u = bf2f(p.r1[(size_t)(R0 + pp) * NIN + 1280 + c]);
    const float mixed = acc[e] + p.b_spatial[(size_t)l * 512 + g * 128 + pp];
    p.h[(size_t)(R0 + pp) * DM + 512 + c] = f2bf(u * mixed);
  }
  __syncthreads();
}

DI void phase_dexp_gmlp(const Params& p, char* smem, int bid, int nblk, int l) {
  const bool lat_only = (l == 1);
  const bf16_t* wl = p.wts + (size_t)l * LAYER_W;
  const int nch = lat_only ? 256 : 272;
  const int total = 272 + 272 + nch * 4;
  for (int t = xcd_vb(bid, nblk); t < total; t += nblk) {
    if (t < 272) {
      gemm_tile(p, smem, EPI_UQ, l, p.r1 + 1792, NIN, wl + OFF_WUQ, 256, t >> 1, t & 1);
    } else if (t < 544) {
      int u = t - 272;
      gemm_tile(p, smem, EPI_UKV, l, p.r1 + 2048, NIN, wl + OFF_WUKV, 128, u >> 1, u & 1);
    } else {
      int u = t - 544;
      int ci = u >> 2, g = u & 3;
      int ch = lat_only ? ((ci >> 5) * 34 + 2 + (ci & 31)) : ci;
      gmlp_item(p, smem, l, ch, g);
    }
  }
}

template <int CPR>
DI int kswz(int c, int row) {
  if (CPR == 4) return c ^ ((row >> 2) & 3);
  if (CPR == 8) return c ^ ((row >> 1) & 7);
  return (c & 12) | ((c & 3) ^ ((row >> 2) & 3));
}

template <int DQK, int NMAP>
DI void attn_item(const bf16_t* __restrict__ Qb, const bf16_t* __restrict__ Kb, const bf16_t* __restrict__ Vt,
                  int q0, int nkeys, bf16_t* __restrict__ outp, char* smem_g, float lam, float post_scale,
                  const float* __restrict__ g_subln) {
  typedef __attribute__((address_space(3))) char lchar;
  lchar* smem = (lchar*)smem_g;
  constexpr int CPR = DQK / 8;
  constexpr int KMAPB = 64 * CPR * 16;
  constexpr int KBYTES = NMAP * KMAPB;
  constexpr int STAGE = KBYTES + 8192;
  constexpr int NS = 5;
  constexpr int NKS = KBYTES / 16;
  constexpr int GK = (NKS + NTHREADS - 1) / NTHREADS;
  constexpr int KK = DQK / 16;
  constexpr float THR = 6.0f;
  const int tid = otid();
  const int lane = tid & 63, w = tid >> 6, r = lane & 31, hh = lane >> 5;

  asm volatile("s_waitcnt vmcnt(0)" ::: "memory");
  __builtin_amdgcn_s_barrier();
  asm volatile("" ::: "memory");

  bf16x8 qf[NMAP][KK];
  {
    const int qrow = q0 + w * 32 + r;
#pragma unroll
    for (int m = 0; m < NMAP; ++m)
#pragma unroll
      for (int kk = 0; kk < KK; ++kk)
        qf[m][kk] = *(const bf16x8*)(Qb + (size_t)m * NT * DQK + (size_t)qrow * DQK + kk * 16 + hh * 8);
  }
  const bf16_t* ksrc[GK];
  int kslot[GK];
#pragma unroll
  for (int u = 0; u < GK; ++u) {
    int sl = tid + u * NTHREADS;
    if (sl >= NKS) sl = tid;
    const int m = sl / (64 * CPR), rem = sl % (64 * CPR), row = rem / CPR, cp = rem % CPR;
    const int c = kswz<CPR>(cp, row);
    ksrc[u] = Kb + (size_t)m * NT * DQK + (size_t)row * DQK + c * 8;
    kslot[u] = sl * 16;
  }
  const int vrow = tid >> 3, vcp = tid & 7;
  const bf16_t* vsrc = Vt + (size_t)vrow * NT + ((vcp ^ ((vrow >> 1) & 7)) * 8);
  const int vslot = KBYTES + tid * 16;
  const int nt = nkeys >> 6;

#define ATT_ISSUE(tile, stoff)                                                                                    \
  do {                                                                                                            \
    const int _tl = (tile) < nt ? (tile) : nt - 1;                                                                \
    lchar* _st = smem + (stoff);                                                                                  \
    _Pragma("unroll") for (int u = 0; u < GK; ++u) __builtin_amdgcn_global_load_lds(                              \
        (const unsigned*)(ksrc[u] + (size_t)_tl * 64 * DQK), (lds_u32*)(_st + kslot[u]), 16, 0, 0);                \
    __builtin_amdgcn_global_load_lds((const unsigned*)(vsrc + _tl * 64), (lds_u32*)(_st + vslot), 16, 0, 0);      \
  } while (0)
#define ATT_WAITG()                                                    \
  do {                                                                 \
    if (GK == 1) asm volatile("s_waitcnt vmcnt(2)" ::: "memory");      \
    else asm volatile("s_waitcnt vmcnt(3)" ::: "memory");              \
  } while (0)

  f32x16 O[NMAP][2];
  float mrun[NMAP], lrun[NMAP];
#pragma unroll
  for (int m = 0; m < NMAP; ++m) {
    mrun[m] = 0.f;
    lrun[m] = 0.f;
#pragma unroll
    for (int d = 0; d < 2; ++d)
#pragma unroll
      for (int e = 0; e < 16; ++e) O[m][d][e] = 0.f;
  }
  const int kq = (r >> 2) & 3, k8 = (r >> 1) & 7;
  const int koff = r * (CPR * 16), voff = r * 128;

#define ATT_QK(Sx, so, m, base)                                                                          \
  do {                                                                                                   \
    _Pragma("unroll") for (int t2 = 0; t2 < 2; ++t2) {                                                   \
      _Pragma("unroll") for (int e = 0; e < 16; ++e) Sx[t2][e] = -(base);                                \
      _Pragma("unroll") for (int kk = 0; kk < KK; ++kk) {                                                \
        const int c = kk * 2 + hh;                                                                       \
        const int cp = (CPR == 8) ? (c ^ k8) : ((c & 12) | ((c & 3) ^ kq));                              \
        bf16x8 a = *(const bf16x8*)(smem + (so) + (m) * KMAPB + t2 * 32 * (CPR * 16) + koff + cp * 16);  \
        Sx[t2] = MFMA32(a, qf[m][kk], Sx[t2]);                                                           \
      }                                                                                                  \
    }                                                                                                    \
  } while (0)
#define ATT_PV(Px, so, m)                                                                                \
  do {                                                                                                   \
    _Pragma("unroll") for (int d = 0; d < 2; ++d) _Pragma("unroll") for (int t2 = 0; t2 < 2; ++t2)       \
        _Pragma("unroll") for (int s2 = 0; s2 < 2; ++s2) {                                               \
      const int c = t2 * 4 + s2 * 2 + hh;                                                                \
      bf16x8 vf = *(const bf16x8*)(smem + (so) + KBYTES + d * 32 * 128 + voff + ((c ^ k8) * 16));        \
      O[m][d] = MFMA32(vf, Px[t2][s2], O[m][d]);                                                         \
    }                                                                                                    \
  } while (0)
#define ATT_SOFTMAX(Sx, sbase, Px, m, first)                                                             \
  do {                                                                                                   \
    float mx = fmaxf(Sx[0][0], Sx[1][0]);                                                                \
    _Pragma("unroll") for (int e = 1; e < 16; ++e) mx = max3f(mx, Sx[0][e], Sx[1][e]);                   \
    mx = fmaxf(mx, __shfl_xor(mx, 32));                                                                  \
    const float drift = mrun[m] - (sbase);                                                               \
    const float mxr = mx - drift;                                                                        \
    const bool up = (first) || (mxr > THR);                                                              \
    if (__builtin_amdgcn_ballot_w64(up || (drift != 0.f)) != 0ull) {                                     \
      const float sh = up ? mxr : 0.f;                                                                   \
      const float alpha = (first) ? 1.f : __builtin_amdgcn_exp2f(-sh);                                   \
      mrun[m] += sh;                                                                                     \
      lrun[m] *= alpha;                                                                                  \
      _Pragma("unroll") for (int d = 0; d < 2; ++d) _Pragma("unroll") for (int e = 0; e < 16; ++e)       \
          O[m][d][e] *= alpha;                                                                           \
      const float tot = drift + sh;                                                                      \
      _Pragma("unroll") for (int t2 = 0; t2 < 2; ++t2) _Pragma("unroll") for (int e = 0; e < 16; ++e)    \
          Sx[t2][e] -= tot;                                                                              \
    }                                                                                                    \
    float sum = 0.f;                                                                                     \
    _Pragma("unroll") for (int t2 = 0; t2 < 2; ++t2) _Pragma("unroll") for (int e = 0; e < 16; ++e) {    \
      float pv = __builtin_amdgcn_exp2f(Sx[t2][e]);                                                      \
      Sx[t2][e] = pv;                                                                                    \
      sum += pv;                                                                                         \
    }                                                                                                    \
    lrun[m] += sum;                                                                                      \
    _Pragma("unroll") for (int t2 = 0; t2 < 2; ++t2) _Pragma("unroll") for (int s2 = 0; s2 < 2; ++s2) {  \
      u32x4 pk;                                                                                          \
      _Pragma("unroll") for (int j = 0; j < 4; ++j)                                                      \
          pk[j] = pack2(Sx[t2][8 * s2 + 2 * j], Sx[t2][8 * s2 + 2 * j + 1]);                             \
      Px[t2][s2] = __builtin_bit_cast(bf16x8, pk);                                                       \
    }                                                                                                    \
  } while (0)

  f32x16 Sa[2], Sb[2];
  bf16x8 Pa[2][2], Pb[2][2];
  float basea = 0.f, baseb = 0.f;
#pragma unroll
  for (int t2 = 0; t2 < 2; ++t2)
#pragma unroll
    for (int s2 = 0; s2 < 2; ++s2) {
      u32x4 z = {0u, 0u, 0u, 0u};
      Pa[t2][s2] = __builtin_bit_cast(bf16x8, z);
      Pb[t2][s2] = __builtin_bit_cast(bf16x8, z);
    }
  ATT_ISSUE(0, 0);
  ATT_ISSUE(1, STAGE);
  ATT_ISSUE(2, 2 * STAGE);
  if (GK == 1) asm volatile("s_waitcnt vmcnt(4)" ::: "memory");
  else asm volatile("s_waitcnt vmcnt(6)" ::: "memory");
  __builtin_amdgcn_s_barrier();
  asm volatile("" ::: "memory");
  ATT_QK(Sa, 0, 0, 0.f);
  int sp = 0, sc = 0, sn = STAGE, si = 3 * STAGE;
#define ATT_ADV()                                         \
  do {                                                    \
    sp = sc; sc = sn;                                     \
    sn = (sn + STAGE == NS * STAGE) ? 0 : sn + STAGE;     \
    si = (si + STAGE == NS * STAGE) ? 0 : si + STAGE;     \
  } while (0)
  if (NMAP == 2) {
#pragma unroll 1
    for (int j = 0; j < nt; ++j) {
      ATT_WAITG();
      __builtin_amdgcn_s_barrier();
      asm volatile("" ::: "memory");
      ATT_ISSUE(j + 3, si);
      baseb = mrun[NMAP - 1];
      ATT_QK(Sb, sc, NMAP - 1, baseb);
      ATT_PV(Pb, sp, NMAP - 1);
      ATT_SOFTMAX(Sa, basea, Pa, 0, (j == 0));
      basea = mrun[0];
      ATT_QK(Sa, sn, 0, basea);
      ATT_PV(Pa, sc, 0);
      ATT_SOFTMAX(Sb, baseb, Pb, NMAP - 1, (j == 0));
      ATT_ADV();
    }
    ATT_PV(Pb, sp, NMAP - 1);
  } else {
#pragma unroll 1
    for (int j = 0; j < nt; j += 2) {
      ATT_WAITG();
      __builtin_amdgcn_s_barrier();
      asm volatile("" ::: "memory");
      ATT_ISSUE(j + 3, si);
      baseb = mrun[0];
      ATT_QK(Sb, sn, 0, baseb);
      ATT_PV(Pb, sp, 0);
      ATT_SOFTMAX(Sa, basea, Pa, 0, (j == 0));
      ATT_ADV();
      ATT_WAITG();
      __builtin_amdgcn_s_barrier();
      asm volatile("" ::: "memory");
      ATT_ISSUE(j + 4, si);
      basea = mrun[0];
      ATT_QK(Sa, sn, 0, basea);
      ATT_PV(Pa, sp, 0);
      ATT_SOFTMAX(Sb, baseb, Pb, 0, false);
      ATT_ADV();
    }
    ATT_PV(Pb, sp, 0);
  }
#undef ATT_ISSUE
#undef ATT_WAITG
#undef ATT_QK
#undef ATT_PV
#undef ATT_SOFTMAX
#undef ATT_ADV
  asm volatile("s_waitcnt vmcnt(0)" ::: "memory");
#pragma unroll
  for (int m = 0; m < NMAP; ++m) lrun[m] += __shfl_xor(lrun[m], 32);
  bf16_t* orow = outp + (size_t)(w * 32 + r) * DM;
  if (NMAP == 1) {
    const float inv = 1.f / lrun[0];
#pragma unroll
    for (int d = 0; d < 2; ++d)
#pragma unroll
      for (int e4 = 0; e4 < 4; ++e4) {
        u32x2 o;
        o[0] = pack2(O[0][d][e4 * 4 + 0] * inv, O[0][d][e4 * 4 + 1] * inv);
        o[1] = pack2(O[0][d][e4 * 4 + 2] * inv, O[0][d][e4 * 4 + 3] * inv);
        *(u32x2*)(orow + d * 32 + 8 * e4 + 4 * hh) = o;
      }
  } else {
    const float i1 = 1.f / lrun[0], i2 = lam / lrun[NMAP - 1];
    float ss = 0.f;
#pragma unroll
    for (int d = 0; d < 2; ++d)
#pragma unroll
      for (int e = 0; e < 16; ++e) {
        float o = O[0][d][e] * i1 - O[NMAP - 1][d][e] * i2;
        O[0][d][e] = o;
        ss += o * o;
      }
    ss += __shfl_xor(ss, 32);
    const float rstd = rsqrtf(ss * (1.f / 64.f) + EPS) * post_scale;
#pragma unroll
    for (int d = 0; d < 2; ++d)
#pragma unroll
      for (int e4 = 0; e4 < 4; ++e4) {
        const int dv = d * 32 + 8 * e4 + 4 * hh;
        u32x2 o;
        o[0] = pack2(O[0][d][e4 * 4 + 0] * rstd * g_subln[dv + 0], O[0][d][e4 * 4 + 1] * rstd * g_subln[dv + 1]);
        o[1] = pack2(O[0][d][e4 * 4 + 2] * rstd * g_subln[dv + 2], O[0][d][e4 * 4 + 3] * rstd * g_subln[dv + 3]);
        *(u32x2*)(orow + dv) = o;
      }
  }
}


template <int DQK>
DI void attn_item_w64(const bf16_t* __restrict__ Qb, const bf16_t* __restrict__ Kb, const bf16_t* __restrict__ Vt,
                      int q0, int nkeys, bf16_t* __restrict__ outp, char* smem_g) {
  typedef __attribute__((address_space(3))) char lchar;
  lchar* smem = (lchar*)smem_g;
  constexpr int CPR = DQK / 8;
  constexpr int KBYTES = 64 * CPR * 16;
  constexpr int STAGE = KBYTES + 8192;
  constexpr int NS = 4;
  constexpr int NKS = KBYTES / 16;
  constexpr int GK = (NKS + NTHREADS - 1) / NTHREADS;
  constexpr int KK = DQK / 16;
  constexpr float THR = 6.0f;
  const int tid = otid();
  const int lane = tid & 63, w = tid >> 6, r = lane & 31, hh = lane >> 5;

  asm volatile("s_waitcnt vmcnt(0)" ::: "memory");
  __builtin_amdgcn_s_barrier();
  asm volatile("" ::: "memory");

  bf16x8 qf[2][KK];
#pragma unroll
  for (int g = 0; g < 2; ++g) {
    const int qrow = q0 + w * 64 + g * 32 + r;
#pragma unroll
    for (int kk = 0; kk < KK; ++kk) qf[g][kk] = *(const bf16x8*)(Qb + (size_t)qrow * DQK + kk * 16 + hh * 8);
  }
  const bf16_t* ksrc[GK];
  int kslot[GK];
#pragma unroll
  for (int u = 0; u < GK; ++u) {
    int sl = tid + u * NTHREADS;
    if (sl >= NKS) sl = tid;
    const int row = sl / CPR, cp = sl % CPR;
    const int c = kswz<CPR>(cp, row);
    ksrc[u] = Kb + (size_t)row * DQK + c * 8;
    kslot[u] = sl * 16;
  }
  const int vrow = tid >> 3, vcp = tid & 7;
  const bf16_t* vsrc = Vt + (size_t)vrow * NT + ((vcp ^ ((vrow >> 1) & 7)) * 8);
  const int vslot = KBYTES + tid * 16;
  const int nt = nkeys >> 6;
#define ATT_ISSUE(tile)                                                                                           \
  do {                                                                                                            \
    const int _tl = (tile) < nt ? (tile) : nt - 1;                                                                \
    lchar* _st = smem + ((tile) & (NS - 1)) * STAGE;                                                              \
    _Pragma("unroll") for (int u = 0; u < GK; ++u) __builtin_amdgcn_global_load_lds(                              \
        (const unsigned*)(ksrc[u] + (size_t)_tl * 64 * DQK), (lds_u32*)(_st + kslot[u]), 16, 0, 0);                \
    __builtin_amdgcn_global_load_lds((const unsigned*)(vsrc + _tl * 64), (lds_u32*)(_st + vslot), 16, 0, 0);      \
  } while (0)
  f32x16 O[2][2];
  float mrun[2], lrun[2];
#pragma unroll
  for (int g = 0; g < 2; ++g) {
    mrun[g] = 0.f;
    lrun[g] = 0.f;
#pragma unroll
    for (int d = 0; d < 2; ++d)
#pragma unroll
      for (int e = 0; e < 16; ++e) O[g][d][e] = 0.f;
  }
  ATT_ISSUE(0);
  ATT_ISSUE(1);
  ATT_ISSUE(2);
  const int kq = (r >> 2) & 3, k8 = (r >> 1) & 7;
#pragma unroll 1
  for (int it = 0; it < nt; ++it) {
    if (GK == 1) asm volatile("s_waitcnt vmcnt(4)" ::: "memory");
    else asm volatile("s_waitcnt vmcnt(6)" ::: "memory");
    __builtin_amdgcn_s_barrier();
    asm volatile("" ::: "memory");
    ATT_ISSUE(it + 3);
    const lchar* cur = smem + (it & (NS - 1)) * STAGE;
    f32x16 S[2][2];
    {
      constexpr int KSTEP = (KK > 4) ? 3 : KK;
      const unsigned kbase = (unsigned)(size_t)cur + r * (CPR * 16);
#pragma unroll
      for (int g = 0; g < 2; ++g)
#pragma unroll
        for (int t2 = 0; t2 < 2; ++t2)
#pragma unroll
          for (int e = 0; e < 16; ++e) S[g][t2][e] = -mrun[g];
#pragma unroll
      for (int kb = 0; kb < KK; kb += KSTEP) {
        bf16x8 kf[2 * KSTEP];
#pragma unroll
        for (int k2 = 0; k2 < KSTEP; ++k2) {
          const int c = (kb + k2) * 2 + hh;
          const int cp = (CPR == 8) ? (c ^ k8) : ((c & 12) | ((c & 3) ^ kq));
          const unsigned ad = kbase + cp * 16;
          asm volatile("ds_read_b128 %0, %1" : "=v"(kf[2 * k2]) : "v"(ad));
          asm volatile("ds_read_b128 %0, %1 offset:%2" : "=v"(kf[2 * k2 + 1]) : "v"(ad), "n"(32 * CPR * 16));
        }
#pragma unroll
        for (int k2 = 0; k2 < KSTEP; ++k2)
#pragma unroll
          for (int t2 = 0; t2 < 2; ++t2) {
            asm volatile("s_waitcnt lgkmcnt(%1)" : "+v"(kf[2 * k2 + t2]) : "n"(2 * KSTEP - 1 - (2 * k2 + t2)));
#pragma unroll
            for (int g = 0; g < 2; ++g) S[g][t2] = MFMA32(kf[2 * k2 + t2], qf[g][kb + k2], S[g][t2]);
          }
      }
    }
    bf16x8 pb[2][2][2];
#pragma unroll
    for (int g = 0; g < 2; ++g) {
      float mx = fmaxf(S[g][0][0], S[g][1][0]);
#pragma unroll
      for (int e = 1; e < 16; ++e) mx = max3f(mx, S[g][0][e], S[g][1][e]);
      mx = fmaxf(mx, __shfl_xor(mx, 32));
      const bool need = (it == 0) || (mx > THR);
      if (__builtin_amdgcn_ballot_w64(need) != 0ull) {
        const float sh = need ? mx : 0.f;
        const float alpha = (it == 0) ? 1.f : __builtin_amdgcn_exp2f(-sh);
        mrun[g] += sh;
        lrun[g] *= alpha;
#pragma unroll
        for (int d = 0; d < 2; ++d)
#pragma unroll
          for (int e = 0; e < 16; ++e) O[g][d][e] *= alpha;
#pragma unroll
        for (int t2 = 0; t2 < 2; ++t2)
#pragma unroll
          for (int e = 0; e < 16; ++e) S[g][t2][e] -= sh;
      }
      float sum = 0.f;
#pragma unroll
      for (int t2 = 0; t2 < 2; ++t2)
#pragma unroll
        for (int e = 0; e < 16; ++e) {
          float pv = __builtin_amdgcn_exp2f(S[g][t2][e]);
          S[g][t2][e] = pv;
          sum += pv;
        }
      lrun[g] += sum;
#pragma unroll
      for (int t2 = 0; t2 < 2; ++t2)
#pragma unroll
        for (int s2 = 0; s2 < 2; ++s2) {
          u32x4 pk;
#pragma unroll
          for (int j = 0; j < 4; ++j) pk[j] = pack2(S[g][t2][8 * s2 + 2 * j], S[g][t2][8 * s2 + 2 * j + 1]);
          pb[g][t2][s2] = __builtin_bit_cast(bf16x8, pk);
        }
    }
    {
      bf16x8 vf[8];
      const unsigned vbase = (unsigned)(size_t)cur + KBYTES + r * 128;
#pragma unroll
      for (int q = 0; q < 4; ++q) {
        const unsigned ad = vbase + (((q * 2 + hh) ^ k8) * 16);
        asm volatile("ds_read_b128 %0, %1" : "=v"(vf[2 * q]) : "v"(ad));
        asm volatile("ds_read_b128 %0, %1 offset:4096" : "=v"(vf[2 * q + 1]) : "v"(ad));
      }
#pragma unroll
      for (int q = 0; q < 4; ++q)
#pragma unroll
        for (int d = 0; d < 2; ++d) {
          asm volatile("s_waitcnt lgkmcnt(%1)" : "+v"(vf[2 * q + d]) : "n"(7 - (2 * q + d)));
#pragma unroll
          for (int g = 0; g < 2; ++g) O[g][d] = MFMA32(vf[2 * q + d], pb[g][q >> 1][q & 1], O[g][d]);
        }
    }
  }
#undef ATT_ISSUE
  asm volatile("s_waitcnt vmcnt(0)" ::: "memory");
#pragma unroll
  for (int g = 0; g < 2; ++g) {
    const float l = lrun[g] + __shfl_xor(lrun[g], 32);
    const float inv = 1.f / l;
    bf16_t* orow = outp + (size_t)(w * 64 + g * 32 + r) * DM;
#pragma unroll
    for (int d = 0; d < 2; ++d)
#pragma unroll
      for (int e4 = 0; e4 < 4; ++e4) {
        u32x2 o;
        o[0] = pack2(O[g][d][e4 * 4 + 0] * inv, O[g][d][e4 * 4 + 1] * inv);
        o[1] = pack2(O[g][d][e4 * 4 + 2] * inv, O[g][d][e4 * 4 + 3] * inv);
        *(u32x2*)(orow + d * 32 + 8 * e4 + 4 * hh) = o;
      }
  }
}

DI void phase_attn(const Params& p, char* smem, int bid, int nblk, int l) {
  const bool lat_only = (l == 1);
  const int nq = lat_only ? 16 : 17;
  const int per = NB * 4 * nq;
  const int total = 3 * per;
  const float lam_init = (l == 0) ? 0.2f : 0.35550906759096927f;
  float lam;
  {
    const float* lv = p.lam_vecs + l * 128;
    float s1 = 0.f, s2 = 0.f;
    for (int i = 0; i < 32; ++i) { s1 += lv[i] * lv[32 + i]; s2 += lv[64 + i] * lv[96 + i]; }
    lam = __builtin_amdgcn_exp2f(s1 * LOG2E) - __builtin_amdgcn_exp2f(s2 * LOG2E) + lam_init;
  }
  const int nA = NB * 4 * 16, nW = NB * 4 * 8;
  const int nlat = nA + 2 * nW;
  const int total_items = nlat + (lat_only ? 0 : 3 * NB * 4);
  for (int t = xcd_vb(bid, nblk); t < total_items; t += nblk) {
    int mixer, bh, q0, nkeys = NT;
    bool wide = false;
    if (t < nA) { mixer = 0; bh = t >> 4; q0 = ((t & 15) + 1) * 256; }
    else if (t < nlat) { const int u = t - nA; mixer = 1 + u / nW; const int v = u % nW; bh = v >> 3; q0 = 256 + (v & 7) * 512; wide = true; }
    else { const int u = t - nlat; mixer = u / (NB * 4); bh = u % (NB * 4); q0 = 0; nkeys = 256; }
    const int b = bh >> 2, hd = bh & 3;
    bf16_t* mixrow = p.h + ((size_t)b * NT + q0) * DM;
    if (mixer == 0) {
      attn_item<32, 2>(p.r2 + QA_OFF + (size_t)(b * 4 + hd) * 2 * NT * 32, p.r2 + KA_OFF + (size_t)(b * 4 + hd) * 2 * NT * 32,
                       p.r2 + VAT_OFF + (size_t)(b * 4 + hd) * 64 * NT, q0, nkeys, mixrow + hd * 64, smem, lam,
                       1.f - lam_init, p.g_subln + l * 64);
    } else if (mixer == 1) {
      const bf16_t* Q = p.r2 + QD_OFF + (size_t)(b * 4 + hd) * NT * 96;
      const bf16_t* K = p.r2 + KD_OFF + (size_t)(b * 4 + hd) * NT * 96;
      const bf16_t* V = p.r2 + VDT_OFF + (size_t)(b * 4 + hd) * 64 * NT;
      if (wide) attn_item_w64<96>(Q, K, V, q0, nkeys, mixrow + 768 + hd * 64, smem);
      else attn_item<96, 1>(Q, K, V, q0, nkeys, mixrow + 768 + hd * 64, smem, 0.f, 0.f, nullptr);
    } else {
      const bf16_t* Q = p.r2 + QB_OFF + (size_t)(b * 4 + hd) * NT * 64;
      const bf16_t* K = p.r2 + KB_OFF + (size_t)(b * 2 + (hd >> 1)) * NT * 64;
      const bf16_t* V = p.r2 + VBT_OFF + (size_t)(b * 2 + (hd >> 1)) * 64 * NT;
      if (wide) attn_item_w64<64>(Q, K, V, q0, nkeys, mixrow + 256 + hd * 64, smem);
      else attn_item<64, 1>(Q, K, V, q0, nkeys, mixrow + 256 + hd * 64, smem, 0.f, 0.f, nullptr);
    }
  }
}


#define XB_TMO      128
#define XB_XCNT(j)  (256  + 64 * (j))
#define XB_XSUB(j)  (1280 + 64 * (j))
#define XB_XGEN(j)  (2304 + 64 * (j))
#define XB_TOP      3328
#define XB_TOPGEN   3392
#define XCD_BAR_WORDS 3456
#define XB_SPIN_CAP (1u << 18)
#define LAS __attribute__((address_space(3)))
DI unsigned xb_ld(unsigned* p) { return __hip_atomic_load(p, __ATOMIC_RELAXED, __HIP_MEMORY_SCOPE_AGENT); }
DI unsigned xb_add(unsigned* p, unsigned v) { return __hip_atomic_fetch_add(p, v, __ATOMIC_RELAXED, __HIP_MEMORY_SCOPE_AGENT); }
DI unsigned xb_xcc_id() { return (unsigned)__builtin_amdgcn_s_getreg((3 << 11) | 20) & 0xFu; }
#define XB_SPIN(cond, bar) do { unsigned _sp = 0; while (cond) { __builtin_amdgcn_s_sleep(1); \
    if ((++_sp & 255u) == 0u) { if (xb_ld(&(bar)[XB_TMO])) break; if (_sp > XB_SPIN_CAP) { atomicAdd(&(bar)[XB_TMO], 1u); break; } } } } while (0)
struct XcdBarrier { unsigned* bar; unsigned x; volatile LAS unsigned* st; };
DI XcdBarrier xcd_barrier_post(unsigned* bar, volatile LAS unsigned* st) {
  XcdBarrier b; b.bar = bar; b.x = xb_xcc_id(); b.st = st;
  if (threadIdx.x == 0) (void)xb_add(&bar[XB_XCNT(b.x)], 1u);
  return b;
}
DI void xcd_barrier_complete(unsigned* bar, unsigned x, unsigned& nloc, unsigned& nx) {
  const unsigned G = gridDim.x * gridDim.y * gridDim.z;
  unsigned sum, cnt, mine, sp = 0u;
  for (;;) {
    sum = 0u; cnt = 0u; mine = 0u;
#pragma unroll
    for (unsigned j = 0; j < 16; ++j) { const unsigned c = xb_ld(&bar[XB_XCNT(j)]); sum += c; cnt += (c > 0u) ? 1u : 0u; mine = (j == x) ? c : mine; }
    if (sum == G) break;
    __builtin_amdgcn_s_sleep(1);
    if ((++sp & 255u) == 0u) { if (xb_ld(&bar[XB_TMO])) break; if (sp > XB_SPIN_CAP) { atomicAdd(&bar[XB_TMO], 1u); break; } }
  }
  nloc = mine > 0u ? mine : 1u; nx = cnt > 0u ? cnt : 1u;
}
DI void xcd_barrier(const XcdBarrier& b) {
  asm volatile("s_waitcnt vmcnt(0)" ::: "memory");
  __syncthreads();
  if (threadIdx.x == 0) {
    unsigned* bar = b.bar;
    __builtin_amdgcn_s_waitcnt(0);
    unsigned nloc = b.st[0], nx = b.st[1];
    if (nloc == 0u) { xcd_barrier_complete(bar, b.x, nloc, nx); b.st[0] = nloc; b.st[1] = nx; }
    const unsigned old = xb_add(&bar[XB_XSUB(b.x)], 1u);
    const unsigned gen = old / nloc;
    if (old + 1u == (gen + 1u) * nloc) {
      __builtin_amdgcn_fence(__ATOMIC_RELEASE, "agent");
      asm volatile("s_waitcnt vmcnt(0)" ::: "memory");
      const unsigned og = xb_add(&bar[XB_TOP], 1u);
      const unsigned tg = og / nx;
      if (og + 1u == (tg + 1u) * nx) xb_add(&bar[XB_TOPGEN], 1u);
      else XB_SPIN(xb_ld(&bar[XB_TOPGEN]) == tg, bar);
      __builtin_amdgcn_fence(__ATOMIC_ACQUIRE, "agent");
      xb_add(&bar[XB_XGEN(b.x)], 1u);
      asm volatile("s_waitcnt vmcnt(0)" ::: "memory");
    } else {
      XB_SPIN(xb_ld(&bar[XB_XGEN(b.x)]) == gen, bar);
      __builtin_amdgcn_fence(__ATOMIC_ACQUIRE, "agent");
      asm volatile("s_waitcnt vmcnt(0)" ::: "memory");
    }
  }
  __syncthreads();
}

DI const Params& kp() {
  auto k = __builtin_amdgcn_kernarg_segment_ptr();
  asm volatile("" : "+s"(k));
  return *(const Params*)k;
}

#ifndef PROG
#define PROG 0xBA9876543210ull
#define NSTEP 12
#endif
constexpr int N_PHASES = 2 + 2 * NSTEP;
#ifndef PMASK
#define PMASK 0xffff
#endif
#define PM(k) ((PMASK >> (k)) & 1)
#ifndef REPMASK
#define REPMASK 0
#endif

__global__ void __launch_bounds__(NTHREADS) trunk_megakernel(Params p) {
  __shared__ __attribute__((aligned(16))) char smem[131072 + 16];
  cg::grid_group grid = cg::this_grid();
  const int bid = blockIdx.x, nblk = gridDim.x;
  if (threadIdx.x == 0) *(uint4*)(smem + 131072) = make_uint4(0u, 0u, 0u, 0u);
  __syncthreads();
  XcdBarrier xb;
  xb.bar = p.bar; xb.x = 0; xb.st = (volatile LAS unsigned*)(smem + 131072);
  if (p.phase_hi - p.phase_lo > 1) xb = xcd_barrier_post(p.bar, (volatile LAS unsigned*)(smem + 131072));
#pragma unroll 1
  for (int ph = p.phase_lo; ph < p.phase_hi; ++ph) {
    if (ph == 0) {
      if (PM(12)) phase_setup(kp(), smem, bid, nblk);
    } else if (ph == 1) {
      if (PM(13)) phase_rowpass(kp(), bid, nblk, 0, -1, 0.f, 0, 0, true, false);
    } else {
      const int l = (ph - 2) / NSTEP, s = (int)((PROG >> (4 * ((ph - 2) % NSTEP))) & 15ull);


      const bool lo = (l == 1);
      switch (s) {
        case 0: if (PM(0)) phase_gemm(kp(), smem, bid, nblk, EPI_SWIGLU, l, kp().h, DM, kp().wts + (size_t)l * LAYER_W + OFF_W1, DM, 22, false); break;
        case 1: if (PM(1)) phase_gemm(kp(), smem, bid, nblk, EPI_Y, l, kp().r1, DFF, kp().wts + (size_t)l * LAYER_W + OFF_W2, DFF, 4, false); break;
        case 2: if (PM(2)) phase_rowpass(kp(), bid, nblk, l, 0, 0.5f, l, 1, l == 0, false); break;
        case 3: if (PM(3)) phase_gemm(kp(), smem, bid, nblk, EPI_WIN, l, kp().h, DM, kp().wts + (size_t)l * LAYER_W + OFF_WIN, DM, 9, false); break;
        case 4: if (PM(4)) phase_rowprep(kp(), bid, nblk, l); break;
        case 5: if (PM(5)) phase_dexp_gmlp(kp(), smem, bid, nblk, l); break;
        case 6: if (PM(6)) phase_attn(kp(), smem, bid, nblk, l); break;
        case 7: if (PM(7)) phase_gemm(kp(), smem, bid, nblk, EPI_Y, l, kp().h, DM, kp().wts + (size_t)l * LAYER_W + OFF_WOUT, DM, 4, lo); break;
        case 8: if (PM(8)) phase_rowpass(kp(), bid, nblk, l, 1, 1.0f, l, 2, false, lo); break;
        case 9: if (PM(9)) phase_gemm(kp(), smem, bid, nblk, EPI_SWIGLU, l, kp().h, DM, kp().wts + (size_t)l * LAYER_W + OFF_W3, DM, 22, lo); break;
        case 10: if (PM(10)) phase_gemm(kp(), smem, bid, nblk, EPI_Y, l, kp().r1, DFF, kp().wts + (size_t)l * LAYER_W + OFF_W4, DFF, 4, lo); break;
        default: if (PM(11)) phase_rowpass(kp(), bid, nblk, l, 2, 0.5f, l + 1, (l == 0) ? 0 : -1, false, lo); break;
      }
    }
    if (ph + 1 < p.phase_hi) { if (ph == 0) grid.sync(); else xcd_barrier(xb); }
  }
}

extern "C" void kernel_launch(void* const* d_in, const int* in_sizes, int n_in, void* d_out, int out_size, void* d_ws,
                              size_t ws_size, hipStream_t stream) {
  static int grid_blocks = 0;
  if (!grid_blocks) {
    int dev = 0, cus = 0, per_cu = 0;
    hipGetDevice(&dev);
    hipDeviceGetAttribute(&cus, hipDeviceAttributeMultiprocessorCount, dev);
    hipOccupancyMaxActiveBlocksPerMultiprocessor(&per_cu, trunk_megakernel, NTHREADS, 0);
    if (per_cu < 1) per_cu = 1;
    if (per_cu > 1) per_cu = 1;
    grid_blocks = cus * per_cu;
  }
  Params p{};
  const float** pf = (const float**)&p;
  for (int i = 0; i < 26; ++i) pf[i] = (const float*)d_in[i];
  p.out = (float*)d_out;
  char* ws = (char*)d_ws;
  size_t off = 0;
  auto take = [&](size_t bytes) { char* q = ws + off; off += (bytes + 255) & ~(size_t)255; return q; };
  p.wts = (bf16_t*)take(2 * LAYER_W * 2);
  p.mods = (float*)take((size_t)2 * 9 * 9216 * 4);
  p.rope = (float*)take(3072 * 4);
  p.xctx = (float*)take((size_t)2048 * 1024 * 4);
  p.h = (bf16_t*)take((size_t)MROWS * DM * 2);
  p.r1 = (bf16_t*)take((size_t)MROWS * DFF * 2);
  p.r2 = (bf16_t*)take((size_t)MROWS * NIN * 2);
  p.bar = (unsigned*)take(XCD_BAR_WORDS * 4);
  hipMemsetAsync(p.bar, 0, XCD_BAR_WORDS * 4, stream);
  if (off > ws_size) fprintf(stderr, "workspace too small: need %zu have %zu\n", off, ws_size);
#if MULTI_LAUNCH
  for (int ph = 0; ph < N_PHASES; ++ph) {
    Params q = p;
    q.phase_lo = ph;
    q.phase_hi = ph + 1;
    void* args[] = {&q};
    hipError_t e = hipLaunchCooperativeKernel((void*)trunk_megakernel, dim3(grid_blocks), dim3(NTHREADS), args, 0, stream);
    if (e != hipSuccess) fprintf(stderr, "launch failed: %s\n", hipGetErrorString(e));
  }
#else
  p.phase_lo = 0;
  p.phase_hi = N_PHASES;
  void* args[] = {&p};
  hipError_t e = hipLaunchCooperativeKernel((void*)trunk_megakernel, dim3(grid_blocks), dim3(NTHREADS), args, 0, stream);
  if (e != hipSuccess) fprintf(stderr, "cooperative launch failed: %s (grid %d)\n", hipGetErrorString(e), grid_blocks);
#endif
}
```

```cpp
#include <hip/hip_runtime.h>
#include <hip/hip_cooperative_groups.h>
#include <stdint.h>
#include <cstdio>
namespace cg = cooperative_groups;

#ifndef MULTI_LAUNCH
#define MULTI_LAUNCH 0
#endif

typedef unsigned short bf16_t;
using bf16x8 = __attribute__((ext_vector_type(8))) short;
using f32x16 = __attribute__((ext_vector_type(16))) float;
using u32x4 = __attribute__((ext_vector_type(4))) unsigned;
using u32x2 = __attribute__((ext_vector_type(2))) unsigned;

#define DI __device__ __forceinline__
#define MFMA32(a, b, c) __builtin_amdgcn_mfma_f32_32x32x16_bf16((a), (b), (c), 0, 0, 0)

constexpr int NT = 4352;
constexpr int NB = 8;
constexpr int MROWS = NB * NT;
constexpr int DM = 1024;
constexpr int DFF = 2816;
constexpr int NIN = 2304;
constexpr int NTHREADS = 512;
constexpr float EPS = 1e-6f;
constexpr float LOG2E = 1.4426950408889634f;

constexpr size_t OFF_W1 = 0;
constexpr size_t OFF_W2 = 5767168;
constexpr size_t OFF_W3 = 8650752;
constexpr size_t OFF_W4 = 14417920;
constexpr size_t OFF_WIN = 17301504;
constexpr size_t OFF_WOUT = 19660800;
constexpr size_t OFF_WUQ = 20709376;
constexpr size_t OFF_WUKV = 20840448;
constexpr size_t OFF_WSP = 20905984;
constexpr size_t LAYER_W = 20971520;

constexpr size_t QA_OFF = 0;
constexpr size_t KA_OFF = 8912896;
constexpr size_t VAT_OFF = 17825792;
constexpr size_t QB_OFF = 26738688;
constexpr size_t KB_OFF = 35651584;
constexpr size_t VBT_OFF = 40108032;
constexpr size_t QD_OFF = 44564480;
constexpr size_t KD_OFF = 57933824;
constexpr size_t VDT_OFF = 71303168;

struct Params {
  const float *x, *c, *ctx, *c_ctx, *w_ada, *b_ada, *g_pre, *g_post, *w_ffn1_in, *w_ffn1_out, *w_ffn2_in,
      *w_ffn2_out, *w_in, *w_out, *lam_vecs, *g_subln, *g_qnorm, *g_knorm, *w_spatial, *b_spatial, *ln_g, *ln_b,
      *g_q_a, *w_uq, *g_kv_a, *w_ukv;
  float* out;
  bf16_t* wts;
  float* mods;
  float* rope;
  float* xctx;
  bf16_t* h;
  bf16_t* r1;
  bf16_t* r2;
  unsigned* bar;
  int phase_lo, phase_hi;
};

DI int otid() { int t = threadIdx.x; asm volatile("" : "+v"(t)); return t; }
DI float bf2f(bf16_t v) { return __uint_as_float(((unsigned)v) << 16); }
DI bf16_t f2bf(float f) { __bf16 b = (__bf16)f; return __builtin_bit_cast(unsigned short, b); }
DI unsigned pack2(float a, float b) {
  unsigned r;
  asm("v_cvt_pk_bf16_f32 %0, %1, %2" : "=v"(r) : "v"(a), "v"(b));
  return r;
}
DI float xhalf_max(float x) {
  const unsigned u = __float_as_uint(x);
  auto r = __builtin_amdgcn_permlane32_swap(u, u, false, false);
  return fmaxf(__uint_as_float(r[0]), __uint_as_float(r[1]));
}
DI float max3f(float a, float b, float c) {
  float r;
  asm("v_max3_f32 %0, %1, %2, %3" : "=v"(r) : "v"(a), "v"(b), "v"(c));
  return r;
}
DI int crow(int e, int hh) { return (e & 3) + 8 * (e >> 2) + 4 * hh; }
DI float wave_sum(float v) {
#pragma unroll
  for (int o = 32; o >= 1; o >>= 1) v += __shfl_xor(v, o);
  return v;
}
DI float gelu_tanh(float x) {
  float u = 0.7978845608028654f * (x + 0.044715f * x * x * x);
  float t = __builtin_amdgcn_exp2f(u * (2.f * LOG2E));
  float th = 1.f - 2.f * __builtin_amdgcn_rcpf(1.f + t);
  return 0.5f * x * (1.f + th);
}
DI float silu(float x) { return x * __builtin_amdgcn_rcpf(1.f + __builtin_amdgcn_exp2f(-x * LOG2E)); }

DI void convert_tile(const float* __restrict__ src, int K, int N, int mode, bf16_t* __restrict__ dst, int kt, int nt,
                     float* tile) {
  const int tid = otid();
  {
    const int kl = tid >> 6, n4 = (tid & 63) * 4;
    const int np = nt * 256 + n4;
    int sc = np;
    if (mode == 1) {
      int j = (np >> 7) & 1, tl = np >> 8, cc = np & 127;
      sc = j * DFF + tl * 128 + cc;
    }
    const bool valid = (mode == 1) || (np < N);
    float4 v[8];
#pragma unroll
    for (int i = 0; i < 8; ++i) {
      v[i] = make_float4(0.f, 0.f, 0.f, 0.f);
      if (valid) v[i] = *(const float4*)(src + (size_t)(kt * 64 + kl + 8 * i) * N + sc);
    }
#pragma unroll
    for (int i = 0; i < 8; ++i) {
      float* tp = tile + (kl + 8 * i) * 257 + n4;
      tp[0] = v[i].x; tp[1] = v[i].y; tp[2] = v[i].z; tp[3] = v[i].w;
    }
  }
  __syncthreads();
#pragma unroll
  for (int i = 0; i < 4; ++i) {
    const int cid = tid + i * NTHREADS;
    const int nl = cid >> 3, kc = (cid & 7) * 8;
    u32x4 o;
#pragma unroll
    for (int j = 0; j < 4; ++j) o[j] = pack2(tile[(kc + 2 * j) * 257 + nl], tile[(kc + 2 * j + 1) * 257 + nl]);
    *(u32x4*)(dst + (size_t)(nt * 256 + nl) * K + kt * 64 + kc) = o;
  }
  __syncthreads();
}

DI void phase_setup(const Params& p, char* smem, int bid, int nblk) {
  const int tid = otid();
  constexpr int PER_LAYER = 1292;
  constexpr int N_CONV = 2 * PER_LAYER;
  constexpr int N_MOD = 288;
  const int total = N_CONV + N_MOD + 1;
  for (int it = bid; it < total; it += nblk) {
    if (it < N_CONV) {
      const int l = it / PER_LAYER;
      int i = it - l * PER_LAYER;
      bf16_t* wl = p.wts + (size_t)l * LAYER_W;
      float* tile = (float*)smem;
      if (i < 352) { convert_tile(p.w_ffn1_in + (size_t)l * DM * 2 * DFF, DM, 2 * DFF, 1, wl + OFF_W1, i / 22, i % 22, tile); continue; }
      i -= 352;
      if (i < 176) { convert_tile(p.w_ffn1_out + (size_t)l * DFF * DM, DFF, DM, 0, wl + OFF_W2, i / 4, i % 4, tile); continue; }
      i -= 176;
      if (i < 352) { convert_tile(p.w_ffn2_in + (size_t)l * DM * 2 * DFF, DM, 2 * DFF, 1, wl + OFF_W3, i / 22, i % 22, tile); continue; }
      i -= 352;
      if (i < 176) { convert_tile(p.w_ffn2_out + (size_t)l * DFF * DM, DFF, DM, 0, wl + OFF_W4, i / 4, i % 4, tile); continue; }
      i -= 176;
      if (i < 144) { convert_tile(p.w_in + (size_t)l * DM * 2208, DM, 2208, 0, wl + OFF_WIN, i / 9, i % 9, tile); continue; }
      i -= 144;
      if (i < 64) { convert_tile(p.w_out + (size_t)l * DM * DM, DM, DM, 0, wl + OFF_WOUT, i / 4, i % 4, tile); continue; }
      i -= 64;
      if (i < 8) { convert_tile(p.w_uq + (size_t)l * 256 * 384, 256, 384, 0, wl + OFF_WUQ, i / 2, i % 2, tile); continue; }
      i -= 8;
      if (i < 4) { convert_tile(p.w_ukv + (size_t)l * 128 * 512, 128, 512, 0, wl + OFF_WUKV, i / 2, i % 2, tile); continue; }
      i -= 4;
      {
        const float* s = p.w_spatial + (size_t)l * 65536 + (size_t)i * 4096;
        bf16_t* d = wl + OFF_WSP + (size_t)i * 4096;
        for (int e = tid; e < 4096; e += NTHREADS) d[e] = f2bf(s[e]);
      }
    } else if (it < N_CONV + N_MOD) {
      const int m = it - N_CONV;
      const int l = m / 144, cg64 = m % 144;
      float* s = (float*)smem;
      float* red = (float*)(smem + 36864);
      for (int e = tid; e < 9 * 1024; e += NTHREADS) {
        int b = e >> 10, k = e & 1023;
        float v = (b < 8) ? p.c[b * 1024 + k] : p.c_ctx[k];
        s[e] = silu(v);
      }
      __syncthreads();
      const int w = tid >> 6, lane = tid & 63;
      const int col = cg64 * 64 + lane;
      float acc[9];
#pragma unroll
      for (int b = 0; b < 9; ++b) acc[b] = 0.f;
      const float* wp = p.w_ada + (size_t)l * 1024 * 9216 + col;
      for (int k = w * 128; k < w * 128 + 128; ++k) {
        float wv = wp[(size_t)k * 9216];
#pragma unroll
        for (int b = 0; b < 9; ++b) acc[b] += s[b * 1024 + k] * wv;
      }
#pragma unroll
      for (int b = 0; b < 9; ++b) red[(w * 9 + b) * 64 + lane] = acc[b];
      __syncthreads();
      for (int e = tid; e < 9 * 64; e += NTHREADS) {
        int b = e >> 6, ln = e & 63;
        float t = 0.f;
#pragma unroll
        for (int ww = 0; ww < 8; ++ww) t += red[(ww * 9 + b) * 64 + ln];
        int cc = cg64 * 64 + ln;
        p.mods[((size_t)l * 9 + b) * 9216 + cc] = t + p.b_ada[(size_t)l * 9216 + cc];
      }
      __syncthreads();
    } else {
      for (int e = tid; e < 64 * 8; e += NTHREADS) {
        int pos = e >> 3, j = e & 7;
        float inv = __builtin_amdgcn_exp2f(-(float)j * (13.287712379549449f / 8.f));
        float rev = (float)pos * inv * 0.15915494309189535f;
        p.rope[e] = __builtin_amdgcn_cosf(rev);
        p.rope[512 + e] = __builtin_amdgcn_sinf(rev);
      }
      for (int e = tid; e < 64 * 16; e += NTHREADS) {
        int pos = e >> 4, j = e & 15;
        float inv = __builtin_amdgcn_exp2f(-(float)j * (13.287712379549449f / 16.f));
        float rev = (float)pos * inv * 0.15915494309189535f;
        p.rope[1024 + e] = __builtin_amdgcn_cosf(rev);
        p.rope[2048 + e] = __builtin_amdgcn_sinf(rev);
      }
    }
  }
}

DI void phase_rowpass(const Params& p, int bid, int nblk, int l_post, int j_post, float wres, int l_pre,
                              int j_pre, bool src_inputs, bool lat_only) {
  const int tid = otid(); const int lane = tid & 63, w = tid >> 6;
  const int gw = bid * 8 + w, nw = nblk * 8;
  const int nlat_pw = (NB * 4096 + nw - 1) / nw;
  const int nctx_pw = lat_only ? 0 : (NB * 256 + nw - 1) / nw;
  const int r_begin = 0, r_end = nlat_pw + nctx_pw;
  const int nsplit = (j_post == 1) ? 4 : 7;
  const bf16_t* __restrict__ y = p.r2;
  const bool has_post = j_post >= 0, has_pre = j_pre >= 0;
  float4 gate[4], gpo[4], shf[4], scl[4], gpr[4];
  int cur_mrow = -1;
  const float* __restrict__ gpost_p = p.g_post + ((size_t)l_post * 3 + (has_post ? j_post : 0)) * DM;
  const float* __restrict__ gpre_p = p.g_pre + ((size_t)(has_pre ? l_pre : 0) * 3 + (has_pre ? j_pre : 0)) * DM;
#pragma unroll
  for (int c = 0; c < 4; ++c) {
    gpo[c] = has_post ? *(const float4*)(gpost_p + c * 256 + lane * 4) : make_float4(0.f, 0.f, 0.f, 0.f);
    gpr[c] = has_pre ? *(const float4*)(gpre_p + c * 256 + lane * 4) : make_float4(0.f, 0.f, 0.f, 0.f);
    gate[c] = shf[c] = scl[c] = make_float4(0.f, 0.f, 0.f, 0.f);
  }
  float4 xn[4];
  u32x2 yn[4];
#define RP_ROW(ri, R, bb, tt)                                                                      \
  int R;                                                                                           \
  if ((ri) < nlat_pw) { int _li = gw * nlat_pw + (ri); if (_li > NB * 4096 - 1) _li = NB * 4096 - 1; \
    R = (_li >> 12) * NT + 256 + (_li & 4095); }                                                   \
  else { int _ci = gw * nctx_pw + ((ri) - nlat_pw); if (_ci > NB * 256 - 1) _ci = NB * 256 - 1;     \
    R = (_ci >> 8) * NT + (_ci & 255); }                                                           \
  const int bb = R / NT, tt = R - bb * NT;
#define RP_SRC(bb, tt, ptr)                                                                       \
  const float* ptr;                                                                               \
  if ((tt) < 256) ptr = (src_inputs ? p.ctx : p.xctx) + ((size_t)(bb) * 256 + (tt)) * DM;        \
  else ptr = (src_inputs ? p.x : p.out) + ((size_t)(bb) * 4096 + ((tt) - 256)) * DM;
  if (r_begin < r_end) {
    RP_ROW(r_begin, R0, b0, t0)
    RP_SRC(b0, t0, s0)
#pragma unroll
    for (int c = 0; c < 4; ++c) {
      xn[c] = *(const float4*)(s0 + c * 256 + lane * 4);
      if (has_post && t0 >= 256) yn[c] = *(const u32x2*)(y + (size_t)R0 * DM + c * 256 + lane * 4);
    }
  }
  for (int ri = r_begin; ri < r_end; ++ri) {
    RP_ROW(ri, R, b, t)
    const bool isctx = t < 256;
    const int mrow = isctx ? 8 : b;
    float* dst = isctx ? p.xctx + ((size_t)b * 256 + t) * DM : p.out + ((size_t)b * 4096 + (t - 256)) * DM;
    float xv[16], yv[16];
#pragma unroll
    for (int c = 0; c < 4; ++c) {
      xv[c * 4 + 0] = xn[c].x; xv[c * 4 + 1] = xn[c].y; xv[c * 4 + 2] = xn[c].z; xv[c * 4 + 3] = xn[c].w;
      yv[c * 4 + 0] = __uint_as_float(yn[c][0] << 16);
      yv[c * 4 + 1] = __uint_as_float(yn[c][0] & 0xffff0000u);
      yv[c * 4 + 2] = __uint_as_float(yn[c][1] << 16);
      yv[c * 4 + 3] = __uint_as_float(yn[c][1] & 0xffff0000u);
    }
    if (isctx && has_post) {
      const float* pp = (const float*)((const char*)p.r2 + (size_t)MROWS * DM * 2) + ((size_t)b * 256 + t) * DM + lane * 4;
      float4 q4[7][4];
#pragma unroll
      for (int sp = 0; sp < 7; ++sp)
#pragma unroll
        for (int c = 0; c < 4; ++c)
          q4[sp][c] = (sp < nsplit) ? *(const float4*)(pp + (size_t)sp * 2048 * DM + c * 256) : make_float4(0.f, 0.f, 0.f, 0.f);
#pragma unroll
      for (int c = 0; c < 4; ++c) {
        float4 a4 = q4[0][c];
#pragma unroll
        for (int sp = 1; sp < 7; ++sp) { a4.x += q4[sp][c].x; a4.y += q4[sp][c].y; a4.z += q4[sp][c].z; a4.w += q4[sp][c].w; }
        yv[c * 4 + 0] = a4.x; yv[c * 4 + 1] = a4.y; yv[c * 4 + 2] = a4.z; yv[c * 4 + 3] = a4.w;
      }
    }
    if (ri + 1 < r_end) {
      RP_ROW(ri + 1, Rn, bn, tn)
      RP_SRC(bn, tn, sn)
#pragma unroll
      for (int c = 0; c < 4; ++c) {
        xn[c] = *(const float4*)(sn + c * 256 + lane * 4);
        if (has_post && tn >= 256) yn[c] = *(const u32x2*)(y + (size_t)Rn * DM + c * 256 + lane * 4);
      }
    }
    if (!((ri < nlat_pw) ? (gw * nlat_pw + ri < NB * 4096) : (gw * nctx_pw + (ri - nlat_pw) < NB * 256))) continue;
    if (mrow != cur_mrow) {
      cur_mrow = mrow;
      const float* mpo = p.mods + ((size_t)l_post * 9 + mrow) * 9216 + (3 * (has_post ? j_post : 0) + 2) * DM;
      const float* mpr = p.mods + ((size_t)(has_pre ? l_pre : 0) * 9 + mrow) * 9216 + (3 * (has_pre ? j_pre : 0)) * DM;
#pragma unroll
      for (int c = 0; c < 4; ++c) {
        if (has_post) gate[c] = *(const float4*)(mpo + c * 256 + lane * 4);
        if (has_pre) {
          shf[c] = *(const float4*)(mpr + c * 256 + lane * 4);
          scl[c] = *(const float4*)(mpr + DM + c * 256 + lane * 4);
        }
      }
    }
    if (has_post) {
      float ss = 0.f;
#pragma unroll
      for (int q = 0; q < 16; ++q) ss += yv[q] * yv[q];
      ss = wave_sum(ss);
      const float rstd = rsqrtf(ss * (1.f / DM) + EPS) * wres;
#pragma unroll
      for (int c = 0; c < 4; ++c) {
        xv[c * 4 + 0] += gate[c].x * yv[c * 4 + 0] * rstd * gpo[c].x;
        xv[c * 4 + 1] += gate[c].y * yv[c * 4 + 1] * rstd * gpo[c].y;
        xv[c * 4 + 2] += gate[c].z * yv[c * 4 + 2] * rstd * gpo[c].z;
        xv[c * 4 + 3] += gate[c].w * yv[c * 4 + 3] * rstd * gpo[c].w;
        *(float4*)(dst + c * 256 + lane * 4) = make_float4(xv[c * 4 + 0], xv[c * 4 + 1], xv[c * 4 + 2], xv[c * 4 + 3]);
      }
    }
    if (has_pre) {
      float ss = 0.f;
#pragma unroll
      for (int q = 0; q < 16; ++q) ss += xv[q] * xv[q];
      ss = wave_sum(ss);
      const float rstd = rsqrtf(ss * (1.f / DM) + EPS);
#pragma unroll
      for (int c = 0; c < 4; ++c) {
        float h0 = xv[c * 4 + 0] * rstd * gpr[c].x * (1.f + scl[c].x) + shf[c].x;
        float h1 = xv[c * 4 + 1] * rstd * gpr[c].y * (1.f + scl[c].y) + shf[c].y;
        float h2 = xv[c * 4 + 2] * rstd * gpr[c].z * (1.f + scl[c].z) + shf[c].z;
        float h3 = xv[c * 4 + 3] * rstd * gpr[c].w * (1.f + scl[c].w) + shf[c].w;
        u32x2 o;
        o[0] = pack2(h0, h1);
        o[1] = pack2(h2, h3);
        *(u32x2*)(p.h + (size_t)R * DM + c * 256 + lane * 4) = o;
      }
    }
  }
#undef RP_ROW
#undef RP_SRC
}

enum { EPI_SWIGLU = 0, EPI_Y = 1, EPI_WIN = 2, EPI_UQ = 3, EPI_UKV = 4, EPI_YCTX = 5 };

DI void gemm_mainloop(const bf16_t* __restrict__ A, int lda, const bf16_t* __restrict__ Bt, int ldb, int K, char* smem,
                      f32x16 (&acc)[4][2]) {
  const int tid = otid(), lane = tid & 63, w = tid >> 6, wm = w >> 2, wn = w & 3, r = lane & 31, hh = lane >> 5;
  const int lc = tid & 7, lr = tid >> 3;
  const bf16_t* ap = A + (size_t)lr * lda + lc * 8;
  const bf16_t* bp = Bt + (size_t)lr * ldb + lc * 8;
  const int st_off = lr * 128 + ((lc ^ ((lr >> 1) & 7)) << 4);
  u32x4 ra[4], rb[4];
#pragma unroll
  for (int i = 0; i < 4; ++i)
#pragma unroll
    for (int j = 0; j < 2; ++j)
#pragma unroll
      for (int e = 0; e < 16; ++e) acc[i][j][e] = 0.f;
  const int nk = K >> 6;
#pragma unroll
  for (int i = 0; i < 4; ++i) {
    ra[i] = *(const u32x4*)(ap + (size_t)i * 64 * lda);
    rb[i] = *(const u32x4*)(bp + (size_t)i * 64 * ldb);
  }
#pragma unroll
  for (int i = 0; i < 4; ++i) {
    *(u32x4*)(smem + st_off + i * 8192) = ra[i];
    *(u32x4*)(smem + 32768 + st_off + i * 8192) = rb[i];
  }
  __syncthreads();
  const int sw = (r >> 1) & 7;
#pragma unroll 1
  for (int kt = 0; kt < nk; ++kt) {
    char* cur = smem + (kt & 1) * 65536;
    const bool more = (kt + 1 < nk);
    if (more) {
      ap += 64;
      bp += 64;
#pragma unroll
      for (int i = 0; i < 4; ++i) {
        ra[i] = *(const u32x4*)(ap + (size_t)i * 64 * lda);
        rb[i] = *(const u32x4*)(bp + (size_t)i * 64 * ldb);
      }
    }
    const char* abase = cur + (wm * 128 + r) * 128;
    const char* bbase = cur + 32768 + (wn * 64 + r) * 128;
#pragma unroll
    for (int ks = 0; ks < 4; ++ks) {
      const int off = (((2 * ks + hh) ^ sw) << 4);
      bf16x8 af[4], bfr[2];
#pragma unroll
      for (int i = 0; i < 4; ++i) af[i] = *(const bf16x8*)(abase + i * 4096 + off);
#pragma unroll
      for (int j = 0; j < 2; ++j) bfr[j] = *(const bf16x8*)(bbase + j * 4096 + off);
#pragma unroll
      for (int i = 0; i < 4; ++i)
#pragma unroll
        for (int j = 0; j < 2; ++j) acc[i][j] = MFMA32(af[i], bfr[j], acc[i][j]);
    }
    if (more) {
      char* nxt = smem + ((kt + 1) & 1) * 65536;
#pragma unroll
      for (int i = 0; i < 4; ++i) {
        *(u32x4*)(nxt + st_off + i * 8192) = ra[i];
        *(u32x4*)(nxt + 32768 + st_off + i * 8192) = rb[i];
      }
    }
    __syncthreads();
  }
}

DI int lat_tile(int i) { return (i >> 4) * 17 + 1 + (i & 15); }

DI void gemm_tile(const Params& p, char* smem, int mode, int layer, const bf16_t* A, int lda, const bf16_t* Bt,
                          int K, int rt, int ct) {
  f32x16 acc[4][2];
  const int row0 = rt * 256, col0 = ct * 256;
  gemm_mainloop(A + (size_t)row0 * lda, lda, Bt + (size_t)col0 * K, K, K, smem, acc);
  const int tid = otid(), lane = tid & 63, w = tid >> 6, wm = w >> 2, wn = w & 3, r = lane & 31, hh = lane >> 5;
  const int rb = row0 + wm * 128, cb = col0 + wn * 64;
  const int b = row0 / NT;
  const int tb = rb - b * NT;
  if (mode == EPI_SWIGLU) {
    bf16_t* act = p.r1;
    const int oc = ct * 128 + wn * 32 + r;
#pragma unroll
    for (int i = 0; i < 4; ++i)
#pragma unroll
      for (int e = 0; e < 16; ++e) {
        float g = acc[i][0][e], u = acc[i][1][e];
        act[(size_t)(rb + i * 32 + crow(e, hh)) * DFF + oc] = f2bf(silu(g) * u);
      }
  } else if (mode == EPI_Y) {
    bf16_t* y = p.r2;
#pragma unroll
    for (int i = 0; i < 4; ++i)
#pragma unroll
      for (int j = 0; j < 2; ++j)
#pragma unroll
        for (int e = 0; e < 16; ++e)
          y[(size_t)(rb + i * 32 + crow(e, hh)) * DM + cb + j * 32 + r] = f2bf(acc[i][j][e]);
  } else if (mode == EPI_WIN) {
    const bool isAv = (cb >= 512 && cb < 768);
    const bool isBv = (cb >= 1152 && cb < 1280);
    if (isAv || isBv) {
      bf16_t* vt;
      if (isAv) vt = p.r2 + VAT_OFF + (size_t)((b * 4 + (cb - 512) / 64) * 64) * NT;
      else vt = p.r2 + VBT_OFF + (size_t)((b * 2 + (cb - 1152) / 64) * 64) * NT;
#pragma unroll
      for (int i = 0; i < 4; ++i)
#pragma unroll
        for (int j = 0; j < 2; ++j)
#pragma unroll
          for (int e4 = 0; e4 < 4; ++e4) {
            u32x2 o;
            o[0] = pack2(acc[i][j][e4 * 4 + 0], acc[i][j][e4 * 4 + 1]);
            o[1] = pack2(acc[i][j][e4 * 4 + 2], acc[i][j][e4 * 4 + 3]);
            int t = tb + i * 32 + 8 * e4 + 4 * hh;
            *(u32x2*)(vt + (size_t)(j * 32 + r) * NT + t) = o;
          }
    } else {
      bf16_t* pp = p.r1;
#pragma unroll
      for (int i = 0; i < 4; ++i)
#pragma unroll
        for (int j = 0; j < 2; ++j)
#pragma unroll
          for (int e = 0; e < 16; ++e)
            pp[(size_t)(rb + i * 32 + crow(e, hh)) * NIN + cb + j * 32 + r] = f2bf(acc[i][j][e]);
    }
  } else if (mode == EPI_UQ) {
    const float scale = 0.10206207261596577f * LOG2E;
    const bool isctx = tb < 256;
#pragma unroll
    for (int j = 0; j < 2; ++j) {
      const int n0 = cb + j * 32;
      if (n0 >= 384) continue;
      const int head = n0 / 96, seg = (n0 % 96) / 32;
      bf16_t* qd = p.r2 + QD_OFF + (size_t)(b * 4 + head) * NT * 96 + seg * 32 + r;
#pragma unroll
      for (int i = 0; i < 4; ++i)
#pragma unroll
        for (int e = 0; e < 16; ++e) {
          float v = acc[i][j][e];
          const int t = tb + i * 32 + crow(e, hh);
          if (seg == 2) {
            float pr = __shfl_xor(v, 8);
            if (!isctx) {
              const int pos = t - 256;
              const int pa = (r & 16) ? (pos & 63) : (pos >> 6);
              const float cs = p.rope[pa * 8 + (r & 7)], sn = p.rope[512 + pa * 8 + (r & 7)];
              v = v * cs + ((r & 8) ? pr : -pr) * sn;
            }
          }
          qd[(size_t)t * 96] = f2bf(v * scale);
        }
    }
  } else {
#pragma unroll
    for (int j = 0; j < 2; ++j) {
      const int n0 = cb + j * 32;
      const int head = n0 >> 7, wseg = n0 & 127;
      if (wseg < 64) {
        bf16_t* kd = p.r2 + KD_OFF + (size_t)(b * 4 + head) * NT * 96 + wseg + r;
#pragma unroll
        for (int i = 0; i < 4; ++i)
#pragma unroll
          for (int e = 0; e < 16; ++e) kd[(size_t)(tb + i * 32 + crow(e, hh)) * 96] = f2bf(acc[i][j][e]);
      } else {
        bf16_t* vt = p.r2 + VDT_OFF + (size_t)((b * 4 + head) * 64 + (wseg - 64) + r) * NT;
#pragma unroll
        for (int i = 0; i < 4; ++i)
#pragma unroll
          for (int e4 = 0; e4 < 4; ++e4) {
            u32x2 o;
            o[0] = pack2(acc[i][j][e4 * 4 + 0], acc[i][j][e4 * 4 + 1]);
            o[1] = pack2(acc[i][j][e4 * 4 + 2], acc[i][j][e4 * 4 + 3]);
            *(u32x2*)(vt + tb + i * 32 + 16 * (e4 >> 1) + 8 * hh + 4 * (e4 & 1)) = o;
          }
      }
    }
  }
}


using f32x4 = __attribute__((ext_vector_type(4))) float;
typedef __attribute__((address_space(3))) unsigned lds_u32;
DI int lds_byte8(int r, int c) {
  int st = (r >> 4) * 2 + (c >> 5), rr = r & 15, cc = c & 31, ob = rr * 64 + cc * 2;
  return st * 1024 + (ob ^ (((ob >> 9) & 1) << 5));
}
DI void stage_rc8(int b, int& R, int& C) {
  int st = b / 1024, sb = b % 1024, swz = sb ^ (((sb >> 9) & 1) << 5);
  R = (st >> 1) * 16 + swz / 64;
  C = (st & 1) * 32 + (swz % 64) / 2;
}
#define G8_HT 16384
#define G8_SA(b, h) (smem + ((b) * 2 + (h)) * G8_HT)
#define G8_SB(b, h) (smem + (4 + (b) * 2 + (h)) * G8_HT)
#define G8_STAGE(P, BASE, goff0, goff1, ld, br, kt)                                                              \
  do {                                                                                                            \
    const bf16_t* _g = (BASE) + (size_t)(br) * (ld) + (size_t)(kt) * 64;                                          \
    __builtin_amdgcn_global_load_lds((const unsigned*)(_g + goff0), (lds_u32*)((P) + tid * 16), 16, 0, 0);        \
    __builtin_amdgcn_global_load_lds((const unsigned*)(_g + goff1), (lds_u32*)((P) + tid * 16 + 8192), 16, 0, 0); \
  } while (0)
#define G8_LDA(dst, b, h)                                                                                 \
  _Pragma("unroll") for (int m = 0; m < 4; ++m) _Pragma("unroll") for (int k = 0; k < 2; ++k) dst[m][k] = \
      *(const bf16x8*)(G8_SA(b, h) + lds_byte8(wr * 64 + m * 16 + fr, k * 32 + fq * 8))
#define G8_LDB(dst, b, h)                                                                                 \
  _Pragma("unroll") for (int n = 0; n < 2; ++n) _Pragma("unroll") for (int k = 0; k < 2; ++k) dst[n][k] = \
      *(const bf16x8*)(G8_SB(b, h) + lds_byte8(wc * 32 + n * 16 + fr, k * 32 + fq * 8))
#define G8_MMA(ai, bj, AT, BX)                                                                         \
  do {                                                                                                 \
    __builtin_amdgcn_s_setprio(1);                                                                     \
    _Pragma("unroll") for (int m = 0; m < 4; ++m) _Pragma("unroll") for (int n = 0; n < 2; ++n)        \
        _Pragma("unroll") for (int k = 0; k < 2; ++k) acc[ai][bj][m][n] =                              \
            __builtin_amdgcn_mfma_f32_16x16x32_bf16(AT[m][k], BX[n][k], acc[ai][bj][m][n], 0, 0, 0);   \
    __builtin_amdgcn_s_setprio(0);                                                                     \
  } while (0)
#define G8_WAIT_V(n) asm volatile("s_waitcnt vmcnt(" #n ")" ::: "memory")
#define G8_WAIT_L(n) asm volatile("s_waitcnt lgkmcnt(" #n ")" ::: "memory")
#define G8_BAR __builtin_amdgcn_s_barrier()
#define G8_SCHED __builtin_amdgcn_sched_barrier(0)

DI void gemm8_mainloop(const bf16_t* __restrict__ A, int lda, const bf16_t* __restrict__ Bt, int ldb, int K,
                       __attribute__((address_space(3))) char* smem, f32x4 (&acc)[2][2][4][2]) {
  const int tid = otid();
  const int wid = tid >> 6, lane = tid & 63, wr = wid >> 2, wc = wid & 3, fr = lane & 15, fq = lane >> 4;
  int r0, c0, r1, c1;
  stage_rc8(tid * 16, r0, c0);
  stage_rc8(tid * 16 + 8192, r1, c1);
  const int ga0 = r0 * lda + c0, ga1 = r1 * lda + c1, gb0 = r0 * ldb + c0, gb1 = r1 * ldb + c1;
#pragma unroll
  for (int a = 0; a < 2; ++a)
#pragma unroll
    for (int b = 0; b < 2; ++b)
#pragma unroll
      for (int m = 0; m < 4; ++m)
#pragma unroll
        for (int n = 0; n < 2; ++n) acc[a][b][m][n] = (f32x4){0.f, 0.f, 0.f, 0.f};
  bf16x8 At[4][2], B0[2][2], B1[2][2];
  const int nt = K >> 6;
  G8_WAIT_V(0);
  G8_STAGE(G8_SB(0, 0), Bt, gb0, gb1, ldb, 0, 0);
  G8_STAGE(G8_SA(0, 0), A, ga0, ga1, lda, 0, 0);
  G8_STAGE(G8_SB(0, 1), Bt, gb0, gb1, ldb, 128, 0);
  G8_STAGE(G8_SA(0, 1), A, ga0, ga1, lda, 128, 0);
  if (wr == 1) G8_BAR;
  G8_WAIT_V(4); G8_BAR;
  G8_STAGE(G8_SB(1, 0), Bt, gb0, gb1, ldb, 0, 1);
  G8_STAGE(G8_SA(1, 0), A, ga0, ga1, lda, 0, 1);
  G8_STAGE(G8_SB(1, 1), Bt, gb0, gb1, ldb, 128, 1);
  G8_WAIT_V(6); G8_BAR;
#pragma unroll 1
  for (int t = 0; t < nt - 2; t += 2) {
    G8_LDB(B0, 0, 0); G8_SCHED; G8_LDA(At, 0, 0); G8_STAGE(G8_SA(1, 1), A, ga0, ga1, lda, 128, t + 1);
    G8_WAIT_L(8); G8_BAR; G8_WAIT_L(0); G8_MMA(0, 0, At, B0); G8_BAR; G8_SCHED;
    G8_LDB(B1, 0, 1); G8_STAGE(G8_SB(0, 0), Bt, gb0, gb1, ldb, 0, t + 2);
    G8_BAR; G8_WAIT_L(0); G8_MMA(0, 1, At, B1); G8_BAR;
    G8_LDA(At, 0, 1); G8_STAGE(G8_SA(0, 0), A, ga0, ga1, lda, 0, t + 2);
    G8_BAR; G8_WAIT_L(0); G8_MMA(1, 0, At, B0); G8_BAR; G8_SCHED;
    G8_STAGE(G8_SB(0, 1), Bt, gb0, gb1, ldb, 128, t + 2);
    G8_WAIT_V(6); G8_BAR; G8_MMA(1, 1, At, B1); G8_BAR;
    G8_LDB(B0, 1, 0); G8_SCHED; G8_LDA(At, 1, 0); G8_STAGE(G8_SA(0, 1), A, ga0, ga1, lda, 128, t + 2);
    G8_WAIT_L(8); G8_BAR; G8_WAIT_L(0); G8_MMA(0, 0, At, B0); G8_BAR; G8_SCHED;
    G8_LDB(B1, 1, 1); G8_STAGE(G8_SB(1, 0), Bt, gb0, gb1, ldb, 0, t + 3);
    G8_BAR; G8_WAIT_L(0); G8_MMA(0, 1, At, B1); G8_BAR;
    G8_LDA(At, 1, 1); G8_STAGE(G8_SA(1, 0), A, ga0, ga1, lda, 0, t + 3);
    G8_BAR; G8_WAIT_L(0); G8_MMA(1, 0, At, B0); G8_BAR; G8_SCHED;
    G8_STAGE(G8_SB(1, 1), Bt, gb0, gb1, ldb, 128, t + 3);
    G8_WAIT_V(6); G8_BAR; G8_MMA(1, 1, At, B1); G8_BAR;
  }
  {
    G8_LDB(B0, 0, 0); G8_LDA(At, 0, 0); G8_STAGE(G8_SA(1, 1), A, ga0, ga1, lda, 128, nt - 1);
    G8_BAR; G8_WAIT_L(0); G8_MMA(0, 0, At, B0); G8_BAR;
    G8_LDB(B1, 0, 1); G8_BAR; G8_WAIT_L(0); G8_MMA(0, 1, At, B1); G8_BAR;
    G8_LDA(At, 0, 1); G8_WAIT_V(4); G8_BAR; G8_WAIT_L(0); G8_MMA(1, 0, At, B0); G8_MMA(1, 1, At, B1); G8_BAR;
  }
  {
    G8_LDB(B0, 1, 0); G8_LDA(At, 1, 0); G8_WAIT_V(2); G8_BAR; G8_WAIT_L(0); G8_MMA(0, 0, At, B0); G8_BAR;
    G8_LDB(B1, 1, 1); G8_WAIT_V(0); G8_BAR; G8_WAIT_L(0); G8_MMA(0, 1, At, B1); G8_BAR;
    G8_LDA(At, 1, 1); G8_BAR; G8_WAIT_L(0); G8_MMA(1, 0, At, B0); G8_MMA(1, 1, At, B1); G8_BAR;
  }
  if (wr == 0) G8_BAR;
}

DI void gemm8_tile(const Params& p, char* smem_g, int mode, const bf16_t* A, int lda, const bf16_t* Bt, int K, int rt,
                   int ct, int k0 = 0, int klen = 0, int split = 0) {
  f32x4 acc[2][2][4][2];
  const int row0 = rt * 256, col0 = ct * 256;
  gemm8_mainloop(A + (size_t)row0 * lda + k0, lda, Bt + (size_t)col0 * K + k0, K, klen ? klen : K,
                 (__attribute__((address_space(3))) char*)smem_g, acc);
  const int tid = otid();
  const int wid = tid >> 6, lane = tid & 63, wr = wid >> 2, wc = wid & 3, fr = lane & 15, fq = lane >> 4;
  const int b = row0 / NT;
  const int rw = row0 + wr * 64 + fq * 4;
  if (mode == EPI_SWIGLU) {
    bf16_t* act = p.r1;
#pragma unroll
    for (int ai = 0; ai < 2; ++ai)
#pragma unroll
      for (int m = 0; m < 4; ++m)
#pragma unroll
        for (int n = 0; n < 2; ++n)
#pragma unroll
          for (int j = 0; j < 4; ++j) {
            float g = acc[ai][0][m][n][j], u = acc[ai][1][m][n][j];
            act[(size_t)(rw + ai * 128 + m * 16 + j) * DFF + ct * 128 + wc * 32 + n * 16 + fr] = f2bf(silu(g) * u);
          }
  } else if (mode == EPI_YCTX) {
    float* yc = (float*)((char*)p.r2 + (size_t)MROWS * DM * 2) + (size_t)split * 2048 * DM + (size_t)(b * 256) * DM;
    const int tl = wr * 64 + fq * 4;
#pragma unroll
    for (int ai = 0; ai < 2; ++ai)
#pragma unroll
      for (int bj = 0; bj < 2; ++bj)
#pragma unroll
        for (int m = 0; m < 4; ++m)
#pragma unroll
          for (int n = 0; n < 2; ++n)
#pragma unroll
            for (int j = 0; j < 4; ++j)
              yc[(size_t)(tl + ai * 128 + m * 16 + j) * DM + col0 + bj * 128 + wc * 32 + n * 16 + fr] =
                  acc[ai][bj][m][n][j];
  } else if (mode == EPI_Y) {
    bf16_t* y = p.r2;
#pragma unroll
    for (int ai = 0; ai < 2; ++ai)
#pragma unroll
      for (int bj = 0; bj < 2; ++bj)
#pragma unroll
        for (int m = 0; m < 4; ++m)
#pragma unroll
          for (int n = 0; n < 2; ++n)
#pragma unroll
            for (int j = 0; j < 4; ++j)
              y[(size_t)(rw + ai * 128 + m * 16 + j) * DM + col0 + bj * 128 + wc * 32 + n * 16 + fr] =
                  f2bf(acc[ai][bj][m][n][j]);
  } else {
    const int tw16 = row0 - b * NT + wr * 64 + (((fq & 1) << 1) | (fq >> 1)) * 4;
#pragma unroll
    for (int bj = 0; bj < 2; ++bj) {
      const int cb = col0 + bj * 128 + wc * 32;
      const bool isAv = (cb >= 512 && cb < 768);
      const bool isBv = (cb >= 1152 && cb < 1280);
      if (isAv || isBv) {
        bf16_t* vt;
        if (isAv) vt = p.r2 + VAT_OFF + (size_t)((b * 4 + (cb - 512) / 64) * 64 + (cb & 32)) * NT;
        else vt = p.r2 + VBT_OFF + (size_t)((b * 2 + (cb - 1152) / 64) * 64 + (cb & 32)) * NT;
#pragma unroll
        for (int ai = 0; ai < 2; ++ai)
#pragma unroll
          for (int m = 0; m < 4; ++m)
#pragma unroll
            for (int n = 0; n < 2; ++n) {
              u32x2 o;
              o[0] = pack2(acc[ai][bj][m][n][0], acc[ai][bj][m][n][1]);
              o[1] = pack2(acc[ai][bj][m][n][2], acc[ai][bj][m][n][3]);
              *(u32x2*)(vt + (size_t)(n * 16 + fr) * NT + tw16 + ai * 128 + m * 16) = o;
            }
      } else {
        bf16_t* pp = p.r1;
#pragma unroll
        for (int ai = 0; ai < 2; ++ai)
#pragma unroll
          for (int m = 0; m < 4; ++m)
#pragma unroll
            for (int n = 0; n < 2; ++n)
#pragma unroll
              for (int j = 0; j < 4; ++j)
                pp[(size_t)(rw + ai * 128 + m * 16 + j) * NIN + cb + n * 16 + fr] = f2bf(acc[ai][bj][m][n][j]);
      }
    }
  }
}

DI int xcd_vb(int bid, int nblk) {
  if (nblk & 7) return bid;
  return (bid & 7) * (nblk >> 3) + (bid >> 3);
}

DI void phase_gemm(const Params& p, char* smem, int bid, int nblk, int mode, int layer, const bf16_t* A, int lda,
                           const bf16_t* Bt, int K, int nct, bool lat_only) {
  const bool ctx_split = (mode == EPI_Y) && !lat_only;
  const bool lat = lat_only || ctx_split;
  const int nrt = lat ? 128 : 136;
  const int nfull = nrt * nct;
  const int nsplit = (K == DFF) ? 7 : 4;
  const int total = nfull + (ctx_split ? 32 * nsplit : 0);
  const int nig = 8 * nct;
  for (int t = xcd_vb(bid, nblk); t < total; t += nblk) {
    if (t < nfull) {
      const int gid = t / nig, fm = gid * 8;
      const int gsz = (nrt - fm) < 8 ? (nrt - fm) : 8;
      const int rem = t - gid * nig;
      int rti = fm + rem % gsz, ct = rem / gsz;
      int rt = lat ? lat_tile(rti) : rti;
      gemm8_tile(p, smem, mode, A, lda, Bt, K, rt, ct);
    } else {
      const int u = t - nfull;
      const int tile = u / nsplit, sp = u - tile * nsplit;
      const int rt = (tile >> 2) * 17, ct = tile & 3;
      int k0, klen;
      if (K == DFF) { k0 = sp * 384; klen = (sp == 6) ? 512 : 384; }
      else { klen = K / 4; k0 = sp * klen; }
      gemm8_tile(p, smem, EPI_YCTX, A, lda, Bt, K, rt, ct, k0, klen, sp);
    }
  }
}

DI void phase_rowprep(const Params& p, int bid, int nblk, int l) {
  const int tid = otid(); const int lane = tid & 63, w = tid >> 6;
  const int gw = bid * 8 + w, nw = nblk * 8;
  const float* __restrict__ ropeAc = p.rope;
  const float* __restrict__ ropeAs = p.rope + 512;
  const float* __restrict__ ropeBc = p.rope + 1024;
  const float* __restrict__ ropeBs = p.rope + 2048;
  const float gqn = p.g_qnorm[l * 64 + lane], gkn = p.g_knorm[l * 64 + lane];
  float lng[4], lnb[4], gqa[4], gkva[2];
#pragma unroll
  for (int i = 0; i < 4; ++i) {
    lng[i] = p.ln_g[l * 256 + i * 64 + lane];
    lnb[i] = p.ln_b[l * 256 + i * 64 + lane];
    gqa[i] = p.g_q_a[l * 256 + i * 64 + lane];
  }
  gkva[0] = p.g_kv_a[l * 128 + lane];
  gkva[1] = p.g_kv_a[l * 128 + 64 + lane];
  const float scaleA = 0.17677669529663687f * LOG2E;
  const float scaleB = 0.125f * LOG2E;
  bf16_t* __restrict__ qkv = p.r2;
  const int rpw = (MROWS + nw - 1) / nw;
  const int r_begin = gw * rpw, r_end = (r_begin + rpw < MROWS) ? r_begin + rpw : MROWS;
  float na[8], nb_[6], nc[8], nd[6], nkr = 0.f;
#define RPREP_LOAD(Rr)                                                                   \
  do {                                                                                   \
    const bf16_t* _P = p.r1 + (size_t)(Rr) * NIN;                                        \
    _Pragma("unroll") for (int i = 0; i < 8; ++i) na[i] = bf2f(_P[i * 64 + lane]);       \
    _Pragma("unroll") for (int i = 0; i < 6; ++i) nb_[i] = bf2f(_P[768 + i * 64 + lane]); \
    _Pragma("unroll") for (int i = 0; i < 8; ++i) nc[i] = bf2f(_P[1280 + i * 64 + lane]); \
    _Pragma("unroll") for (int i = 0; i < 6; ++i) nd[i] = bf2f(_P[1792 + i * 64 + lane]); \
    nkr = bf2f(_P[2176 + (lane & 31)]);                                                  \
  } while (0)
  if (r_begin < r_end) RPREP_LOAD(r_begin);
  for (int R = r_begin; R < r_end; ++R) {
    const int b = R / NT, t = R - b * NT;
    const bool isctx = t < 256;
    const int pos = t - 256;
    const int prow = pos >> 6, pcol = pos & 63;
    bf16_t* P = p.r1 + (size_t)R * NIN;
    float va[8], vb[6], vc[8], vd[6], vkr;
#pragma unroll
    for (int i = 0; i < 8; ++i) { va[i] = na[i]; vc[i] = nc[i]; }
#pragma unroll
    for (int i = 0; i < 6; ++i) { vb[i] = nb_[i]; vd[i] = nd[i]; }
    vkr = nkr;
    if (R + 1 < r_end) RPREP_LOAD(R + 1);
    {
      const int d = lane & 31;
      const int pa = (d & 16) ? pcol : prow;
      float cs = 1.f, sn = 0.f;
      if (!isctx) { cs = ropeAc[pa * 8 + (d & 7)]; sn = ropeAs[pa * 8 + (d & 7)]; }
      const float sg = (d & 8) ? sn : -sn;
#pragma unroll
      for (int i = 0; i < 4; ++i) {
        const int hm = (i * 64 + lane) >> 5;
        float vq = va[i], vk = va[4 + i];
        float pq = __shfl_xor(vq, 8), pk = __shfl_xor(vk, 8);
        vq = vq * cs + sg * pq;
        vk = vk * cs + sg * pk;
        size_t o = ((size_t)(b * 8 + hm) * NT + t) * 32 + d;
        qkv[QA_OFF + o] = f2bf(vq * scaleA);
        qkv[KA_OFF + o] = f2bf(vk);
      }
    }
    {
      const int d = lane;
      const int pa = (d & 32) ? pcol : prow;
      float cs = 1.f, sn = 0.f;
      if (!isctx) { cs = ropeBc[pa * 16 + (d & 15)]; sn = ropeBs[pa * 16 + (d & 15)]; }
      const float sg = (d & 16) ? sn : -sn;
      float ss[6];
#pragma unroll
      for (int i = 0; i < 6; ++i) ss[i] = vb[i] * vb[i];
#pragma unroll
      for (int o = 32; o >= 1; o >>= 1)
#pragma unroll
        for (int i = 0; i < 6; ++i) ss[i] += __shfl_xor(ss[i], o);
#pragma unroll
      for (int i = 0; i < 6; ++i) {
        float v = vb[i] * rsqrtf(ss[i] * (1.f / 64.f) + EPS) * (i < 4 ? gqn : gkn);
        float pr = __shfl_xor(v, 16);
        v = v * cs + sg * pr;
        if (i < 4) qkv[QB_OFF + ((size_t)(b * 4 + i) * NT + t) * 64 + d] = f2bf(v * scaleB);
        else qkv[KB_OFF + ((size_t)(b * 2 + (i - 4)) * NT + t) * 64 + d] = f2bf(v);
      }
    }
    {
      float s1 = 0.f, sq = 0.f, skv = 0.f;
#pragma unroll
      for (int i = 0; i < 4; ++i) {
        vc[i] = gelu_tanh(vc[i]);
        vc[4 + i] = gelu_tanh(vc[4 + i]);
        s1 += vc[4 + i];
        sq += vd[i] * vd[i];
      }
      skv = vd[4] * vd[4] + vd[5] * vd[5];
#pragma unroll
      for (int o = 32; o >= 1; o >>= 1) {
        s1 += __shfl_xor(s1, o);
        sq += __shfl_xor(sq, o);
        skv += __shfl_xor(skv, o);
      }
      const float mu = s1 * (1.f / 256.f);
      float s2 = 0.f;
#pragma unroll
      for (int i = 0; i < 4; ++i) { vc[4 + i] -= mu; s2 += vc[4 + i] * vc[4 + i]; }
      s2 = wave_sum(s2);
      const float rln = rsqrtf(s2 * (1.f / 256.f) + EPS);
      const float rq = rsqrtf(sq * (1.f / 256.f) + EPS);
      const float rkv = rsqrtf(skv * (1.f / 128.f) + EPS);
#pragma unroll
      for (int i = 0; i < 4; ++i) {
        P[1280 + i * 64 + lane] = f2bf(vc[i]);
        P[1536 + i * 64 + lane] = f2bf(vc[4 + i] * rln * lng[i] + lnb[i]);
        P[1792 + i * 64 + lane] = f2bf(vd[i] * rq * gqa[i]);
      }
      P[2048 + lane] = f2bf(vd[4] * rkv * gkva[0]);
      P[2048 + 64 + lane] = f2bf(vd[5] * rkv * gkva[1]);
    }
    {
      const int d = lane & 31;
      float kr = vkr;
      float pr = __shfl_xor(kr, 8);
      if (!isctx) {
        const int pa = (d & 16) ? pcol : prow;
        kr = kr * ropeAc[pa * 8 + (d & 7)] + ((d & 8) ? pr : -pr) * ropeAs[pa * 8 + (d & 7)];
      }
      if (lane < 32) {
        const bf16_t kb = f2bf(kr);
#pragma unroll
        for (int hd = 0; hd < 4; ++hd) qkv[KD_OFF + ((size_t)(b * 4 + hd) * NT + t) * 96 + 64 + d] = kb;
      }
    }
  }
}

#undef RPREP_LOAD
DI void gmlp_item(const Params& p, char* smem, int l, int ch, int g) {
  const int tid = otid(), lane = tid & 63, w = tid >> 6, r = lane & 31, hh = lane >> 5;
  const int R0 = ch * 128;
  bf16_t* vT = (bf16_t*)smem;
#pragma unroll
  for (int u = 0; u < 2; ++u) {
    const int cid = tid + u * NTHREADS;
    const int q = cid >> 3, cc = cid & 7;
    u32x4 v = *(const u32x4*)(p.r1 + (size_t)(R0 + q) * NIN + 1536 + g * 64 + cc * 8);
#pragma unroll
    for (int j = 0; j < 4; ++j) {
      vT[(cc * 8 + 2 * j) * 136 + q] = (bf16_t)(v[j] & 0xffffu);
      vT[(cc * 8 + 2 * j + 1) * 136 + q] = (bf16_t)(v[j] >> 16);
    }
  }
  __syncthreads();
  const int wp = w >> 1, wc = w & 1;
  const bf16_t* wsp = p.wts + (size_t)l * LAYER_W + OFF_WSP + (size_t)g * 16384;
  f32x16 acc;
#pragma unroll
  for (int e = 0; e < 16; ++e) acc[e] = 0.f;
#pragma unroll
  for (int ks = 0; ks < 8; ++ks) {
    bf16x8 a = *(const bf16x8*)(wsp + (wp * 32 + r) * 128 + ks * 16 + hh * 8);
    bf16x8 bb = *(const bf16x8*)(vT + (wc * 32 + r) * 136 + ks * 16 + hh * 8);
    acc = MFMA32(a, bb, acc);
  }
  const int c = g * 64 + wc * 32 + r;
#pragma unroll
  for (int e = 0; e < 16; ++e) {
    const int pp = wp * 32 + crow(e, hh);
    const float u = bf2f(p.r1[(size_t)(R0 + pp) * NIN + 1280 + c]);
    const float mixed = acc[e] + p.b_spatial[(size_t)l * 512 + g * 128 + pp];
    p.h[(size_t)(R0 + pp) * DM + 512 + c] = f2bf(u * mixed);
  }
  __syncthreads();
}

DI void phase_dexp_gmlp(const Params& p, char* smem, int bid, int nblk, int l) {
  const bool lat_only = (l == 1);
  const bf16_t* wl = p.wts + (size_t)l * LAYER_W;
  const int nch = lat_only ? 256 : 272;
  const int total = 272 + 272 + nch * 4;
  for (int t = xcd_vb(bid, nblk); t < total; t += nblk) {
    if (t < 272) {
      gemm_tile(p, smem, EPI_UQ, l, p.r1 + 1792, NIN, wl + OFF_WUQ, 256, t >> 1, t & 1);
    } else if (t < 544) {
      int u = t - 272;
      gemm_tile(p, smem, EPI_UKV, l, p.r1 + 2048, NIN, wl + OFF_WUKV, 128, u >> 1, u & 1);
    } else {
      int u = t - 544;
      int ci = u >> 2, g = u & 3;
      int ch = lat_only ? ((ci >> 5) * 34 + 2 + (ci & 31)) : ci;
      gmlp_item(p, smem, l, ch, g);
    }
  }
}

template <int CPR>
DI int kswz(int c, int row) {
  if (CPR == 4) return c ^ ((row >> 2) & 3);
  if (CPR == 8) return c ^ ((row >> 1) & 7);
  return (c & 12) | ((c & 3) ^ ((row >> 2) & 3));
}

template <int DQK, int NMAP>
DI void attn_item(const bf16_t* __restrict__ Qb, const bf16_t* __restrict__ Kb, const bf16_t* __restrict__ Vt,
                  int q0, int nkeys, bf16_t* __restrict__ outp, char* smem_g, float lam, float post_scale,
                  const float* __restrict__ g_subln) {
  typedef __attribute__((address_space(3))) char lchar;
  lchar* smem = (lchar*)smem_g;
  constexpr int CPR = DQK / 8;
  constexpr int KMAPB = 64 * CPR * 16;
  constexpr int KBYTES = NMAP * KMAPB;
  constexpr int STAGE = KBYTES + 8192;
  constexpr int NS = 5;
  constexpr int NKS = KBYTES / 16;
  constexpr int GK = (NKS + NTHREADS - 1) / NTHREADS;
  constexpr int KK = DQK / 16;
  constexpr float THR = 6.0f;
  const int tid = otid();
  const int lane = tid & 63, w = tid >> 6, r = lane & 31, hh = lane >> 5;

  asm volatile("s_waitcnt vmcnt(0)" ::: "memory");
  __builtin_amdgcn_s_barrier();
  asm volatile("" ::: "memory");

  bf16x8 qf[NMAP][KK];
  {
    const int qrow = q0 + w * 32 + r;
#pragma unroll
    for (int m = 0; m < NMAP; ++m)
#pragma unroll
      for (int kk = 0; kk < KK; ++kk)
        qf[m][kk] = *(const bf16x8*)(Qb + (size_t)m * NT * DQK + (size_t)qrow * DQK + kk * 16 + hh * 8);
  }
  const bf16_t* ksrc[GK];
  int kslot[GK];
#pragma unroll
  for (int u = 0; u < GK; ++u) {
    int sl = tid + u * NTHREADS;
    if (sl >= NKS) sl = tid;
    const int m = sl / (64 * CPR), rem = sl % (64 * CPR), row = rem / CPR, cp = rem % CPR;
    const int c = kswz<CPR>(cp, row);
    ksrc[u] = Kb + (size_t)m * NT * DQK + (size_t)row * DQK + c * 8;
    kslot[u] = sl * 16;
  }
  const int vrow = tid >> 3, vcp = tid & 7;
  const bf16_t* vsrc = Vt + (size_t)vrow * NT + ((vcp ^ ((vrow >> 1) & 7)) * 8);
  const int vslot = KBYTES + tid * 16;
  const int nt = nkeys >> 6;

#define ATT_ISSUE(tile, stoff)                                                                                    \
  do {                                                                                                            \
    const int _tl = (tile) < nt ? (tile) : nt - 1;                                                                \
    lchar* _st = smem + (stoff);                                                                                  \
    _Pragma("unroll") for (int u = 0; u < GK; ++u) __builtin_amdgcn_global_load_lds(                              \
        (const unsigned*)(ksrc[u] + (size_t)_tl * 64 * DQK), (lds_u32*)(_st + kslot[u]), 16, 0, 0);                \
    __builtin_amdgcn_global_load_lds((const unsigned*)(vsrc + _tl * 64), (lds_u32*)(_st + vslot), 16, 0, 0);      \
  } while (0)
#define ATT_WAITG()                                                    \
  do {                                                                 \
    if (GK == 1) asm volatile("s_waitcnt vmcnt(2)" ::: "memory");      \
    else asm volatile("s_waitcnt vmcnt(3)" ::: "memory");              \
  } while (0)

  f32x16 O[NMAP][2];
  float mrun[NMAP], lrun[NMAP];
#pragma unroll
  for (int m = 0; m < NMAP; ++m) {
    mrun[m] = 0.f;
    lrun[m] = 0.f;
#pragma unroll
    for (int d = 0; d < 2; ++d)
#pragma unroll
      for (int e = 0; e < 16; ++e) O[m][d][e] = 0.f;
  }
  const int kq = (r >> 2) & 3, k8 = (r >> 1) & 7;
  const int koff = r * (CPR * 16), voff = r * 128;

#define ATT_QK(Sx, so, m, base)                                                                          \
  do {                                                                                                   \
    _Pragma("unroll") for (int t2 = 0; t2 < 2; ++t2) {                                                   \
      _Pragma("unroll") for (int e = 0; e < 16; ++e) Sx[t2][e] = -(base);                                \
      _Pragma("unroll") for (int kk = 0; kk < KK; ++kk) {                                                \
        const int c = kk * 2 + hh;                                                                       \
        const int cp = (CPR == 8) ? (c ^ k8) : ((c & 12) | ((c & 3) ^ kq));                              \
        bf16x8 a = *(const bf16x8*)(smem + (so) + (m) * KMAPB + t2 * 32 * (CPR * 16) + koff + cp * 16);  \
        Sx[t2] = MFMA32(a, qf[m][kk], Sx[t2]);                                                           \
      }                                                                                                  \
    }                                                                                                    \
  } while (0)
#define ATT_PV(Px, so, m)                                                                                \
  do {                                                                                                   \
    _Pragma("unroll") for (int d = 0; d < 2; ++d) _Pragma("unroll") for (int t2 = 0; t2 < 2; ++t2)       \
        _Pragma("unroll") for (int s2 = 0; s2 < 2; ++s2) {                                               \
      const int c = t2 * 4 + s2 * 2 + hh;                                                                \
      bf16x8 vf = *(const bf16x8*)(smem + (so) + KBYTES + d * 32 * 128 + voff + ((c ^ k8) * 16));        \
      O[m][d] = MFMA32(vf, Px[t2][s2], O[m][d]);                                                         \
    }                                                                                                    \
  } while (0)
#define ATT_SOFTMAX(Sx, sbase, Px, m, first)                                                             \
  do {                                                                                                   \
    float mx = fmaxf(Sx[0][0], Sx[1][0]);                                                                \
    _Pragma("unroll") for (int e = 1; e < 16; ++e) mx = max3f(mx, Sx[0][e], Sx[1][e]);                   \
    mx = xhalf_max(mx);                                                                  \
    const float drift = mrun[m] - (sbase);                                                               \
    const float mxr = mx - drift;                                                                        \
    const bool up = (first) || (mxr > THR);                                                              \
    if (__builtin_amdgcn_ballot_w64(up || (drift != 0.f)) != 0ull) {                                     \
      const float sh = up ? mxr : 0.f;                                                                   \
      const float alpha = (first) ? 1.f : __builtin_amdgcn_exp2f(-sh);                                   \
      mrun[m] += sh;                                                                                     \
      lrun[m] *= alpha;                                                                                  \
      _Pragma("unroll") for (int d = 0; d < 2; ++d) _Pragma("unroll") for (int e = 0; e < 16; ++e)       \
          O[m][d][e] *= alpha;                                                                           \
      const float tot = drift + sh;                                                                      \
      _Pragma("unroll") for (int t2 = 0; t2 < 2; ++t2) _Pragma("unroll") for (int e = 0; e < 16; ++e)    \
          Sx[t2][e] -= tot;                                                                              \
    }                                                                                                    \
    float sum = 0.f;                                                                                     \
    _Pragma("unroll") for (int t2 = 0; t2 < 2; ++t2) _Pragma("unroll") for (int e = 0; e < 16; ++e) {    \
      float pv = __builtin_amdgcn_exp2f(Sx[t2][e]);                                                      \
      Sx[t2][e] = pv;                                                                                    \
      sum += pv;                                                                                         \
    }                                                                                                    \
    lrun[m] += sum;                                                                                      \
    _Pragma("unroll") for (int t2 = 0; t2 < 2; ++t2) _Pragma("unroll") for (int s2 = 0; s2 < 2; ++s2) {  \
      u32x4 pk;                                                                                          \
      _Pragma("unroll") for (int j = 0; j < 4; ++j)                                                      \
          pk[j] = pack2(Sx[t2][8 * s2 + 2 * j], Sx[t2][8 * s2 + 2 * j + 1]);                             \
      Px[t2][s2] = __builtin_bit_cast(bf16x8, pk);                                                       \
    }                                                                                                    \
  } while (0)

  f32x16 Sa[2], Sb[2];
  bf16x8 Pa[2][2], Pb[2][2];
  float basea = 0.f, baseb = 0.f;
#pragma unroll
  for (int t2 = 0; t2 < 2; ++t2)
#pragma unroll
    for (int s2 = 0; s2 < 2; ++s2) {
      u32x4 z = {0u, 0u, 0u, 0u};
      Pa[t2][s2] = __builtin_bit_cast(bf16x8, z);
      Pb[t2][s2] = __builtin_bit_cast(bf16x8, z);
    }
  ATT_ISSUE(0, 0);
  ATT_ISSUE(1, STAGE);
  ATT_ISSUE(2, 2 * STAGE);
  if (GK == 1) asm volatile("s_waitcnt vmcnt(4)" ::: "memory");
  else asm volatile("s_waitcnt vmcnt(6)" ::: "memory");
  __builtin_amdgcn_s_barrier();
  asm volatile("" ::: "memory");
  ATT_QK(Sa, 0, 0, 0.f);
  int sp = 0, sc = 0, sn = STAGE, si = 3 * STAGE;
#define ATT_ADV()                                         \
  do {                                                    \
    sp = sc; sc = sn;                                     \
    sn = (sn + STAGE == NS * STAGE) ? 0 : sn + STAGE;     \
    si = (si + STAGE == NS * STAGE) ? 0 : si + STAGE;     \
  } while (0)
  if (NMAP == 2) {
#pragma unroll 1
    for (int j = 0; j < nt; ++j) {
      ATT_WAITG();
      __builtin_amdgcn_s_barrier();
      asm volatile("" ::: "memory");
      ATT_ISSUE(j + 3, si);
      baseb = mrun[NMAP - 1];
      ATT_QK(Sb, sc, NMAP - 1, baseb);
      ATT_PV(Pb, sp, NMAP - 1);
      ATT_SOFTMAX(Sa, basea, Pa, 0, (j == 0));
      basea = mrun[0];
      ATT_QK(Sa, sn, 0, basea);
      ATT_PV(Pa, sc, 0);
      ATT_SOFTMAX(Sb, baseb, Pb, NMAP - 1, (j == 0));
      ATT_ADV();
    }
    ATT_PV(Pb, sp, NMAP - 1);
  } else {
#pragma unroll 1
    for (int j = 0; j < nt; j += 2) {
      ATT_WAITG();
      __builtin_amdgcn_s_barrier();
      asm volatile("" ::: "memory");
      ATT_ISSUE(j + 3, si);
      baseb = mrun[0];
      ATT_QK(Sb, sn, 0, baseb);
      ATT_PV(Pb, sp, 0);
      ATT_SOFTMAX(Sa, basea, Pa, 0, (j == 0));
      ATT_ADV();
      ATT_WAITG();
      __builtin_amdgcn_s_barrier();
      asm volatile("" ::: "memory");
      ATT_ISSUE(j + 4, si);
      basea = mrun[0];
      ATT_QK(Sa, sn, 0, basea);
      ATT_PV(Pa, sp, 0);
      ATT_SOFTMAX(Sb, baseb, Pb, 0, false);
      ATT_ADV();
    }
    ATT_PV(Pb, sp, 0);
  }
#undef ATT_ISSUE
#undef ATT_WAITG
#undef ATT_QK
#undef ATT_PV
#undef ATT_SOFTMAX
#undef ATT_ADV
  asm volatile("s_waitcnt vmcnt(0)" ::: "memory");
#pragma unroll
  for (int m = 0; m < NMAP; ++m) lrun[m] += __shfl_xor(lrun[m], 32);
  bf16_t* orow = outp + (size_t)(w * 32 + r) * DM;
  if (NMAP == 1) {
    const float inv = 1.f / lrun[0];
#pragma unroll
    for (int d = 0; d < 2; ++d)
#pragma unroll
      for (int e4 = 0; e4 < 4; ++e4) {
        u32x2 o;
        o[0] = pack2(O[0][d][e4 * 4 + 0] * inv, O[0][d][e4 * 4 + 1] * inv);
        o[1] = pack2(O[0][d][e4 * 4 + 2] * inv, O[0][d][e4 * 4 + 3] * inv);
        *(u32x2*)(orow + d * 32 + 8 * e4 + 4 * hh) = o;
      }
  } else {
    const float i1 = 1.f / lrun[0], i2 = lam / lrun[NMAP - 1];
    float ss = 0.f;
#pragma unroll
    for (int d = 0; d < 2; ++d)
#pragma unroll
      for (int e = 0; e < 16; ++e) {
        float o = O[0][d][e] * i1 - O[NMAP - 1][d][e] * i2;
        O[0][d][e] = o;
        ss += o * o;
      }
    ss += __shfl_xor(ss, 32);
    const float rstd = rsqrtf(ss * (1.f / 64.f) + EPS) * post_scale;
#pragma unroll
    for (int d = 0; d < 2; ++d)
#pragma unroll
      for (int e4 = 0; e4 < 4; ++e4) {
        const int dv = d * 32 + 8 * e4 + 4 * hh;
        u32x2 o;
        o[0] = pack2(O[0][d][e4 * 4 + 0] * rstd * g_subln[dv + 0], O[0][d][e4 * 4 + 1] * rstd * g_subln[dv + 1]);
        o[1] = pack2(O[0][d][e4 * 4 + 2] * rstd * g_subln[dv + 2], O[0][d][e4 * 4 + 3] * rstd * g_subln[dv + 3]);
        *(u32x2*)(orow + dv) = o;
      }
  }
}


template <int DQK>
DI void attn_item_w64(const bf16_t* __restrict__ Qb, const bf16_t* __restrict__ Kb, const bf16_t* __restrict__ Vt,
                      int q0, int nkeys, bf16_t* __restrict__ outp, char* smem_g) {
  typedef __attribute__((address_space(3))) char lchar;
  lchar* smem = (lchar*)smem_g;
  constexpr int CPR = DQK / 8;
  constexpr int KBYTES = 64 * CPR * 16;
  constexpr int STAGE = KBYTES + 8192;
  constexpr int NS = 4;
  constexpr int NKS = KBYTES / 16;
  constexpr int GK = (NKS + NTHREADS - 1) / NTHREADS;
  constexpr int KK = DQK / 16;
  constexpr float THR = 6.0f;
  const int tid = otid();
  const int lane = tid & 63, w = tid >> 6, r = lane & 31, hh = lane >> 5;

  asm volatile("s_waitcnt vmcnt(0)" ::: "memory");
  __builtin_amdgcn_s_barrier();
  asm volatile("" ::: "memory");

  bf16x8 qf[2][KK];
#pragma unroll
  for (int g = 0; g < 2; ++g) {
    const int qrow = q0 + w * 64 + g * 32 + r;
#pragma unroll
    for (int kk = 0; kk < KK; ++kk) qf[g][kk] = *(const bf16x8*)(Qb + (size_t)qrow * DQK + kk * 16 + hh * 8);
  }
  const bf16_t* ksrc[GK];
  int kslot[GK];
#pragma unroll
  for (int u = 0; u < GK; ++u) {
    int sl = tid + u * NTHREADS;
    if (sl >= NKS) sl = tid;
    const int row = sl / CPR, cp = sl % CPR;
    const int c = kswz<CPR>(cp, row);
    ksrc[u] = Kb + (size_t)row * DQK + c * 8;
    kslot[u] = sl * 16;
  }
  const int vrow = tid >> 3, vcp = tid & 7;
  const bf16_t* vsrc = Vt + (size_t)vrow * NT + ((vcp ^ ((vrow >> 1) & 7)) * 8);
  const int vslot = KBYTES + tid * 16;
  const int nt = nkeys >> 6;
#define ATT_ISSUE(tile)                                                                                           \
  do {                                                                                                            \
    const int _tl = (tile) < nt ? (tile) : nt - 1;                                                                \
    lchar* _st = smem + ((tile) & (NS - 1)) * STAGE;                                                              \
    _Pragma("unroll") for (int u = 0; u < GK; ++u) __builtin_amdgcn_global_load_lds(                              \
        (const unsigned*)(ksrc[u] + (size_t)_tl * 64 * DQK), (lds_u32*)(_st + kslot[u]), 16, 0, 0);                \
    __builtin_amdgcn_global_load_lds((const unsigned*)(vsrc + _tl * 64), (lds_u32*)(_st + vslot), 16, 0, 0);      \
  } while (0)
  f32x16 O[2][2];
  float mrun[2], lrun[2];
#pragma unroll
  for (int g = 0; g < 2; ++g) {
    mrun[g] = 0.f;
    lrun[g] = 0.f;
#pragma unroll
    for (int d = 0; d < 2; ++d)
#pragma unroll
      for (int e = 0; e < 16; ++e) O[g][d][e] = 0.f;
  }
  ATT_ISSUE(0);
  ATT_ISSUE(1);
  ATT_ISSUE(2);
  const int kq = (r >> 2) & 3, k8 = (r >> 1) & 7;
#pragma unroll 1
  for (int it = 0; it < nt; ++it) {
    if (GK == 1) asm volatile("s_waitcnt vmcnt(4)" ::: "memory");
    else asm volatile("s_waitcnt vmcnt(6)" ::: "memory");
    __builtin_amdgcn_s_barrier();
    asm volatile("" ::: "memory");
    ATT_ISSUE(it + 3);
    const lchar* cur = smem + (it & (NS - 1)) * STAGE;
    f32x16 S[2][2];
    {
      constexpr int KSTEP = (KK > 4) ? 3 : KK;
      const unsigned kbase = (unsigned)(size_t)cur + r * (CPR * 16);
#pragma unroll
      for (int g = 0; g < 2; ++g)
#pragma unroll
        for (int t2 = 0; t2 < 2; ++t2)
#pragma unroll
          for (int e = 0; e < 16; ++e) S[g][t2][e] = -mrun[g];
#pragma unroll
      for (int kb = 0; kb < KK; kb += KSTEP) {
        bf16x8 kf[2 * KSTEP];
#pragma unroll
        for (int k2 = 0; k2 < KSTEP; ++k2) {
          const int c = (kb + k2) * 2 + hh;
          const int cp = (CPR == 8) ? (c ^ k8) : ((c & 12) | ((c & 3) ^ kq));
          const unsigned ad = kbase + cp * 16;
          asm volatile("ds_read_b128 %0, %1" : "=v"(kf[2 * k2]) : "v"(ad));
          asm volatile("ds_read_b128 %0, %1 offset:%2" : "=v"(kf[2 * k2 + 1]) : "v"(ad), "n"(32 * CPR * 16));
        }
#pragma unroll
        for (int k2 = 0; k2 < KSTEP; ++k2)
#pragma unroll
          for (int t2 = 0; t2 < 2; ++t2) {
            asm volatile("s_waitcnt lgkmcnt(%1)" : "+v"(kf[2 * k2 + t2]) : "n"(2 * KSTEP - 1 - (2 * k2 + t2)));
#pragma unroll
            for (int g = 0; g < 2; ++g) S[g][t2] = MFMA32(kf[2 * k2 + t2], qf[g][kb + k2], S[g][t2]);
          }
      }
    }
    bf16x8 pb[2][2][2];
#pragma unroll
    for (int g = 0; g < 2; ++g) {
      float mx = fmaxf(S[g][0][0], S[g][1][0]);
#pragma unroll
      for (int e = 1; e < 16; ++e) mx = max3f(mx, S[g][0][e], S[g][1][e]);
      mx = xhalf_max(mx);
      const bool need = (it == 0) || (mx > THR);
      if (__builtin_amdgcn_ballot_w64(need) != 0ull) {
        const float sh = need ? mx : 0.f;
        const float alpha = (it == 0) ? 1.f : __builtin_amdgcn_exp2f(-sh);
        mrun[g] += sh;
        lrun[g] *= alpha;
#pragma unroll
        for (int d = 0; d < 2; ++d)
#pragma unroll
          for (int e = 0; e < 16; ++e) O[g][d][e] *= alpha;
#pragma unroll
        for (int t2 = 0; t2 < 2; ++t2)
#pragma unroll
          for (int e = 0; e < 16; ++e) S[g][t2][e] -= sh;
      }
      float sum = 0.f;
#pragma unroll
      for (int t2 = 0; t2 < 2; ++t2)
#pragma unroll
        for (int e = 0; e < 16; ++e) {
          float pv = __builtin_amdgcn_exp2f(S[g][t2][e]);
          S[g][t2][e] = pv;
          sum += pv;
        }
      lrun[g] += sum;
#pragma unroll
      for (int t2 = 0; t2 < 2; ++t2)
#pragma unroll
        for (int s2 = 0; s2 < 2; ++s2) {
          u32x4 pk;
#pragma unroll
          for (int j = 0; j < 4; ++j) pk[j] = pack2(S[g][t2][8 * s2 + 2 * j], S[g][t2][8 * s2 + 2 * j + 1]);
          pb[g][t2][s2] = __builtin_bit_cast(bf16x8, pk);
        }
    }
    {
      bf16x8 vf[8];
      const unsigned vbase = (unsigned)(size_t)cur + KBYTES + r * 128;
#pragma unroll
      for (int q = 0; q < 4; ++q) {
        const unsigned ad = vbase + (((q * 2 + hh) ^ k8) * 16);
        asm volatile("ds_read_b128 %0, %1" : "=v"(vf[2 * q]) : "v"(ad));
        asm volatile("ds_read_b128 %0, %1 offset:4096" : "=v"(vf[2 * q + 1]) : "v"(ad));
      }
#pragma unroll
      for (int q = 0; q < 4; ++q)
#pragma unroll
        for (int d = 0; d < 2; ++d) {
          asm volatile("s_waitcnt lgkmcnt(%1)" : "+v"(vf[2 * q + d]) : "n"(7 - (2 * q + d)));
#pragma unroll
          for (int g = 0; g < 2; ++g) O[g][d] = MFMA32(vf[2 * q + d], pb[g][q >> 1][q & 1], O[g][d]);
        }
    }
  }
#undef ATT_ISSUE
  asm volatile("s_waitcnt vmcnt(0)" ::: "memory");
#pragma unroll
  for (int g = 0; g < 2; ++g) {
    const float l = lrun[g] + __shfl_xor(lrun[g], 32);
    const float inv = 1.f / l;
    bf16_t* orow = outp + (size_t)(w * 64 + g * 32 + r) * DM;
#pragma unroll
    for (int d = 0; d < 2; ++d)
#pragma unroll
      for (int e4 = 0; e4 < 4; ++e4) {
        u32x2 o;
        o[0] = pack2(O[g][d][e4 * 4 + 0] * inv, O[g][d][e4 * 4 + 1] * inv);
        o[1] = pack2(O[g][d][e4 * 4 + 2] * inv, O[g][d][e4 * 4 + 3] * inv);
        *(u32x2*)(orow + d * 32 + 8 * e4 + 4 * hh) = o;
      }
  }
}

DI void phase_attn(const Params& p, char* smem, int bid, int nblk, int l) {
  const bool lat_only = (l == 1);
  const int nq = lat_only ? 16 : 17;
  const int per = NB * 4 * nq;
  const int total = 3 * per;
  const float lam_init = (l == 0) ? 0.2f : 0.35550906759096927f;
  float lam;
  {
    const float* lv = p.lam_vecs + l * 128;
    float s1 = 0.f, s2 = 0.f;
    for (int i = 0; i < 32; ++i) { s1 += lv[i] * lv[32 + i]; s2 += lv[64 + i] * lv[96 + i]; }
    lam = __builtin_amdgcn_exp2f(s1 * LOG2E) - __builtin_amdgcn_exp2f(s2 * LOG2E) + lam_init;
  }
  const int nA = NB * 4 * 16, nW = NB * 4 * 8;
  const int nlat = nA + 2 * nW;
  const int total_items = nlat + (lat_only ? 0 : 3 * NB * 4);
  for (int t = xcd_vb(bid, nblk); t < total_items; t += nblk) {
    int mixer, bh, q0, nkeys = NT;
    bool wide = false;
    if (t < nA) { mixer = 0; bh = t >> 4; q0 = ((t & 15) + 1) * 256; }
    else if (t < nlat) { const int u = t - nA; mixer = 1 + u / nW; const int v = u % nW; bh = v >> 3; q0 = 256 + (v & 7) * 512; wide = true; }
    else { const int u = t - nlat; mixer = u / (NB * 4); bh = u % (NB * 4); q0 = 0; nkeys = 256; }
    const int b = bh >> 2, hd = bh & 3;
    bf16_t* mixrow = p.h + ((size_t)b * NT + q0) * DM;
    if (mixer == 0) {
      attn_item<32, 2>(p.r2 + QA_OFF + (size_t)(b * 4 + hd) * 2 * NT * 32, p.r2 + KA_OFF + (size_t)(b * 4 + hd) * 2 * NT * 32,
                       p.r2 + VAT_OFF + (size_t)(b * 4 + hd) * 64 * NT, q0, nkeys, mixrow + hd * 64, smem, lam,
                       1.f - lam_init, p.g_subln + l * 64);
    } else if (mixer == 1) {
      const bf16_t* Q = p.r2 + QD_OFF + (size_t)(b * 4 + hd) * NT * 96;
      const bf16_t* K = p.r2 + KD_OFF + (size_t)(b * 4 + hd) * NT * 96;
      const bf16_t* V = p.r2 + VDT_OFF + (size_t)(b * 4 + hd) * 64 * NT;
      if (wide) attn_item_w64<96>(Q, K, V, q0, nkeys, mixrow + 768 + hd * 64, smem);
      else attn_item<96, 1>(Q, K, V, q0, nkeys, mixrow + 768 + hd * 64, smem, 0.f, 0.f, nullptr);
    } else {
      const bf16_t* Q = p.r2 + QB_OFF + (size_t)(b * 4 + hd) * NT * 64;
      const bf16_t* K = p.r2 + KB_OFF + (size_t)(b * 2 + (hd >> 1)) * NT * 64;
      const bf16_t* V = p.r2 + VBT_OFF + (size_t)(b * 2 + (hd >> 1)) * 64 * NT;
      if (wide) attn_item_w64<64>(Q, K, V, q0, nkeys, mixrow + 256 + hd * 64, smem);
      else attn_item<64, 1>(Q, K, V, q0, nkeys, mixrow + 256 + hd * 64, smem, 0.f, 0.f, nullptr);
    }
  }
}


#define XB_TMO      128
#define XB_XCNT(j)  (256  + 64 * (j))
#define XB_XSUB(j)  (1280 + 64 * (j))
#define XB_XGEN(j)  (2304 + 64 * (j))
#define XB_TOP      3328
#define XB_TOPGEN   3392
#define XCD_BAR_WORDS 3456
#define XB_SPIN_CAP (1u << 18)
#define LAS __attribute__((address_space(3)))
DI unsigned xb_ld(unsigned* p) { return __hip_atomic_load(p, __ATOMIC_RELAXED, __HIP_MEMORY_SCOPE_AGENT); }
DI unsigned xb_add(unsigned* p, unsigned v) { return __hip_atomic_fetch_add(p, v, __ATOMIC_RELAXED, __HIP_MEMORY_SCOPE_AGENT); }
DI unsigned xb_xcc_id() { return (unsigned)__builtin_amdgcn_s_getreg((3 << 11) | 20) & 0xFu; }
#define XB_SPIN(cond, bar) do { unsigned _sp = 0; while (cond) { __builtin_amdgcn_s_sleep(1); \
    if ((++_sp & 255u) == 0u) { if (xb_ld(&(bar)[XB_TMO])) break; if (_sp > XB_SPIN_CAP) { atomicAdd(&(bar)[XB_TMO], 1u); break; } } } } while (0)
struct XcdBarrier { unsigned* bar; unsigned x; volatile LAS unsigned* st; };
DI XcdBarrier xcd_barrier_post(unsigned* bar, volatile LAS unsigned* st) {
  XcdBarrier b; b.bar = bar; b.x = xb_xcc_id(); b.st = st;
  if (threadIdx.x == 0) (void)xb_add(&bar[XB_XCNT(b.x)], 1u);
  return b;
}
DI void xcd_barrier_complete(unsigned* bar, unsigned x, unsigned& nloc, unsigned& nx) {
  const unsigned G = gridDim.x * gridDim.y * gridDim.z;
  unsigned sum, cnt, mine, sp = 0u;
  for (;;) {
    sum = 0u; cnt = 0u; mine = 0u;
#pragma unroll
    for (unsigned j = 0; j < 16; ++j) { const unsigned c = xb_ld(&bar[XB_XCNT(j)]); sum += c; cnt += (c > 0u) ? 1u : 0u; mine = (j == x) ? c : mine; }
    if (sum == G) break;
    __builtin_amdgcn_s_sleep(1);
    if ((++sp & 255u) == 0u) { if (xb_ld(&bar[XB_TMO])) break; if (sp > XB_SPIN_CAP) { atomicAdd(&bar[XB_TMO], 1u); break; } }
  }
  nloc = mine > 0u ? mine : 1u; nx = cnt > 0u ? cnt : 1u;
}
DI void xcd_barrier(const XcdBarrier& b) {
  asm volatile("s_waitcnt vmcnt(0)" ::: "memory");
  __syncthreads();
  if (threadIdx.x == 0) {
    unsigned* bar = b.bar;
    __builtin_amdgcn_s_waitcnt(0);
    unsigned nloc = b.st[0], nx = b.st[1];
    if (nloc == 0u) { xcd_barrier_complete(bar, b.x, nloc, nx); b.st[0] = nloc; b.st[1] = nx; }
    const unsigned old = xb_add(&bar[XB_XSUB(b.x)], 1u);
    const unsigned gen = old / nloc;
    if (old + 1u == (gen + 1u) * nloc) {
      __builtin_amdgcn_fence(__ATOMIC_RELEASE, "agent");
      asm volatile("s_waitcnt vmcnt(0)" ::: "memory");
      const unsigned og = xb_add(&bar[XB_TOP], 1u);
      const unsigned tg = og / nx;
      if (og + 1u == (tg + 1u) * nx) xb_add(&bar[XB_TOPGEN], 1u);
      else XB_SPIN(xb_ld(&bar[XB_TOPGEN]) == tg, bar);
      __builtin_amdgcn_fence(__ATOMIC_ACQUIRE, "agent");
      xb_add(&bar[XB_XGEN(b.x)], 1u);
      asm volatile("s_waitcnt vmcnt(0)" ::: "memory");
    } else {
      XB_SPIN(xb_ld(&bar[XB_XGEN(b.x)]) == gen, bar);
      __builtin_amdgcn_fence(__ATOMIC_ACQUIRE, "agent");
      asm volatile("s_waitcnt vmcnt(0)" ::: "memory");
    }
  }
  __syncthreads();
}

DI const Params& kp() {
  auto k = __builtin_amdgcn_kernarg_segment_ptr();
  asm volatile("" : "+s"(k));
  return *(const Params*)k;
}

#ifndef PROG
#define PROG 0xBA9876543210ull
#define NSTEP 12
#endif
constexpr int N_PHASES = 2 + 2 * NSTEP;
#ifndef PMASK
#define PMASK 0xffff
#endif
#define PM(k) ((PMASK >> (k)) & 1)
#ifndef REPMASK
#define REPMASK 0
#endif

__global__ void __launch_bounds__(NTHREADS) trunk_megakernel(Params p) {
  __shared__ __attribute__((aligned(16))) char smem[131072 + 16];
  cg::grid_group grid = cg::this_grid();
  const int bid = blockIdx.x, nblk = gridDim.x;
  if (threadIdx.x == 0) *(uint4*)(smem + 131072) = make_uint4(0u, 0u, 0u, 0u);
  __syncthreads();
  XcdBarrier xb;
  xb.bar = p.bar; xb.x = 0; xb.st = (volatile LAS unsigned*)(smem + 131072);
  if (p.phase_hi - p.phase_lo > 1) xb = xcd_barrier_post(p.bar, (volatile LAS unsigned*)(smem + 131072));
#pragma unroll 1
  for (int ph = p.phase_lo; ph < p.phase_hi; ++ph) {
    if (ph == 0) {
      if (PM(12)) phase_setup(kp(), smem, bid, nblk);
    } else if (ph == 1) {
      if (PM(13)) phase_rowpass(kp(), bid, nblk, 0, -1, 0.f, 0, 0, true, false);
    } else {
      const int l = (ph - 2) / NSTEP, s = (int)((PROG >> (4 * ((ph - 2) % NSTEP))) & 15ull);


      const bool lo = (l == 1);
      switch (s) {
        case 0: if (PM(0)) phase_gemm(kp(), smem, bid, nblk, EPI_SWIGLU, l, kp().h, DM, kp().wts + (size_t)l * LAYER_W + OFF_W1, DM, 22, false); break;
        case 1: if (PM(1)) phase_gemm(kp(), smem, bid, nblk, EPI_Y, l, kp().r1, DFF, kp().wts + (size_t)l * LAYER_W + OFF_W2, DFF, 4, false); break;
        case 2: if (PM(2)) phase_rowpass(kp(), bid, nblk, l, 0, 0.5f, l, 1, l == 0, false); break;
        case 3: if (PM(3)) phase_gemm(kp(), smem, bid, nblk, EPI_WIN, l, kp().h, DM, kp().wts + (size_t)l * LAYER_W + OFF_WIN, DM, 9, false); break;
        case 4: if (PM(4)) phase_rowprep(kp(), bid, nblk, l); break;
        case 5: if (PM(5)) phase_dexp_gmlp(kp(), smem, bid, nblk, l); break;
        case 6: if (PM(6)) phase_attn(kp(), smem, bid, nblk, l); break;
        case 7: if (PM(7)) phase_gemm(kp(), smem, bid, nblk, EPI_Y, l, kp().h, DM, kp().wts + (size_t)l * LAYER_W + OFF_WOUT, DM, 4, lo); break;
        case 8: if (PM(8)) phase_rowpass(kp(), bid, nblk, l, 1, 1.0f, l, 2, false, lo); break;
        case 9: if (PM(9)) phase_gemm(kp(), smem, bid, nblk, EPI_SWIGLU, l, kp().h, DM, kp().wts + (size_t)l * LAYER_W + OFF_W3, DM, 22, lo); break;
        case 10: if (PM(10)) phase_gemm(kp(), smem, bid, nblk, EPI_Y, l, kp().r1, DFF, kp().wts + (size_t)l * LAYER_W + OFF_W4, DFF, 4, lo); break;
        default: if (PM(11)) phase_rowpass(kp(), bid, nblk, l, 2, 0.5f, l + 1, (l == 0) ? 0 : -1, false, lo); break;
      }
    }
    if (ph + 1 < p.phase_hi) { if (ph == 0) grid.sync(); else xcd_barrier(xb); }
  }
}

extern "C" void kernel_launch(void* const* d_in, const int* in_sizes, int n_in, void* d_out, int out_size, void* d_ws,
                              size_t ws_size, hipStream_t stream) {
  static int grid_blocks = 0;
  if (!grid_blocks) {
    int dev = 0, cus = 0, per_cu = 0;
    hipGetDevice(&dev);
    hipDeviceGetAttribute(&cus, hipDeviceAttributeMultiprocessorCount, dev);
    hipOccupancyMaxActiveBlocksPerMultiprocessor(&per_cu, trunk_megakernel, NTHREADS, 0);
    if (per_cu < 1) per_cu = 1;
    if (per_cu > 1) per_cu = 1;
    grid_blocks = cus * per_cu;
  }
  Params p{};
  const float** pf = (const float**)&p;
  for (int i = 0; i < 26; ++i) pf[i] = (const float*)d_in[i];
  p.out = (float*)d_out;
  char* ws = (char*)d_ws;
  size_t off = 0;
  auto take = [&](size_t bytes) { char* q = ws + off; off += (bytes + 255) & ~(size_t)255; return q; };
  p.wts = (bf16_t*)take(2 * LAYER_W * 2);
  p.mods = (float*)take((size_t)2 * 9 * 9216 * 4);
  p.rope = (float*)take(3072 * 4);
  p.xctx = (float*)take((size_t)2048 * 1024 * 4);
  p.h = (bf16_t*)take((size_t)MROWS * DM * 2);
  p.r1 = (bf16_t*)take((size_t)MROWS * DFF * 2);
  p.r2 = (bf16_t*)take((size_t)MROWS * NIN * 2);
  p.bar = (unsigned*)take(XCD_BAR_WORDS * 4);
  hipMemsetAsync(p.bar, 0, XCD_BAR_WORDS * 4, stream);
  if (off > ws_size) fprintf(stderr, "workspace too small: need %zu have %zu\n", off, ws_size);
#if MULTI_LAUNCH
  for (int ph = 0; ph < N_PHASES; ++ph) {
    Params q = p;
    q.phase_lo = ph;
    q.phase_hi = ph + 1;
    void* args[] = {&q};
    hipError_t e = hipLaunchCooperativeKernel((void*)trunk_megakernel, dim3(grid_blocks), dim3(NTHREADS), args, 0, stream);
    if (e != hipSuccess) fprintf(stderr, "launch failed: %s\n", hipGetErrorString(e));
  }
#else
  p.phase_lo = 0;
  p.phase_hi = N_PHASES;
  void* args[] = {&p};
  hipError_t e = hipLaunchCooperativeKernel((void*)trunk_megakernel, dim3(grid_blocks), dim3(NTHREADS), args, 0, stream);
  if (e != hipSuccess) fprintf(stderr, "cooperative launch failed: %s (grid %d)\n", hipGetErrorString(e), grid_blocks);
#endif
}
```
